# Optimizing an MI355X kernel written in HIP

```python
import math
import jax, jax.numpy as jnp
from jax import lax
import numpy as np

D_MODEL = 2048
BATCH = 4
SEQ = 4096
DEPTH = 2

EPS = 1e-6
S5_WIDTH = D_MODEL // 4
S5_GROUP = 16
S5_GROUPS = S5_WIDTH // S5_GROUP
S5_STATE = 64
GDN_HEAD_DIM = 128
GDN_WIDTH = D_MODEL // 4
GDN_HEADS = GDN_WIDTH // GDN_HEAD_DIM
GDN_CONV = 4
GDN_CHUNK = 64
NSA_HEAD_DIM = 64
NSA_WIDTH = D_MODEL // 2
NSA_HEADS = NSA_WIDTH // NSA_HEAD_DIM
NSA_KV_HEADS = 4
NSA_KV_WIDTH = NSA_KV_HEADS * NSA_HEAD_DIM
CMP_LEN = 32
CMP_STRIDE = 16
CMP_HIDDEN = 256
SLC_BLOCK = 64
SLC_TOPK = 16
WINDOW = 512
Q_BLOCK = 128
ROPE_THETA = 10000.0
BIG = 1e9
N_GROUPS = 4
EXPERTS_PER_GROUP = 8
N_EXPERTS = N_GROUPS * EXPERTS_PER_GROUP
TOP_K = 2
D_EXPERT = 512
MOE_BLOCK = 128
IN_SIZES = (S5_WIDTH, 3 * GDN_WIDTH, GDN_WIDTH, GDN_HEADS, GDN_HEADS, NSA_WIDTH, 6 * NSA_KV_WIDTH, 3 * NSA_HEADS)
D_IN = sum(IN_SIZES)

kernel_name = 'hybrid_s5_gdn_nsa_hmoe_block'


def rms_norm(x, gain):
    xf = x.astype(jnp.float32)
    y = xf * lax.rsqrt(jnp.mean(xf * xf, axis=-1, keepdims=True) + EPS)
    return (y * gain.astype(jnp.float32)).astype(x.dtype)


def l2_norm(x):
    return x * lax.rsqrt(jnp.sum(x * x, axis=-1, keepdims=True) + EPS)


def rope_tables(pos, dim):
    inv_freq = ROPE_THETA ** (-jnp.arange(0, dim, 2, dtype=jnp.float32) / dim)
    ang = pos.astype(jnp.float32)[:, None] * inv_freq[None, :]
    return jnp.cos(ang)[:, None, :], jnp.sin(ang)[:, None, :]


def rope(x, cos, sin):
    x1, x2 = jnp.split(x, 2, axis=-1)
    return jnp.concatenate([x1 * cos - x2 * sin, x2 * cos + x1 * sin], axis=-1).astype(x.dtype)


def masked_softmax(s, mask):
    s = jnp.where(mask, s, -jnp.inf)
    m = jnp.max(s, axis=-1, keepdims=True)
    m = jnp.where(jnp.isfinite(m), m, 0.0)
    p = jnp.exp(s - m)
    return p / jnp.maximum(jnp.sum(p, axis=-1, keepdims=True), jnp.finfo(jnp.float32).tiny)


def s5_mixer(u, lam_re, lam_im, b_re, b_im, c_re, c_im, d_skip, log_dt, glu_w, glu_b):
    Bsz, S, _ = u.shape
    f32 = jnp.float32
    lam = lax.complex(lam_re.astype(f32), lam_im.astype(f32))
    dt = jnp.exp(log_dt.astype(f32))[:, None]
    lam_bar = jnp.exp(lam * dt)
    b = lax.complex(b_re.astype(f32), b_im.astype(f32))
    b_bar = ((lam_bar - 1.0) / lam)[:, :, None] * b
    c = lax.complex(c_re.astype(f32), c_im.astype(f32))
    ug = u.astype(f32).reshape(Bsz, S, S5_GROUPS, S5_GROUP)
    bu = jnp.einsum('gph,bsgh->bsgp', b_bar, ug.astype(jnp.complex64))
    a = jnp.broadcast_to(lam_bar, bu.shape)

    def combine(left, right):
        a_l, b_l = left
        a_r, b_r = right
        return a_r * a_l, a_r * b_l + b_r

    _, states = lax.associative_scan(combine, (a, bu), axis=1)
    y = jnp.einsum('ghp,bsgp->bsgh', c, states).real + d_skip.astype(f32).reshape(S5_GROUPS, S5_GROUP) * ug
    y = jax.nn.gelu(y.reshape(Bsz, S, S5_WIDTH))
    y = y * jax.nn.sigmoid(y @ glu_w.astype(f32) + glu_b.astype(f32))
    return y.astype(u.dtype)


def short_causal_conv(x, w):
    C = x.shape[-1]
    return lax.conv_general_dilated(x, w[:, None, :].astype(x.dtype), window_strides=(1,),
                                    padding=[(GDN_CONV - 1, 0)], dimension_numbers=('NWC', 'WIO', 'NWC'),
                                    feature_group_count=C)


def gated_delta_rule(q, k, v, g, beta):
    Bsz, S, H, dk = q.shape
    dv = v.shape[-1]
    C = GDN_CHUNK
    N = S // C

    def chunks(t):
        return t.reshape(Bsz, N, C, H, -1).transpose(1, 0, 3, 2, 4)

    qc, kc, vc = chunks(q), chunks(k), chunks(v)
    gc = g.reshape(Bsz, N, C, H).transpose(1, 0, 3, 2)
    bc = beta.reshape(Bsz, N, C, H).transpose(1, 0, 3, 2)
    gcum = jnp.cumsum(gc, axis=-1)
    incl = jnp.tril(jnp.ones((C, C), dtype=bool))
    strict = jnp.tril(jnp.ones((C, C), dtype=bool), -1)
    decay = jnp.exp(jnp.where(incl, gcum[..., :, None] - gcum[..., None, :], -jnp.inf))
    k_beta = kc * bc[..., None]
    a_mat = jnp.where(strict, jnp.einsum('nbhid,nbhjd->nbhij', k_beta, kc) * decay, 0.0)
    eye = jnp.eye(C, dtype=jnp.float32)
    t_mat = lax.linalg.triangular_solve(a_mat + eye, jnp.broadcast_to(eye, a_mat.shape),
                                        left_side=True, lower=True, unit_diagonal=True)
    u = t_mat @ (vc * bc[..., None])
    w = t_mat @ (k_beta * jnp.exp(gcum)[..., None])
    qk = jnp.einsum('nbhid,nbhjd->nbhij', qc, kc) * decay

    def step(state, inp):
        q_n, k_n, u_n, w_n, g_n, qk_n = inp
        v_new = u_n - w_n @ state
        o = (q_n * jnp.exp(g_n)[..., None]) @ state + qk_n @ v_new
        g_last = g_n[..., -1:]
        state = state * jnp.exp(g_last)[..., None] + jnp.einsum(
            'bhcd,bhce->bhde', k_n * jnp.exp(g_last - g_n)[..., None], v_new)
        return state, o

    state0 = jnp.zeros((Bsz, H, dk, dv), jnp.float32)
    _, o = lax.scan(step, state0, (qc, kc, u, w, gcum, qk))
    return o.transpose(1, 0, 3, 2, 4).reshape(Bsz, S, H, dv)


def gdn_mixer(qkv, z, a, b, conv_w, a_log, dt_bias, norm_w):
    Bsz, S, _ = qkv.shape
    f32 = jnp.float32
    qkv = jax.nn.silu(short_causal_conv(qkv, conv_w)).astype(f32)
    q, k, v = (t.reshape(Bsz, S, GDN_HEADS, GDN_HEAD_DIM) for t in jnp.split(qkv, 3, axis=-1))
    q = l2_norm(q) * GDN_HEAD_DIM ** -0.5
    k = l2_norm(k)
    beta = jax.nn.sigmoid(b.astype(f32))
    g = -jnp.exp(a_log.astype(f32)) * jax.nn.softplus(a.astype(f32) + dt_bias.astype(f32))
    o = gated_delta_rule(q, k, v, g, beta)
    o = rms_norm(o, norm_w) * jax.nn.silu(z.astype(f32).reshape(Bsz, S, GDN_HEADS, GDN_HEAD_DIM))
    return o.reshape(Bsz, S, GDN_WIDTH).astype(z.dtype)


def nsa_mixer(q, kv, gate_logits, q_norm, k_norm, cmp_pe, cmp_w1, cmp_w2, cos, sin):
    Bsz, S, _ = q.shape
    f32 = jnp.float32
    G, R, dh = NSA_KV_HEADS, NSA_HEADS // NSA_KV_HEADS, NSA_HEAD_DIM
    scale = dh ** -0.5
    q = rope(rms_norm(q.reshape(Bsz, S, NSA_HEADS, dh), q_norm), cos, sin)
    kc_raw, vc_raw, ks, vs, kw, vw = (t.reshape(Bsz, S, G, dh) for t in jnp.split(kv, 6, axis=-1))
    ks = rope(rms_norm(ks, k_norm[1]), cos, sin)
    kw = rope(rms_norm(kw, k_norm[2]), cos, sin)

    n_cmp = (S - CMP_LEN) // CMP_STRIDE + 1
    win_idx = jnp.arange(n_cmp)[:, None] * CMP_STRIDE + jnp.arange(CMP_LEN)[None, :]
    cmp_end = win_idx[:, -1]

    def compress(t, pe, w1, w2):
        blocks = t[:, win_idx] + pe[:, None, :]
        blocks = jnp.moveaxis(blocks, 3, 2).reshape(Bsz, n_cmp, G, CMP_LEN * dh)
        return jax.nn.gelu(blocks @ w1) @ w2

    cos_c, sin_c = rope_tables(cmp_end, dh)
    k_cmp = rope(rms_norm(compress(kc_raw, cmp_pe[0], cmp_w1[0], cmp_w2[0]), k_norm[0]), cos_c, sin_c)
    v_cmp = compress(vc_raw, cmp_pe[1], cmp_w1[1], cmp_w2[1])

    n_slc = S // SLC_BLOCK
    n_top = min(SLC_TOPK, n_slc)
    c0 = jnp.arange(n_cmp) * CMP_STRIDE
    s0 = jnp.arange(n_slc) * SLC_BLOCK
    overlap = jnp.clip(jnp.minimum(c0[:, None] + CMP_LEN, s0[None, :] + SLC_BLOCK)
                       - jnp.maximum(c0[:, None], s0[None, :]), 0, None).astype(f32) / CMP_LEN
    k_blocks = ks.reshape(Bsz, n_slc, SLC_BLOCK, G, dh).transpose(0, 3, 1, 2, 4)
    v_blocks = vs.reshape(Bsz, n_slc, SLC_BLOCK, G, dh).transpose(0, 3, 1, 2, 4)
    k_pad = jnp.pad(kw, ((0, 0), (WINDOW, 0), (0, 0), (0, 0)))
    v_pad = jnp.pad(vw, ((0, 0), (WINDOW, 0), (0, 0), (0, 0)))
    gates = jax.nn.sigmoid(gate_logits.astype(f32)).reshape(Bsz, S, G, R, 3)

    n_qb = S // Q_BLOCK
    qb = q.reshape(Bsz, n_qb, Q_BLOCK, G, R, dh).transpose(1, 0, 2, 3, 4, 5)
    gb = gates.reshape(Bsz, n_qb, Q_BLOCK, G, R, 3).transpose(1, 0, 2, 3, 4, 5)
    b_ix = jnp.arange(Bsz)[:, None, None, None]
    g_ix = jnp.arange(G)[None, None, :, None]
    j_ix = jnp.arange(n_slc)
    n_sel_keys = n_top * SLC_BLOCK

    def attend_block(args):
        q_blk, g_blk, blk = args
        t = blk * Q_BLOCK + jnp.arange(Q_BLOCK)
        s = jnp.einsum('bqgrd,bngd->bqgrn', q_blk, k_cmp).astype(f32) * scale
        valid = (cmp_end[None, :] <= t[:, None])[None, :, None, None, :]
        p_cmp = masked_softmax(s, valid)
        o_cmp = jnp.einsum('bqgrn,bngd->bqgrd', p_cmp.astype(v_cmp.dtype), v_cmp)
        imp = jnp.einsum('bqgrn,nj->bqgj', p_cmp, overlap)
        cur = (t // SLC_BLOCK)[:, None]
        forced = (j_ix[None, :] == 0) | (j_ix[None, :] == cur) | (j_ix[None, :] == cur - 1)
        started = s0[None, :] <= t[:, None]
        imp = jnp.where(forced[None, :, None, :], BIG, jnp.where(started[None, :, None, :], imp, -BIG))
        _, sel = lax.top_k(imp, n_top)
        k_sel = k_blocks[b_ix, g_ix, sel].reshape(Bsz, Q_BLOCK, G, n_sel_keys, dh)
        v_sel = v_blocks[b_ix, g_ix, sel].reshape(Bsz, Q_BLOCK, G, n_sel_keys, dh)
        pos = (sel[..., None] * SLC_BLOCK + jnp.arange(SLC_BLOCK)).reshape(Bsz, Q_BLOCK, G, n_sel_keys)
        s = jnp.einsum('bqgrd,bqgkd->bqgrk', q_blk, k_sel).astype(f32) * scale
        ok = (pos <= t[None, :, None, None])[:, :, :, None, :]
        p = masked_softmax(s, ok)
        o_slc = jnp.einsum('bqgrk,bqgkd->bqgrd', p.astype(v_sel.dtype), v_sel)
        k_win = lax.dynamic_slice_in_dim(k_pad, blk * Q_BLOCK, Q_BLOCK + WINDOW, axis=1)
        v_win = lax.dynamic_slice_in_dim(v_pad, blk * Q_BLOCK, Q_BLOCK + WINDOW, axis=1)
        kpos = blk * Q_BLOCK - WINDOW + jnp.arange(Q_BLOCK + WINDOW)
        diff = t[:, None] - kpos[None, :]
        in_win = (diff >= 0) & (diff < WINDOW) & (kpos[None, :] >= 0)
        s = jnp.einsum('bqgrd,bkgd->bqgrk', q_blk, k_win).astype(f32) * scale
        p = masked_softmax(s, in_win[None, :, None, None, :])
        o_win = jnp.einsum('bqgrk,bkgd->bqgrd', p.astype(v_win.dtype), v_win)
        o = g_blk[..., 0:1] * o_cmp + g_blk[..., 1:2] * o_slc + g_blk[..., 2:3] * o_win
        return o.astype(q_blk.dtype)

    out = lax.map(attend_block, (qb, gb, jnp.arange(n_qb)))
    return out.transpose(1, 0, 2, 3, 4, 5).reshape(Bsz, S, NSA_WIDTH)


def hybrid_mixer(a, w_in, lam_re, lam_im, b_re, b_im, c_re, c_im, s5_d, s5_log_dt, glu_w, glu_b,
                 s5_out_norm, conv_w, a_log, dt_bias, gdn_norm_w, q_norm, k_norm, cmp_pe, cmp_w1,
                 cmp_w2, nsa_out_norm, w_out, cos, sin):
    proj = a @ w_in
    u, qkv, z, ga, gb, q, kv, gate_logits = jnp.split(proj, np.cumsum(IN_SIZES)[:-1].tolist(), axis=-1)
    y_s5 = rms_norm(s5_mixer(u, lam_re, lam_im, b_re, b_im, c_re, c_im, s5_d, s5_log_dt, glu_w, glu_b), s5_out_norm)
    y_gdn = gdn_mixer(qkv, z, ga, gb, conv_w, a_log, dt_bias, gdn_norm_w)
    y_nsa = rms_norm(nsa_mixer(q, kv, gate_logits, q_norm, k_norm, cmp_pe, cmp_w1, cmp_w2, cos, sin), nsa_out_norm)
    return jnp.concatenate([y_s5, y_gdn.astype(y_s5.dtype), y_nsa.astype(y_s5.dtype)], axis=-1) @ w_out


def hier_moe(h, group_w, group_b, expert_w, expert_b, w_gate, w_up, w_down):
    Bsz, S, D = h.shape
    f32 = jnp.float32
    x = h.reshape(-1, D)
    T = x.shape[0]
    g_logits = (x @ group_w).astype(f32) + group_b.astype(f32)
    grp = jnp.argmax(g_logits, axis=-1)
    p_grp = jnp.take_along_axis(jax.nn.softmax(g_logits, axis=-1), grp[:, None], axis=-1)
    e_logits = ((x @ expert_w).astype(f32) + expert_b.astype(f32)).reshape(T, N_GROUPS, EXPERTS_PER_GROUP)
    e_logits = jnp.take_along_axis(e_logits, grp[:, None, None], axis=1)[:, 0]
    top_logit, top_local = lax.top_k(e_logits, TOP_K)
    weights = jax.nn.softmax(top_logit, axis=-1) * p_grp
    experts = grp[:, None] * EXPERTS_PER_GROUP + top_local
    n_assign = T * TOP_K
    e_flat = experts.reshape(-1)
    w_flat = weights.reshape(-1)
    tok_flat = jnp.repeat(jnp.arange(T, dtype=jnp.int32), TOP_K)
    order = jnp.argsort(e_flat)
    e_sorted = e_flat[order]
    counts = jnp.bincount(e_flat, length=N_EXPERTS)
    padded = (counts + MOE_BLOCK - 1) // MOE_BLOCK * MOE_BLOCK
    pad_start = jnp.cumsum(padded) - padded
    start = jnp.cumsum(counts) - counts
    dest = pad_start[e_sorted] + jnp.arange(n_assign) - start[e_sorted]
    n_blk = (n_assign + MOE_BLOCK - 1) // MOE_BLOCK + N_EXPERTS
    cap = n_blk * MOE_BLOCK
    slot_tok = jnp.full((cap,), T, jnp.int32).at[dest].set(tok_flat[order])
    slot_w = jnp.zeros((cap,), f32).at[dest].set(w_flat[order])
    blk_expert = jnp.minimum(jnp.searchsorted(jnp.cumsum(padded), jnp.arange(n_blk) * MOE_BLOCK, side='right'),
                             N_EXPERTS - 1)
    x_pad = jnp.concatenate([x, jnp.zeros((1, D), x.dtype)], axis=0)

    def expert_block(args):
        tok, wt, e = args
        xt = x_pad[tok]
        hid = jax.nn.silu(xt @ w_gate[e]) * (xt @ w_up[e])
        return (hid @ w_down[e]) * wt[:, None].astype(x.dtype)

    y = lax.map(expert_block, (slot_tok.reshape(n_blk, MOE_BLOCK), slot_w.reshape(n_blk, MOE_BLOCK), blk_expert))
    out = jnp.zeros((T + 1, D), y.dtype).at[slot_tok].add(y.reshape(cap, D))[:T]
    return out.reshape(Bsz, S, D).astype(h.dtype)


def setup_inputs(seed: int = 0) -> dict:
    key = jax.random.key(seed)
    ks = jax.random.split(key, 40)
    L, f32 = DEPTH, jnp.float32

    def nrm(k, shape, s):
        return s * jax.random.normal(k, shape, f32)

    def gain(k, shape):
        return 1.0 + 0.02 * jax.random.normal(k, shape, f32)

    log_dt_lo, log_dt_hi = math.log(1e-3), math.log(1e-1)
    gdn_dt = jnp.exp(jax.random.uniform(ks[15], (L, GDN_HEADS), f32, log_dt_lo, log_dt_hi))
    return {
        'x': jax.random.normal(ks[0], (BATCH, SEQ, D_MODEL), f32),
        'ln_mix': gain(ks[1], (L, D_MODEL)),
        'w_in': nrm(ks[2], (L, D_MODEL, D_IN), D_MODEL ** -0.5),
        's5_lambda_re': -0.5 + nrm(ks[3], (L, S5_GROUPS, S5_STATE), 0.01),
        's5_lambda_im': jnp.pi * jnp.arange(S5_STATE, dtype=f32) + nrm(ks[4], (L, S5_GROUPS, S5_STATE), 0.01),
        's5_b_re': nrm(ks[5], (L, S5_GROUPS, S5_STATE, S5_GROUP), (2 * S5_GROUP) ** -0.5),
        's5_b_im': nrm(ks[6], (L, S5_GROUPS, S5_STATE, S5_GROUP), (2 * S5_GROUP) ** -0.5),
        's5_c_re': nrm(ks[7], (L, S5_GROUPS, S5_GROUP, S5_STATE), S5_STATE ** -0.5),
        's5_c_im': nrm(ks[8], (L, S5_GROUPS, S5_GROUP, S5_STATE), S5_STATE ** -0.5),
        's5_d': nrm(ks[9], (L, S5_WIDTH), 0.5),
        's5_log_dt': jax.random.uniform(ks[10], (L, S5_GROUPS), f32, log_dt_lo, log_dt_hi),
        's5_glu_w': nrm(ks[11], (L, S5_WIDTH, S5_WIDTH), S5_WIDTH ** -0.5),
        's5_glu_b': nrm(ks[12], (L, S5_WIDTH), 0.01),
        's5_out_norm': gain(ks[13], (L, S5_WIDTH)),
        'gdn_conv_w': nrm(ks[14], (L, GDN_CONV, 3 * GDN_WIDTH), GDN_CONV ** -0.5),
        'gdn_a_log': jnp.log(jax.random.uniform(ks[16], (L, GDN_HEADS), f32, 1.0, 16.0)),
        'gdn_dt_bias': gdn_dt + jnp.log(-jnp.expm1(-gdn_dt)),
        'gdn_norm_w': gain(ks[17], (L, GDN_HEAD_DIM)),
        'nsa_q_norm': gain(ks[18], (L, NSA_HEAD_DIM)),
        'nsa_k_norm': gain(ks[19], (L, 3, NSA_HEAD_DIM)),
        'nsa_cmp_pe': nrm(ks[20], (L, 2, CMP_LEN, NSA_HEAD_DIM), 0.1),
        'nsa_cmp_w1': nrm(ks[21], (L, 2, CMP_LEN * NSA_HEAD_DIM, CMP_HIDDEN), (CMP_LEN * NSA_HEAD_DIM) ** -0.5),
        'nsa_cmp_w2': nrm(ks[22], (L, 2, CMP_HIDDEN, NSA_HEAD_DIM), CMP_HIDDEN ** -0.5),
        'nsa_out_norm': gain(ks[23], (L, NSA_WIDTH)),
        'w_out': nrm(ks[24], (L, D_MODEL, D_MODEL), D_MODEL ** -0.5),
        'ln_ffn': gain(ks[25], (L, D_MODEL)),
        'moe_group_w': nrm(ks[26], (L, D_MODEL, N_GROUPS), D_MODEL ** -0.5),
        'moe_group_b': nrm(ks[27], (L, N_GROUPS), 0.01),
        'moe_expert_w': nrm(ks[28], (L, D_MODEL, N_EXPERTS), D_MODEL ** -0.5),
        'moe_expert_b': nrm(ks[29], (L, N_EXPERTS), 0.01),
        'moe_w_gate': nrm(ks[30], (L, N_EXPERTS, D_MODEL, D_EXPERT), D_MODEL ** -0.5),
        'moe_w_up': nrm(ks[31], (L, N_EXPERTS, D_MODEL, D_EXPERT), D_MODEL ** -0.5),
        'moe_w_down': nrm(ks[32], (L, N_EXPERTS, D_EXPERT, D_MODEL), D_EXPERT ** -0.5),
    }


def reference(x, ln_mix, w_in, s5_lambda_re, s5_lambda_im, s5_b_re, s5_b_im, s5_c_re, s5_c_im, s5_d,
              s5_log_dt, s5_glu_w, s5_glu_b, s5_out_norm, gdn_conv_w, gdn_a_log, gdn_dt_bias, gdn_norm_w,
              nsa_q_norm, nsa_k_norm, nsa_cmp_pe, nsa_cmp_w1, nsa_cmp_w2, nsa_out_norm, w_out, ln_ffn,
              moe_group_w, moe_group_b, moe_expert_w, moe_expert_b, moe_w_gate, moe_w_up, moe_w_down):
    S = x.shape[1]
    cos, sin = rope_tables(jnp.arange(S), NSA_HEAD_DIM)
    for l in range(DEPTH):
        y = hybrid_mixer(rms_norm(x, ln_mix[l]), w_in[l], s5_lambda_re[l], s5_lambda_im[l], s5_b_re[l],
                         s5_b_im[l], s5_c_re[l], s5_c_im[l], s5_d[l], s5_log_dt[l], s5_glu_w[l], s5_glu_b[l],
                         s5_out_norm[l], gdn_conv_w[l], gdn_a_log[l], gdn_dt_bias[l], gdn_norm_w[l],
                         nsa_q_norm[l], nsa_k_norm[l], nsa_cmp_pe[l], nsa_cmp_w1[l], nsa_cmp_w2[l],
                         nsa_out_norm[l], w_out[l], cos, sin)
        h = x + y.astype(x.dtype)
        x = h + hier_moe(rms_norm(h, ln_ffn[l]), moe_group_w[l], moe_group_b[l], moe_expert_w[l],
                         moe_expert_b[l], moe_w_gate[l], moe_w_up[l], moe_w_down[l])
    return x
```

```cpp
#include <hip/hip_runtime.h>
#include <hip/hip_cooperative_groups.h>
#include <cstdio>
#include <cstdint>
namespace cg = cooperative_groups;

#define DI __device__ __forceinline__
extern "C" __device__ size_t __ockl_get_num_groups(unsigned);
#define LAS __attribute__((address_space(3)))
typedef unsigned short bf16_t;
typedef short bf16x8 __attribute__((ext_vector_type(8)));
typedef short s16x4 __attribute__((ext_vector_type(4)));
typedef float f32x4 __attribute__((ext_vector_type(4)));
typedef float f32x2 __attribute__((ext_vector_type(2)));
typedef float f32x16 __attribute__((ext_vector_type(16)));
typedef unsigned u32x4 __attribute__((ext_vector_type(4)));
typedef unsigned u32x2 __attribute__((ext_vector_type(2)));

constexpr int D = 2048, BATCH = 4, SEQ = 4096, T = BATCH * SEQ, DEPTH = 2;
constexpr int DIN = 5176, NPROJ = 5120, NPAD = 5376, NSMALL = 64;
constexpr int C_U = 0, C_QKV = 512, C_Z = 2048, C_NQ = 2560, C_NKV = 3584;
constexpr int NEXP = 32, DEXP = 512;
constexpr int MOE_TILES_MAX = 160;
constexpr int NCHUNK = 64;
constexpr int LDS_BYTES = 160 * 1024;
constexpr float EPS = 1e-6f;

struct Params {
    const float* in[33];
    float* out;
    bf16_t* WinT; bf16_t* WoutT; bf16_t* gluT; bf16_t* w1T; bf16_t* w2T; bf16_t* WguT; bf16_t* WdT; float* Wr;
    bf16_t* s5Bt; bf16_t* s5Ct; f32x2* s5lam; float* bias1; f32x2* rope;
    bf16_t* xb; float* rstd_mix; float* rstd_ffn; float* h; bf16_t* proj; float* small; bf16_t* mix;
    bf16_t* s5y; f32x2* s5E;
    bf16_t* qn; bf16_t* ksn; bf16_t* kwn; bf16_t* vsT; bf16_t* vwT; bf16_t* kcmp; bf16_t* vcmpT;
    bf16_t* gP; float* gRT; bf16_t* gQp; float* gOU; bf16_t* gST; float* gA;
    int* tok_list; float* w_list; int* tokinfo; int* cnt; bf16_t* hid; bf16_t* ybuf;
    unsigned* err;
};

typedef const __attribute__((address_space(4))) Params& CP;
enum { I_X = 0, I_LN_MIX, I_W_IN, I_LAM_RE, I_LAM_IM, I_B_RE, I_B_IM, I_C_RE, I_C_IM, I_S5D, I_S5LOGDT, I_GLU_W, I_GLU_B,
       I_S5NORM, I_CONV_W, I_A_LOG, I_DT_BIAS, I_GDN_NORM, I_QNORM, I_KNORM, I_CMP_PE, I_CMP_W1, I_CMP_W2, I_NSA_NORM,
       I_W_OUT, I_LN_FFN, I_GROUP_W, I_GROUP_B, I_EXPERT_W, I_EXPERT_B, I_W_GATE, I_W_UP, I_W_DOWN };

DI bf16_t f2bf(float x) { unsigned u = __float_as_uint(x); u += 0x7fffu + ((u >> 16) & 1u); return (bf16_t)(u >> 16); }
DI float bf2f(bf16_t x) { return __uint_as_float(((unsigned)x) << 16); }
DI unsigned pk2(float lo, float hi) { return (unsigned)f2bf(lo) | ((unsigned)f2bf(hi) << 16); }
DI float sigmoidf_(float x) { return 1.f / (1.f + __expf(-x)); }
DI float siluf_(float x) { return x / (1.f + __expf(-x)); }
DI float gelu_tanh(float x) { const float u = 0.7978845608028654f * (x + 0.044715f * x * x * x); const float e = __expf(2.f * u); const float th = 1.f - 2.f / (e + 1.f); return 0.5f * x * (1.f + th); }
DI float softplusf_(float x) { return x > 20.f ? x : log1pf(__expf(x)); }
DI int my_lane() { int l = (int)__builtin_amdgcn_mbcnt_hi(~0u, __builtin_amdgcn_mbcnt_lo(~0u, 0u)); asm volatile("" : "+v"(l)); return l; }
template <int M> DI float shflx(float v) {
    if constexpr (M < 32) return __builtin_bit_cast(float, __builtin_amdgcn_ds_swizzle(__builtin_bit_cast(int, v), 0x1f | (M << 10)));
    else return __builtin_bit_cast(float, __builtin_amdgcn_ds_bpermute((my_lane() ^ M) << 2, __builtin_bit_cast(int, v)));
}
DI int shfl_up_i(int v, int o, int lane) { return __builtin_amdgcn_ds_bpermute(((lane - o) & 63) << 2, v); }
DI float shfl_up_f(float v, int o, int lane) { return __builtin_bit_cast(float, __builtin_amdgcn_ds_bpermute(((lane - o) & 63) << 2, __builtin_bit_cast(int, v))); }
DI int shfl_idx_i(int v, int src) { return __builtin_amdgcn_ds_bpermute(src << 2, v); }
DI float wave_sum(float v) {
    v += shflx<1>(v); v += shflx<2>(v); v += shflx<4>(v); v += shflx<8>(v); v += shflx<16>(v); v += shflx<32>(v);
    return v;
}
DI int tidx() { int t = __builtin_amdgcn_workitem_id_x(); asm volatile("" : "+v"(t)); return t; }
DI int bidx() { int b = __builtin_amdgcn_workgroup_id_x(); asm volatile("" : "+s"(b)); return b; }
DI int gdim() { int g = (int)__ockl_get_num_groups(0); asm volatile("" : "+s"(g)); return g; }
DI void lds_wait() { asm volatile("s_waitcnt lgkmcnt(0)" ::: "memory"); }
#define SETTLE_NOPS "s_nop 15\n\ts_nop 15"
DI void settle(f32x4& a) { asm volatile(SETTLE_NOPS : "+v"(a)); }
DI void settle(f32x4& a, f32x4& b) { asm volatile(SETTLE_NOPS : "+v"(a), "+v"(b)); }
DI void settle(f32x4& a, f32x4& b, f32x4& c, f32x4& d) { asm volatile(SETTLE_NOPS : "+v"(a), "+v"(b), "+v"(c), "+v"(d)); }
DI void settle(f32x4& a, f32x4& b, f32x4& c, f32x4& d, f32x4& e, f32x4& f, f32x4& g, f32x4& h) { asm volatile(SETTLE_NOPS : "+v"(a), "+v"(b), "+v"(c), "+v"(d), "+v"(e), "+v"(f), "+v"(g), "+v"(h)); }
DI void settle(f32x16& a) { asm volatile(SETTLE_NOPS : "+v"(a)); }
DI void settle(f32x16& a, f32x16& b) { asm volatile(SETTLE_NOPS : "+v"(a), "+v"(b)); }
#define MFMA16(a, b, c) __builtin_amdgcn_mfma_f32_16x16x32_bf16((a), (b), (c), 0, 0, 0)
#define MFMA32(a, b, c) __builtin_amdgcn_mfma_f32_32x32x16_bf16((a), (b), (c), 0, 0, 0)

namespace g8 {
constexpr int BM = 256, BK = 64, HALF = 128, HT = HALF * BK;
DI int lds_byte(int r, int c) { int st = (r >> 4) * 2 + (c >> 5), rr = r & 15, cc = c & 31, ob = rr * 64 + cc * 2; return st * 1024 + (ob ^ (((ob >> 9) & 1) << 5)); }
DI void stage_rc(int b, int& R, int& C) { int st = b / 1024, sb = b % 1024, swz = sb ^ (((sb >> 9) & 1) << 5); R = (st >> 1) * 16 + swz / 64; C = (st & 1) * 32 + (swz % 64) / 2; }

template <class Epi>
DI void gemm_tile(LAS char* lds, const char* aBase, const unsigned (&aoff)[2][2], long akt, const char* bBase, const unsigned (&boff)[2], long bhalf, int nt, Epi&& epi) {
    const int tid = tidx(), wid = __builtin_amdgcn_readfirstlane(tid >> 6), lane = tid & 63, wr = wid >> 2, wc = wid & 3, fr = lane & 15, fq = lane >> 4;
    const unsigned ldsw = (unsigned)wid * 1024u;
    const int lrA = lds_byte(wr * 64 + fr, fq * 8), lrB = lds_byte(wc * 32 + fr, fq * 8);
#define G8_SA(b, h) (((b) * 2 + (h)) * (HT * 2))
#define G8_SB(b, h) ((4 + (b) * 2 + (h)) * (HT * 2))
#define G8_STAGE_A(bufoff, h, kt) do { const char* _b = aBase + (long)(kt) * akt; _Pragma("unroll") for (int _i = 0; _i < 2; ++_i) \
        __builtin_amdgcn_global_load_lds((const unsigned*)(_b + aoff[h][_i]), (LAS unsigned*)(lds + (bufoff) + ldsw + _i * 8192), 16, 0, 0); } while (0)
#define G8_STAGE_B(bufoff, h, kt) do { const char* _b = bBase + (long)(h) * bhalf + (long)(kt) * 128; _Pragma("unroll") for (int _i = 0; _i < 2; ++_i) \
        __builtin_amdgcn_global_load_lds((const unsigned*)(_b + boff[_i]), (LAS unsigned*)(lds + (bufoff) + ldsw + _i * 8192), 16, 0, 0); } while (0)
#define G8_LDA(dst, b, h) do { _Pragma("unroll") for (int m = 0; m < 4; ++m) _Pragma("unroll") for (int k = 0; k < 2; ++k) dst[m][k] = *(const LAS bf16x8*)(lds + G8_SA(b, h) + lrA + m * 2048 + k * 1024); } while (0)
#define G8_LDB(dst, b, h) do { _Pragma("unroll") for (int n = 0; n < 2; ++n) _Pragma("unroll") for (int k = 0; k < 2; ++k) dst[n][k] = *(const LAS bf16x8*)(lds + G8_SB(b, h) + lrB + n * 2048 + k * 1024); } while (0)
#define G8_MMA(ai, bj, At, Bt) do { __builtin_amdgcn_s_setprio(1); _Pragma("unroll") for (int m = 0; m < 4; ++m) _Pragma("unroll") for (int n = 0; n < 2; ++n) _Pragma("unroll") for (int k = 0; k < 2; ++k) \
        acc[ai][bj][m][n] = MFMA16(Bt[n][k], At[m][k], acc[ai][bj][m][n]); __builtin_amdgcn_s_setprio(0); } while (0)
#define G8_WAIT_V(n) asm volatile("s_waitcnt vmcnt(" #n ")" ::: "memory")
#define G8_WAIT_L(n) asm volatile("s_waitcnt lgkmcnt(" #n ")" ::: "memory")
#define G8_BAR __builtin_amdgcn_s_barrier()
#define G8_SCHED __builtin_amdgcn_sched_barrier(0)
    f32x4 acc[2][2][4][2];
#pragma unroll
    for (int a = 0; a < 2; ++a)
#pragma unroll
        for (int b = 0; b < 2; ++b)
#pragma unroll
            for (int m = 0; m < 4; ++m)
#pragma unroll
                for (int n = 0; n < 2; ++n) acc[a][b][m][n] = (f32x4){0.f, 0.f, 0.f, 0.f};
    bf16x8 At[4][2], B0[2][2], B1[2][2];
    G8_STAGE_B(G8_SB(0, 0), 0, 0); G8_STAGE_A(G8_SA(0, 0), 0, 0); G8_STAGE_B(G8_SB(0, 1), 1, 0); G8_STAGE_A(G8_SA(0, 1), 1, 0);
    if (wr == 1) G8_BAR;
    G8_WAIT_V(4); G8_BAR;
    G8_STAGE_B(G8_SB(1, 0), 0, 1); G8_STAGE_A(G8_SA(1, 0), 0, 1); G8_STAGE_B(G8_SB(1, 1), 1, 1);
    G8_WAIT_V(6); G8_BAR;
    for (int t = 0; t < nt - 2; t += 2) {
        G8_LDB(B0, 0, 0); G8_SCHED; G8_LDA(At, 0, 0); G8_STAGE_A(G8_SA(1, 1), 1, t + 1);
        G8_WAIT_L(8); G8_BAR; G8_WAIT_L(0); G8_MMA(0, 0, At, B0); G8_BAR; G8_SCHED;
        G8_LDB(B1, 0, 1); G8_STAGE_B(G8_SB(0, 0), 0, t + 2);
        G8_BAR; G8_WAIT_L(0); G8_MMA(0, 1, At, B1); G8_BAR;
        G8_LDA(At, 0, 1); G8_STAGE_A(G8_SA(0, 0), 0, t + 2);
        G8_BAR; G8_WAIT_L(0); G8_MMA(1, 0, At, B0); G8_BAR; G8_SCHED;
        G8_STAGE_B(G8_SB(0, 1), 1, t + 2);
        G8_WAIT_V(6); G8_BAR; G8_MMA(1, 1, At, B1); G8_BAR;
        G8_LDB(B0, 1, 0); G8_SCHED; G8_LDA(At, 1, 0); G8_STAGE_A(G8_SA(0, 1), 1, t + 2);
        G8_WAIT_L(8); G8_BAR; G8_WAIT_L(0); G8_MMA(0, 0, At, B0); G8_BAR; G8_SCHED;
        G8_LDB(B1, 1, 1); G8_STAGE_B(G8_SB(1, 0), 0, t + 3);
        G8_BAR; G8_WAIT_L(0); G8_MMA(0, 1, At, B1); G8_BAR;
        G8_LDA(At, 1, 1); G8_STAGE_A(G8_SA(1, 0), 0, t + 3);
        G8_BAR; G8_WAIT_L(0); G8_MMA(1, 0, At, B0); G8_BAR; G8_SCHED;
        G8_STAGE_B(G8_SB(1, 1), 1, t + 3);
        G8_WAIT_V(6); G8_BAR; G8_MMA(1, 1, At, B1); G8_BAR;
    }
    { G8_LDB(B0, 0, 0); G8_LDA(At, 0, 0); G8_STAGE_A(G8_SA(1, 1), 1, nt - 1);
      G8_BAR; G8_WAIT_L(0); G8_MMA(0, 0, At, B0); G8_BAR;
      G8_LDB(B1, 0, 1); G8_BAR; G8_WAIT_L(0); G8_MMA(0, 1, At, B1); G8_BAR;
      G8_LDA(At, 0, 1); G8_WAIT_V(4); G8_BAR; G8_WAIT_L(0); G8_MMA(1, 0, At, B0); G8_MMA(1, 1, At, B1); G8_BAR; }
    { G8_LDB(B0, 1, 0); G8_LDA(At, 1, 0); G8_WAIT_V(2); G8_BAR; G8_WAIT_L(0); G8_MMA(0, 0, At, B0); G8_BAR;
      G8_LDB(B1, 1, 1); G8_WAIT_V(0); G8_BAR; G8_WAIT_L(0); G8_MMA(0, 1, At, B1); G8_BAR;
      G8_LDA(At, 1, 1); G8_BAR; G8_WAIT_L(0); G8_MMA(1, 0, At, B0); G8_MMA(1, 1, At, B1); G8_BAR; }
    if (wr == 0) G8_BAR;
    asm volatile(SETTLE_NOPS : "+v"(acc[0][0][0][0]), "+v"(acc[0][0][0][1]), "+v"(acc[0][0][1][0]), "+v"(acc[0][0][1][1]), "+v"(acc[0][0][2][0]), "+v"(acc[0][0][2][1]), "+v"(acc[0][0][3][0]), "+v"(acc[0][0][3][1]),
                 "+v"(acc[0][1][0][0]), "+v"(acc[0][1][0][1]), "+v"(acc[0][1][1][0]), "+v"(acc[0][1][1][1]), "+v"(acc[0][1][2][0]), "+v"(acc[0][1][2][1]), "+v"(acc[0][1][3][0]), "+v"(acc[0][1][3][1]));
    asm volatile("" : "+v"(acc[1][0][0][0]), "+v"(acc[1][0][0][1]), "+v"(acc[1][0][1][0]), "+v"(acc[1][0][1][1]), "+v"(acc[1][0][2][0]), "+v"(acc[1][0][2][1]), "+v"(acc[1][0][3][0]), "+v"(acc[1][0][3][1]),
                 "+v"(acc[1][1][0][0]), "+v"(acc[1][1][0][1]), "+v"(acc[1][1][1][0]), "+v"(acc[1][1][1][1]), "+v"(acc[1][1][2][0]), "+v"(acc[1][1][2][1]), "+v"(acc[1][1][3][0]), "+v"(acc[1][1][3][1]));
    epi(acc, wr * 64 + fr, wc * 32 + 4 * fq);
#undef G8_SA
#undef G8_SB
#undef G8_STAGE_A
#undef G8_STAGE_B
#undef G8_LDA
#undef G8_LDB
#undef G8_MMA
}
DI void my_rc(int i, int& R, int& C) { stage_rc(tidx() * 16 + i * 8192, R, C); }
DI bool unit_of(int L, int nM, int nN, int& pm, int& pn) {
    const int nwg = nM * nN; if (L >= nwg) return false;
    int wgid = L; { const int q = nwg / 8, r = nwg % 8, xcd = wgid % 8, off = wgid / 8; wgid = (xcd < r ? xcd * (q + 1) : r * (q + 1) + (xcd - r) * q) + off; }
    const int nig = 8 * nN, gid = wgid / nig, fm = gid * 8, gsz = (nM - fm) < 8 ? (nM - fm) : 8;
    pm = fm + ((wgid % nig) % gsz); pn = (wgid % nig) / gsz; return true;
}
}

typedef f32x4 Acc[2][2][4][2];
#define ACC_FOR(ai, m, bj, n) _Pragma("unroll") for (int ai = 0; ai < 2; ++ai) _Pragma("unroll") for (int m = 0; m < 4; ++m) _Pragma("unroll") for (int bj = 0; bj < 2; ++bj) _Pragma("unroll") for (int n = 0; n < 2; ++n)

DI void tconv_tile(LAS float* scr, const float* src, long src_ld, bf16_t* dst, long dst_ld, int nvalid, const float* kscale) {
    const int tid = tidx();
#pragma unroll
    for (int i = 0; i < 8; ++i) { const int e = tid + i * 512, kk = e >> 6, nn = e & 63; float v = 0.f; if (nn < nvalid) v = src[(long)kk * src_ld + nn]; if (kscale) v *= kscale[kk]; scr[kk * 65 + nn] = v; }
    __syncthreads();
    { const int nn = tid >> 3, c = tid & 7;
      if (nn < nvalid) { u32x4 o; const LAS float* s = scr + (8 * c) * 65 + nn;
          o.x = pk2(s[0], s[65]); o.y = pk2(s[2 * 65], s[3 * 65]); o.z = pk2(s[4 * 65], s[5 * 65]); o.w = pk2(s[6 * 65], s[7 * 65]);
          *(u32x4*)(dst + (long)nn * dst_ld + 8 * c) = o; } }
    __syncthreads();
}
DI void tconv_job(LAS float* scr, int& base, const float* src, long src_ld, bf16_t* dst, long dst_ld, int K, int N, const float* kscale) {
    const int nkt = K / 64, nnt = (N + 63) / 64, ntile = nkt * nnt, G = gdim();
    const int first = ((int)bidx() - base % G + G) % G;
    for (int tl = first; tl < ntile; tl += G) { const int kt = tl % nkt, ntl = tl / nkt; const int nv = min(64, N - ntl * 64);
        tconv_tile(scr, src + (long)kt * 64 * src_ld + ntl * 64, src_ld, dst + (long)ntl * 64 * dst_ld + kt * 64, dst_ld, nv, kscale ? kscale + kt * 64 : nullptr); }
    base += ntile;
}
DI void p0_convert(CP p, int l, LAS char* lds) {
    LAS float* scr = (LAS float*)lds; int base = 0;
    const float* win = p.in[I_W_IN] + (long)l * D * DIN; const float* lnm = p.in[I_LN_MIX] + l * D;
    tconv_job(scr, base, win, DIN, p.WinT, D, D, 2560, lnm);
    tconv_job(scr, base, win + 2568, DIN, p.WinT + 2560L * D, D, D, 2560, lnm);
    tconv_job(scr, base, win + 2560, DIN, p.WinT + 5120L * D, D, D, 8, lnm);
    tconv_job(scr, base, win + 5128, DIN, p.WinT + 5128L * D, D, D, 48, lnm);
    tconv_job(scr, base, p.in[I_W_OUT] + (long)l * D * D, D, p.WoutT, D, D, D, nullptr);
    tconv_job(scr, base, p.in[I_GLU_W] + (long)l * 512 * 512, 512, p.gluT, 512, 512, 512, nullptr);
    for (int kv = 0; kv < 2; ++kv) {
        tconv_job(scr, base, p.in[I_CMP_W1] + (long)(l * 2 + kv) * 2048 * 256, 256, p.w1T + (long)kv * 256 * 2048, 2048, 2048, 256, nullptr);
        tconv_job(scr, base, p.in[I_CMP_W2] + (long)(l * 2 + kv) * 256 * 64, 64, p.w2T + (long)kv * 64 * 256, 256, 256, 64, nullptr);
    }
    const float* lnf = p.in[I_LN_FFN] + l * D;
    for (int e = 0; e < NEXP; ++e)
        for (int which = 0; which < 2; ++which)
            for (int grp = 0; grp < 4; ++grp) {
                const float* src = p.in[which ? I_W_UP : I_W_GATE] + (long)(l * NEXP + e) * D * DEXP + grp * 128;
                bf16_t* dst = p.WguT + ((long)e * 1024 + grp * 256 + which * 128) * D;
                tconv_job(scr, base, src, DEXP, dst, D, D, 128, lnf);
            }
    for (int e = 0; e < NEXP; ++e)
        tconv_job(scr, base, p.in[I_W_DOWN] + (long)(l * NEXP + e) * DEXP * D, D, p.WdT + (long)e * D * DEXP, DEXP, DEXP, D, nullptr);
    const long gtid = (long)bidx() * 512 + tidx(), nth = (long)gdim() * 512;
    { unsigned* z = (unsigned*)(p.WinT + (long)DIN * D); for (long i = gtid; i < (long)(NPAD - DIN) * D / 2; i += nth) z[i] = 0u; }
    for (long i = gtid; i < 48L * D; i += nth) { const int n = (int)(i / D), k = (int)(i % D); float v = 0.f;
        if (n < 4) v = p.in[I_GROUP_W][((long)l * D + k) * 4 + n]; else if (n < 36) v = p.in[I_EXPERT_W][((long)l * D + k) * 32 + (n - 4)];
        p.Wr[i] = v * lnf[k]; }
    for (long i = gtid; i < 32 * 64; i += nth) { const int g = (int)(i >> 6), pp = (int)(i & 63);
        const float a = p.in[I_LAM_RE][(l * 32 + g) * 64 + pp], w = p.in[I_LAM_IM][(l * 32 + g) * 64 + pp], dt = __expf(p.in[I_S5LOGDT][l * 32 + g]);
        const float ea = expf(a * dt); float sn, cs; sincosf(w * dt, &sn, &cs);
        const float lr = ea * cs, li = ea * sn;
        const float sh = sinf(0.5f * w * dt); const float lr1 = expm1f(a * dt) * cs - 2.f * sh * sh;
        const float den = 1.f / (a * a + w * w);
        const float cr = (lr1 * a + li * w) * den, ci = (li * a - lr1 * w) * den;
        p.s5lam[g * 64 + pp] = (f32x2){lr, li};
        { const float e64 = expf(a * dt * 64.f); float s6, c6; sincosf(w * dt * 64.f, &s6, &c6); p.s5lam[2048 + g * 64 + pp] = (f32x2){e64 * c6, e64 * s6}; }
        for (int hh = 0; hh < 16; ++hh) {
            const float br = p.in[I_B_RE][((long)(l * 32 + g) * 64 + pp) * 16 + hh], bi = p.in[I_B_IM][((long)(l * 32 + g) * 64 + pp) * 16 + hh];
            p.s5Bt[((long)g * 128 + pp) * 32 + hh] = f2bf(cr * br - ci * bi); p.s5Bt[((long)g * 128 + pp) * 32 + 16 + hh] = 0;
            p.s5Bt[((long)g * 128 + 64 + pp) * 32 + hh] = f2bf(cr * bi + ci * br); p.s5Bt[((long)g * 128 + 64 + pp) * 32 + 16 + hh] = 0;
            p.s5Ct[((long)g * 16 + hh) * 128 + pp] = f2bf(p.in[I_C_RE][((long)(l * 32 + g) * 16 + hh) * 64 + pp]);
            p.s5Ct[((long)g * 16 + hh) * 128 + 64 + pp] = f2bf(-p.in[I_C_IM][((long)(l * 32 + g) * 16 + hh) * 64 + pp]);
        }
    }
    {
        const int gw = bidx() * 8 + __builtin_amdgcn_readfirstlane(tidx() >> 6), nw = gdim() * 8, lane = tidx() & 63;
        for (int o = gw; o < 512; o += nw) { const int kv = o >> 8, n = o & 255; float s = 0.f;
            const float* pe = p.in[I_CMP_PE] + (long)(l * 2 + kv) * 2048; const float* w1 = p.in[I_CMP_W1] + (long)(l * 2 + kv) * 2048 * 256 + n;
            for (int k = lane; k < 2048; k += 64) s += pe[k] * w1[(long)k * 256];
            s = wave_sum(s); if (lane == 0) p.bias1[o] = s; }
    }
}
DI void p0_once(CP p) {
    const long gtid = (long)bidx() * 512 + tidx(), nth = (long)gdim() * 512;
    for (long i = gtid; i < 4096L * 32; i += nth) { const int pos = (int)(i >> 5), k = (int)(i & 31);
        const float invf = exp2f(-(float)k * (13.287712379549449f / 32.f)); const float ang = (float)pos * invf; float s, c; sincosf(ang, &s, &c); p.rope[i] = (f32x2){c, s}; }
    for (long i = gtid; i < 256; i += nth) p.cnt[i] = 0;
}

DI void p1_rows(CP p, int mode, int lprev) {
    const int lane = tidx() & 63, gw = bidx() * 8 + __builtin_amdgcn_readfirstlane(tidx() >> 6), nw = gdim() * 8;
    int ts = 0;
    if (mode > 0) { int c = lane < 32 ? p.cnt[lprev * 32 + lane] : 0; int ntl = (c + 255) >> 8; int inc = ntl;
#pragma unroll
        for (int o = 1; o < 32; o <<= 1) { int v = shfl_up_i(inc, o, lane); if ((lane & 31) >= o) inc += v; }
        ts = inc - ntl; }
    for (int t = gw; t < T; t += nw) {
        f32x4 v[8]; float ss = 0.f;
        if (mode == 0) {
            const f32x4* xr = (const f32x4*)(p.in[I_X] + (long)t * D);
#pragma unroll
            for (int j = 0; j < 8; ++j) v[j] = xr[j * 64 + lane];
        } else {
            const int* ti = p.tokinfo + (long)t * 4; const int e0 = ti[0], p0 = ti[1], e1 = ti[2], p1 = ti[3];
            const long s0 = (long)shfl_idx_i(ts, e0) * 256 + p0, s1 = (long)shfl_idx_i(ts, e1) * 256 + p1;
            const f32x4* hr = (const f32x4*)(p.h + (long)t * D);
            const u32x2* y0 = (const u32x2*)(p.ybuf + s0 * D); const u32x2* y1 = (const u32x2*)(p.ybuf + s1 * D);
#pragma unroll
            for (int j = 0; j < 8; ++j) { f32x4 a = hr[j * 64 + lane]; const u32x2 b0 = y0[j * 64 + lane], b1 = y1[j * 64 + lane];
                a[0] += __uint_as_float(b0.x << 16) + __uint_as_float(b1.x << 16); a[1] += __uint_as_float(b0.x & 0xffff0000u) + __uint_as_float(b1.x & 0xffff0000u);
                a[2] += __uint_as_float(b0.y << 16) + __uint_as_float(b1.y << 16); a[3] += __uint_as_float(b0.y & 0xffff0000u) + __uint_as_float(b1.y & 0xffff0000u);
                v[j] = a; }
        }
        if (mode >= 1) { f32x4* o = (f32x4*)(p.out + (long)t * D);
#pragma unroll
            for (int j = 0; j < 8; ++j) o[j * 64 + lane] = v[j]; }
        if (mode <= 1) {
#pragma unroll
            for (int j = 0; j < 8; ++j) ss += v[j][0] * v[j][0] + v[j][1] * v[j][1] + v[j][2] * v[j][2] + v[j][3] * v[j][3];
            ss = wave_sum(ss);
            if (lane == 0) p.rstd_mix[t] = rsqrtf(ss * (1.f / D) + EPS);
            u32x2* xo = (u32x2*)(p.xb + (long)t * D);
#pragma unroll
            for (int j = 0; j < 8; ++j) { u32x2 w; w.x = pk2(v[j][0], v[j][1]); w.y = pk2(v[j][2], v[j][3]); xo[j * 64 + lane] = w; }
        }
    }
}

DI void p2_inproj(CP p, LAS char* lds) {
    unsigned aoff[2][2], boff[2];
#pragma unroll
    for (int i = 0; i < 2; ++i) { int R, C; g8::my_rc(i, R, C); boff[i] = (unsigned)(R * D + C) * 2u; aoff[0][i] = boff[i]; aoff[1][i] = (unsigned)((128 + R) * D + C) * 2u; }
    for (int u = bidx();; u += gdim()) {
        int pm, pn; if (!g8::unit_of(u, T / 256, NPAD / 256, pm, pn)) break;
        const float* rs = p.rstd_mix + pm * 256; bf16_t* proj = p.proj; float* sm = p.small;
        g8::gemm_tile(lds, (const char*)(p.xb + (long)pm * 256 * D), aoff, 128, (const char*)(p.WinT + (long)pn * 256 * D), boff, 128L * D * 2, D / 64, [&](const Acc& acc, int rb, int cb) {
            ACC_FOR(ai, m, bj, n) { const int r = ai * 128 + m * 16 + rb, c = bj * 128 + n * 16 + cb; const long row = pm * 256 + r;
                f32x4 v = acc[ai][bj][m][n] * rs[r];
                if (pn < 20) { u32x2 w; w.x = pk2(v[0], v[1]); w.y = pk2(v[2], v[3]); *(u32x2*)(proj + row * NPROJ + pn * 256 + c) = w; }
                else if (c < 56) *(f32x4*)(sm + row * NSMALL + c) = v; }
        });
    }
}

DI void s5_item(CP p, int l, int item, int pass, LAS char* wl) {
    const int lane = tidx() & 63, fr = lane & 15, fq = lane >> 4;
    item = __builtin_amdgcn_readfirstlane(item);
    const int g = item & 31, c = (item >> 5) & 63, b = item >> 11;
    LAS float* BU = (LAS float*)wl;
    LAS bf16_t* X = (LAS bf16_t*)(wl + 8192);
    const f32x2 lam = p.s5lam[g * 64 + lane];
    float sre = 0.f, sim = 0.f;
    if (pass == 2) { const f32x2 l64 = p.s5lam[2048 + g * 64 + lane]; const f32x2* E = p.s5E + ((long)(b * 64) * 32 + g) * 64 + lane;
        for (int cc = 0; cc < c; ++cc) { const f32x2 e = E[(long)cc * 32 * 64]; const float nr = l64.x * sre - l64.y * sim + e.x, ni = l64.x * sim + l64.y * sre + e.y; sre = nr; sim = ni; } }
    bf16x8 bfr[8], cfr[4];
#pragma unroll
    for (int nb = 0; nb < 8; ++nb) bfr[nb] = *(const bf16x8*)(p.s5Bt + ((long)g * 128 + nb * 16 + fr) * 32 + 8 * fq);
    if (pass == 2) {
#pragma unroll
        for (int ks = 0; ks < 4; ++ks) cfr[ks] = *(const bf16x8*)(p.s5Ct + ((long)g * 16 + fr) * 128 + ks * 32 + 8 * fq);
    }
    const long tok0 = (long)b * SEQ + c * 64;
    const float dsk = p.in[I_S5D][l * 512 + g * 16 + fr];
    for (int sub = 0; sub < 4; ++sub) {
        const long tb = tok0 + sub * 16;
        const bf16x8 afr = *(const bf16x8*)(p.proj + (tb + fr) * NPROJ + C_U + g * 16 + 8 * (fq & 1));
        f32x4 accs[8];
#pragma unroll
        for (int nb = 0; nb < 8; ++nb) { accs[nb] = (f32x4){0.f, 0.f, 0.f, 0.f}; accs[nb] = MFMA16(afr, bfr[nb], accs[nb]); }
        settle(accs[0], accs[1], accs[2], accs[3], accs[4], accs[5], accs[6], accs[7]);
#pragma unroll
        for (int nb = 0; nb < 8; ++nb)
#pragma unroll
            for (int j = 0; j < 4; ++j) BU[(4 * fq + j) * 128 + nb * 16 + fr] = accs[nb][j];
        lds_wait();
#pragma unroll
        for (int tt = 0; tt < 16; ++tt) { const float br = BU[tt * 128 + lane], bi = BU[tt * 128 + 64 + lane];
            const float nr = lam.x * sre - lam.y * sim + br, ni = lam.x * sim + lam.y * sre + bi; sre = nr; sim = ni;
            if (pass == 2) { X[tt * 136 + lane] = f2bf(sre); X[tt * 136 + 64 + lane] = f2bf(sim); } }
        if (pass == 2) {
            lds_wait();
            f32x4 acc = {0.f, 0.f, 0.f, 0.f};
            bf16x8 xa[4];
#pragma unroll
            for (int ks = 0; ks < 4; ++ks) xa[ks] = *(const LAS bf16x8*)(X + fr * 136 + ks * 32 + 8 * fq);
            lds_wait();
#pragma unroll
            for (int ks = 0; ks < 4; ++ks) acc = MFMA16(xa[ks], cfr[ks], acc);
            settle(acc);
            asm volatile("" :: "v"(xa[0]), "v"(xa[1]), "v"(xa[2]), "v"(xa[3]));
#pragma unroll
            for (int j = 0; j < 4; ++j) { const long tk = tb + 4 * fq + j; const float u = bf2f(p.proj[tk * NPROJ + C_U + g * 16 + fr]);
                p.s5y[tk * 512 + g * 16 + fr] = f2bf(gelu_tanh(acc[j] + dsk * u)); }
        }
        lds_wait();
    }
    if (pass == 1) { p.s5E[((long)(b * 64 + c) * 32 + g) * 64 + lane] = (f32x2){sre, sim};
#ifdef DBG_E2
        ((f32x2*)p.gRT)[((long)(b * 64 + c) * 32 + g) * 64 + lane] = (f32x2){sre, sim};
#endif
    }
}
DI bf16x8 ld8(const bf16_t* q) { return *(const bf16x8*)q; }
DI bf16x8 ld8(const LAS bf16_t* q) { return *(const LAS bf16x8*)q; }
template <int KS, class PA, class PB>
DI f32x4 mma_tile(PA arow, PB brow, f32x4 acc) {
#pragma unroll
    for (int ks = 0; ks < KS; ++ks) acc = MFMA16(ld8(arow + ks * 32), ld8(brow + ks * 32), acc);
    settle(acc);
    return acc;
}
#define ZERO4 ((f32x4){0.f, 0.f, 0.f, 0.f})

constexpr int GP_QG = 0, GP_KN = 17408, GP_KB = 34816, GP_QN = 52224, GP_VBT = 69632, GP_KBGT = 88064, GP_KGT = 106496, GP_AM = 124928, GP_QK = 142336, GP_GT = 151552;
constexpr int GP_TM = 17408, GP_UT = 26624, GP_WT = 45056;
constexpr int SK = 136, ST = 72, SA = 68;

DI void gdn_prep_item(CP p, int l, int item, LAS char* lds) {
    const int tid = tidx(), lane = tid & 63, w = __builtin_amdgcn_readfirstlane(tid >> 6), fr = lane & 15, fq = lane >> 4;
    const int n = item & 63, h = (item >> 6) & 3, b = item >> 8;
    const long tok0 = (long)b * SEQ + n * 64;
    LAS bf16_t* Qg = (LAS bf16_t*)(lds + GP_QG); LAS bf16_t* Kn = (LAS bf16_t*)(lds + GP_KN); LAS bf16_t* Kb = (LAS bf16_t*)(lds + GP_KB); LAS bf16_t* Qn = (LAS bf16_t*)(lds + GP_QN);
    LAS bf16_t* VbT = (LAS bf16_t*)(lds + GP_VBT); LAS bf16_t* KbgT = (LAS bf16_t*)(lds + GP_KBGT); LAS bf16_t* KgT = (LAS bf16_t*)(lds + GP_KGT);
    LAS float* Am = (LAS float*)(lds + GP_AM); LAS bf16_t* QKm = (LAS bf16_t*)(lds + GP_QK); LAS float* gts = (LAS float*)(lds + GP_GT);
    LAS bf16_t* Tm = (LAS bf16_t*)(lds + GP_TM); LAS bf16_t* UT = (LAS bf16_t*)(lds + GP_UT); LAS bf16_t* WT = (LAS bf16_t*)(lds + GP_WT);
    if (tid < 64) {
        const float a = p.small[(tok0 + tid) * NSMALL + h], bb = p.small[(tok0 + tid) * NSMALL + 4 + h];
        const float g = -expf(p.in[I_A_LOG][l * 4 + h]) * softplusf_(a + p.in[I_DT_BIAS][l * 4 + h]);
        float inc = g;
#pragma unroll
        for (int o = 1; o < 64; o <<= 1) { const float v = shfl_up_f(inc, o, lane); if (lane >= o) inc += v; }
        gts[tid] = inc; gts[64 + tid] = sigmoidf_(bb);
    }
    __syncthreads();
    {
        const int i = tid >> 3, sub = tid & 7;
        const float gc = gts[i], beta = gts[64 + i], glast = gts[63];
        const float eg = __expf(gc), egl = __expf(glast - gc);
        const int spos = n * 64 + i;
#pragma unroll
        for (int which = 0; which < 3; ++which) {
            const int cbase = which * 512 + h * 128 + sub * 16;
            float o[16];
#pragma unroll
            for (int cc = 0; cc < 16; ++cc) o[cc] = 0.f;
#pragma unroll
            for (int j = 0; j < 4; ++j) {
                if (spos - 3 + j >= 0) {
                    const bf16_t* xr = p.proj + (tok0 + i - 3 + j) * NPROJ + C_QKV + cbase;
                    const bf16x8 x0 = ld8(xr), x1 = ld8(xr + 8);
                    const float* wr_ = p.in[I_CONV_W] + (long)(l * 4 + j) * 1536 + cbase;
#pragma unroll
                    for (int cc = 0; cc < 8; ++cc) { o[cc] += wr_[cc] * bf2f((bf16_t)x0[cc]); o[8 + cc] += wr_[8 + cc] * bf2f((bf16_t)x1[cc]); }
                }
            }
            float ss = 0.f;
#pragma unroll
            for (int cc = 0; cc < 16; ++cc) { o[cc] = siluf_(o[cc]); ss += o[cc] * o[cc]; }
            ss += shflx<1>(ss); ss += shflx<2>(ss); ss += shflx<4>(ss);
            if (which == 0) {
                const float sc = rsqrtf(ss + 1e-6f) * 0.08838834764831845f;
                u32x4 a0, a1, b0, b1;
#pragma unroll
                for (int cc = 0; cc < 4; ++cc) { a0[cc] = pk2(o[2 * cc] * sc, o[2 * cc + 1] * sc); a1[cc] = pk2(o[8 + 2 * cc] * sc, o[9 + 2 * cc] * sc);
                    b0[cc] = pk2(o[2 * cc] * sc * eg, o[2 * cc + 1] * sc * eg); b1[cc] = pk2(o[8 + 2 * cc] * sc * eg, o[9 + 2 * cc] * sc * eg); }
                *(LAS u32x4*)(Qn + i * SK + sub * 16) = a0; *(LAS u32x4*)(Qn + i * SK + sub * 16 + 8) = a1;
                *(LAS u32x4*)(Qg + i * SK + sub * 16) = b0; *(LAS u32x4*)(Qg + i * SK + sub * 16 + 8) = b1;
            } else if (which == 1) {
                const float sc = rsqrtf(ss + 1e-6f);
                u32x4 a0, a1, b0, b1;
#pragma unroll
                for (int cc = 0; cc < 4; ++cc) { a0[cc] = pk2(o[2 * cc] * sc, o[2 * cc + 1] * sc); a1[cc] = pk2(o[8 + 2 * cc] * sc, o[9 + 2 * cc] * sc);
                    b0[cc] = pk2(o[2 * cc] * sc * beta, o[2 * cc + 1] * sc * beta); b1[cc] = pk2(o[8 + 2 * cc] * sc * beta, o[9 + 2 * cc] * sc * beta); }
                *(LAS u32x4*)(Kn + i * SK + sub * 16) = a0; *(LAS u32x4*)(Kn + i * SK + sub * 16 + 8) = a1;
                *(LAS u32x4*)(Kb + i * SK + sub * 16) = b0; *(LAS u32x4*)(Kb + i * SK + sub * 16 + 8) = b1;
#pragma unroll
                for (int cc = 0; cc < 16; ++cc) { const float kn = o[cc] * sc; KbgT[(sub * 16 + cc) * ST + i] = f2bf(kn * beta * eg); KgT[(sub * 16 + cc) * ST + i] = f2bf(kn * egl); }
            } else {
#pragma unroll
                for (int cc = 0; cc < 16; ++cc) VbT[(sub * 16 + cc) * ST + i] = f2bf(o[cc] * beta);
            }
        }
    }
    __syncthreads();
    for (int tl = w; tl < 16; tl += 8) {
        const int m0 = (tl >> 2) * 16, n0 = (tl & 3) * 16;
        const f32x4 a1 = mma_tile<4>(Kb + (m0 + fr) * SK + 8 * fq, Kn + (n0 + fr) * SK + 8 * fq, ZERO4);
        const f32x4 a2 = mma_tile<4>(Qn + (m0 + fr) * SK + 8 * fq, Kn + (n0 + fr) * SK + 8 * fq, ZERO4);
        const int jj = n0 + fr; const float gj = gts[jj];
#pragma unroll
        for (int j = 0; j < 4; ++j) { const int i = m0 + 4 * fq + j; const float dec = __expf(fminf(gts[i] - gj, 0.f));
            Am[i * SA + jj] = (jj < i) ? a1[j] * dec : 0.f;
            QKm[i * ST + jj] = f2bf((jj <= i) ? a2[j] * dec : 0.f); }
    }
    __syncthreads();
    if (w == 0) {
        float tc[64];
        int lz; asm volatile("v_mov_b32 %0, 0" : "=v"(lz));
        const LAS float* Az = Am + lz;
#pragma unroll
        for (int i = 0; i < 64; ++i) { float acc = (i == lane) ? 1.f : 0.f;
#pragma unroll
            for (int j = 0; j < i; ++j) acc -= Az[i * SA + j] * tc[j];
            tc[i] = acc; }
#pragma unroll
        for (int i = 0; i < 64; ++i) Tm[i * ST + lane] = f2bf(tc[i]);
    }
    __syncthreads();
    for (int tl = w; tl < 32; tl += 8) {
        const int m0 = (tl >> 3) * 16, n0 = (tl & 7) * 16;
        const f32x4 u = mma_tile<2>(Tm + (m0 + fr) * ST + 8 * fq, VbT + (n0 + fr) * ST + 8 * fq, ZERO4);
        const f32x4 ww = mma_tile<2>(Tm + (m0 + fr) * ST + 8 * fq, KbgT + (n0 + fr) * ST + 8 * fq, ZERO4);
        u32x2 pu, pw; pu.x = pk2(u[0], u[1]); pu.y = pk2(u[2], u[3]); pw.x = pk2(ww[0], ww[1]); pw.y = pk2(ww[2], ww[3]);
        *(LAS u32x2*)(UT + (n0 + fr) * ST + m0 + 4 * fq) = pu; *(LAS u32x2*)(WT + (n0 + fr) * ST + m0 + 4 * fq) = pw;
    }
    __syncthreads();
    const long ib = item;
    for (int tl = w; tl < 64; tl += 8) {
        const int mt = tl >> 3, nt = tl & 7, m0 = mt * 16, n0 = nt * 16;
        const f32x4 pv = mma_tile<2>(WT + (m0 + fr) * ST + 8 * fq, KgT + (n0 + fr) * ST + 8 * fq, ZERO4);
        u32x2 pp; pp.x = pk2(-pv[0], -pv[1]); pp.y = pk2(-pv[2], -pv[3]);
        *(u32x2*)(p.gP + ib * 16384 + (n0 + fr) * 128 + (mt >> 1) * 32 + 8 * fq + (mt & 1) * 4) = pp;
        const f32x4 rv = mma_tile<2>(KgT + (m0 + fr) * ST + 8 * fq, UT + (n0 + fr) * ST + 8 * fq, ZERO4);
        *(f32x4*)(p.gRT + ib * 16384 + (n0 + fr) * 128 + m0 + 4 * fq) = rv;
    }
    for (int tl = w; tl < 32; tl += 8) {
        const int mt = tl >> 2, nt = tl & 3, m0 = mt * 16, n0 = nt * 16;
        const f32x4 qw = mma_tile<2>(WT + (m0 + fr) * ST + 8 * fq, QKm + (n0 + fr) * ST + 8 * fq, ZERO4);
        const f32x4 ou = mma_tile<2>(UT + (m0 + fr) * ST + 8 * fq, QKm + (n0 + fr) * ST + 8 * fq, ZERO4);
        const int i = n0 + fr, f = m0 + 4 * fq;
        const u32x2 qg = *(const LAS u32x2*)(Qg + i * SK + f);
        u32x2 qo; qo.x = pk2(__uint_as_float(qg.x << 16) - qw[0], __uint_as_float(qg.x & 0xffff0000u) - qw[1]);
        qo.y = pk2(__uint_as_float(qg.y << 16) - qw[2], __uint_as_float(qg.y & 0xffff0000u) - qw[3]);
        *(u32x2*)(p.gQp + ib * 8192 + i * 128 + f) = qo;
        *(f32x4*)(p.gOU + ib * 8192 + i * 128 + f) = ou;
    }
    if (tid == 0) p.gA[ib] = __expf(gts[63]);
    __syncthreads();
}

DI void gdn_chain(CP p, int ch) {
    const int tid = tidx(), lane = tid & 63, w = __builtin_amdgcn_readfirstlane(tid >> 6), fr = lane & 15, fq = lane >> 4;
    f32x4 acc[8];
#pragma unroll
    for (int mb = 0; mb < 8; ++mb) acc[mb] = ZERO4;
    for (int n = 0; n < 64; ++n) {
        const long ib = (long)ch * 64 + n;
        bf16x8 bfr[4];
#pragma unroll
        for (int ks = 0; ks < 4; ++ks) { u32x4 q; q.x = pk2(acc[2 * ks][0], acc[2 * ks][1]); q.y = pk2(acc[2 * ks][2], acc[2 * ks][3]); q.z = pk2(acc[2 * ks + 1][0], acc[2 * ks + 1][1]); q.w = pk2(acc[2 * ks + 1][2], acc[2 * ks + 1][3]);
            bfr[ks] = __builtin_bit_cast(bf16x8, q);
            bf16_t* sp = p.gST + ib * 16384 + (w * 16 + fr) * 128 + 4 * fq;
            u32x2 lo, hi; lo.x = q.x; lo.y = q.y; hi.x = q.z; hi.y = q.w;
            *(u32x2*)(sp + (2 * ks) * 16) = lo; *(u32x2*)(sp + (2 * ks + 1) * 16) = hi; }
        const float an = p.gA[ib];
#pragma unroll
        for (int mb = 0; mb < 8; ++mb) { const f32x4 r = *(const f32x4*)(p.gRT + ib * 16384 + (w * 16 + fr) * 128 + mb * 16 + 4 * fq); acc[mb] = acc[mb] * an + r; }
#pragma unroll
        for (int mb = 0; mb < 8; ++mb)
#pragma unroll
            for (int ks = 0; ks < 4; ++ks) acc[mb] = MFMA16(ld8(p.gP + ib * 16384 + (mb * 16 + fr) * 128 + ks * 32 + 8 * fq), bfr[ks], acc[mb]);
        settle(acc[0], acc[1], acc[2], acc[3], acc[4], acc[5], acc[6], acc[7]);
    }
}

DI void gdn_out_item(CP p, int l, int item, LAS char* lds) {
    const int tid = tidx(), lane = tid & 63, w = __builtin_amdgcn_readfirstlane(tid >> 6), fr = lane & 15, fq = lane >> 4;
    const int n = item & 63, h = (item >> 6) & 3, b = item >> 8;
    const long tok0 = (long)b * SEQ + n * 64, ib = item;
    LAS float* red = (LAS float*)lds;
    const int n0 = w * 16;
    f32x4 acc[4];
#pragma unroll
    for (int mt = 0; mt < 4; ++mt) acc[mt] = mma_tile<4>(p.gQp + ib * 8192 + (mt * 16 + fr) * 128 + 8 * fq, p.gST + ib * 16384 + (n0 + fr) * 128 + 8 * fq, ZERO4);
#pragma unroll
    for (int mt = 0; mt < 4; ++mt)
#pragma unroll
        for (int j = 0; j < 4; ++j) { acc[mt][j] += p.gOU[ib * 8192 + (mt * 16 + 4 * fq + j) * 128 + n0 + fr];
            float s = acc[mt][j] * acc[mt][j]; s += shflx<1>(s); s += shflx<2>(s); s += shflx<4>(s); s += shflx<8>(s);
            if (fr == 0) red[w * 64 + mt * 16 + 4 * fq + j] = s; }
    __syncthreads();
    const float gw = p.in[I_GDN_NORM][l * 128 + n0 + fr];
#pragma unroll
    for (int mt = 0; mt < 4; ++mt)
#pragma unroll
        for (int j = 0; j < 4; ++j) { const int i = mt * 16 + 4 * fq + j; float tot = 0.f;
#pragma unroll
            for (int ww = 0; ww < 8; ++ww) tot += red[ww * 64 + i];
            const float rstd = rsqrtf(tot * (1.f / 128.f) + EPS);
            const float z = bf2f(p.proj[(tok0 + i) * NPROJ + C_Z + h * 128 + n0 + fr]);
            p.mix[(tok0 + i) * D + 512 + h * 128 + n0 + fr] = f2bf(acc[mt][j] * rstd * gw * siluf_(z)); }
    __syncthreads();
}
DI void nsa_prep_elem(CP p, int l) {
    const int lane = tidx() & 63, gw = bidx() * 8 + __builtin_amdgcn_readfirstlane(tidx() >> 6), nw = gdim() * 8;
    const int hl = lane >> 5, i = lane & 31;
    for (long task = gw; task < (long)T * 12; task += nw) {
        const long t = task / 12; const int k = (int)(task % 12);
        const int s = (int)(t & (SEQ - 1)), b = (int)(t >> 12);
        int col; const float* gain; bf16_t* dst; float osc = 1.f;
        if (k < 8) { const int head = 2 * k + hl; col = C_NQ + head * 64; gain = p.in[I_QNORM] + l * 64; dst = p.qn + t * 1024 + head * 64; osc = 0.125f; }
        else if (k < 10) { const int g = (k - 8) * 2 + hl; col = C_NKV + 2 * 256 + g * 64; gain = p.in[I_KNORM] + (l * 3 + 1) * 64; dst = p.ksn + (((long)(b * 4 + g)) * SEQ + s) * 64; }
        else { const int g = (k - 10) * 2 + hl; col = C_NKV + 4 * 256 + g * 64; gain = p.in[I_KNORM] + (l * 3 + 2) * 64; dst = p.kwn + (((long)(b * 4 + g)) * SEQ + s) * 64; }
        const bf16_t* src = p.proj + t * NPROJ + col;
        const float x1 = bf2f(src[i]), x2 = bf2f(src[32 + i]);
        float ss = x1 * x1 + x2 * x2;
        ss += shflx<1>(ss); ss += shflx<2>(ss); ss += shflx<4>(ss); ss += shflx<8>(ss); ss += shflx<16>(ss);
        const float rstd = rsqrtf(ss * (1.f / 64.f) + EPS);
        const float y1 = x1 * rstd * gain[i], y2 = x2 * rstd * gain[32 + i];
        const f32x2 cs = p.rope[s * 32 + i];
        dst[i] = f2bf((y1 * cs.x - y2 * cs.y) * osc); dst[32 + i] = f2bf((y2 * cs.x + y1 * cs.y) * osc);
    }
}
DI void nsa_vtrans(CP p, LAS char* wl) {
    const int lane = tidx() & 63, gw = bidx() * 8 + __builtin_amdgcn_readfirstlane(tidx() >> 6), nw = gdim() * 8;
    LAS bf16_t* tile = (LAS bf16_t*)wl;
    for (int item = gw; item < 2 * 4 * 4 * 64; item += nw) {
        const int tl = item & 63, g = (item >> 6) & 3, b = (item >> 8) & 3, which = item >> 10;
        const long t = (long)b * SEQ + tl * 64 + lane;
        const bf16_t* src = p.proj + t * NPROJ + C_NKV + (which ? 5 : 3) * 256 + g * 64;
#pragma unroll
        for (int c = 0; c < 8; ++c) { const bf16x8 v = ld8(src + 8 * c);
#pragma unroll
            for (int e = 0; e < 8; ++e) tile[lane * 66 + 8 * c + e] = (bf16_t)v[e]; }
        lds_wait();
        bf16_t* dst = (which ? p.vwT : p.vsT) + ((long)(b * 4 + g) * 64) * SEQ + tl * 64 + lane;
#pragma unroll 8
        for (int d = 0; d < 64; ++d) dst[(long)d * SEQ] = tile[lane * 66 + d];
        lds_wait();
    }
}

DI void nsa_cmp_unit(CP p, int l, int unit, LAS char* lds) {
    const int kv = unit >> 4, mtile = unit & 15;
    const int tid = tidx(), lane = tid & 63, w = __builtin_amdgcn_readfirstlane(tid >> 6), fr = lane & 15, fq = lane >> 4;
    unsigned aoff[2][2], boff[2];
#pragma unroll
    for (int h = 0; h < 2; ++h)
#pragma unroll
        for (int i = 0; i < 2; ++i) { int R, C; g8::my_rc(i, R, C); const int row = mtile * 256 + h * 128 + R;
            const int b = row >> 10, n = min((row & 1023) >> 2, 254), g = row & 3;
            aoff[h][i] = (unsigned)((((long)b * SEQ + 16 * n) * NPROJ + C_NKV + kv * 256 + g * 64 + C) * 2);
            boff[i] = (unsigned)(R * 2048 + C) * 2u; }
    LAS bf16_t* Hs = (LAS bf16_t*)lds;
    const float* b1 = p.bias1 + kv * 256;
    g8::gemm_tile(lds, (const char*)p.proj, aoff, (long)NPROJ * 2, (const char*)(p.w1T + (long)kv * 256 * 2048), boff, 128L * 2048 * 2, 32, [&](const Acc& acc, int rb, int cb) {
        ACC_FOR(ai, m, bj, n) { const int r = ai * 128 + m * 16 + rb, c = bj * 128 + n * 16 + cb; const f32x4 v = acc[ai][bj][m][n];
            u32x2 o; o.x = pk2(gelu_tanh(v[0] + b1[c]), gelu_tanh(v[1] + b1[c + 1])); o.y = pk2(gelu_tanh(v[2] + b1[c + 2]), gelu_tanh(v[3] + b1[c + 3]));
            *(LAS u32x2*)(Hs + r * 264 + c) = o; }
    });
    __syncthreads();
    const bf16_t* w2 = p.w2T + (long)kv * 64 * 256;
    for (int rg = w; rg < 16; rg += 8) {
        f32x4 acc[4];
#pragma unroll
        for (int mt = 0; mt < 4; ++mt) acc[mt] = ZERO4;
#pragma unroll
        for (int ks = 0; ks < 8; ++ks) { const bf16x8 hb = ld8(Hs + (rg * 16 + fr) * 264 + ks * 32 + 8 * fq);
#pragma unroll
            for (int mt = 0; mt < 4; ++mt) acc[mt] = MFMA16(ld8(w2 + (mt * 16 + fr) * 256 + ks * 32 + 8 * fq), hb, acc[mt]); }
        settle(acc[0], acc[1], acc[2], acc[3]);
        const int row = mtile * 256 + rg * 16 + fr; const int b = row >> 10, n = (row & 1023) >> 2, g = row & 3;
        const bool valid = n < 255;
        if (kv == 0) {
            float ss = 0.f;
#pragma unroll
            for (int mt = 0; mt < 4; ++mt)
#pragma unroll
                for (int j = 0; j < 4; ++j) ss += acc[mt][j] * acc[mt][j];
            ss += shflx<16>(ss); ss += shflx<32>(ss);
            const float rstd = rsqrtf(ss * (1.f / 64.f) + EPS);
            const float* gain = p.in[I_KNORM] + (l * 3 + 0) * 64;
            const int pos = min(16 * n + 31, SEQ - 1);
            bf16_t* dst = p.kcmp + (((long)(b * 4 + g)) * 256 + n) * 64;
#pragma unroll
            for (int mt = 0; mt < 2; ++mt) { u32x2 lo, hi; float o1[4], o2[4];
#pragma unroll
                for (int j = 0; j < 4; ++j) { const int d = mt * 16 + 4 * fq + j; const f32x2 cs = p.rope[pos * 32 + d];
                    const float y1 = acc[mt][j] * rstd * gain[d], y2 = acc[mt + 2][j] * rstd * gain[32 + d];
                    o1[j] = valid ? y1 * cs.x - y2 * cs.y : 0.f; o2[j] = valid ? y2 * cs.x + y1 * cs.y : 0.f; }
                lo.x = pk2(o1[0], o1[1]); lo.y = pk2(o1[2], o1[3]); hi.x = pk2(o2[0], o2[1]); hi.y = pk2(o2[2], o2[3]);
                *(u32x2*)(dst + mt * 16 + 4 * fq) = lo; *(u32x2*)(dst + 32 + mt * 16 + 4 * fq) = hi; }
        } else {
            bf16_t* dst = p.vcmpT + (((long)(b * 4 + g)) * 64) * 256 + n;
#pragma unroll
            for (int mt = 0; mt < 4; ++mt)
#pragma unroll
                for (int j = 0; j < 4; ++j) dst[(long)(mt * 16 + 4 * fq + j) * 256] = f2bf(valid ? acc[mt][j] : 0.f);
        }
    }
    __syncthreads();
}

DI int crow(int i, int hh) { return (i & 3) + 8 * (i >> 2) + 4 * hh; }
DI bf16x8 pack8(const float* q) { u32x4 r; r.x = pk2(q[0], q[1]); r.y = pk2(q[2], q[3]); r.z = pk2(q[4], q[5]); r.w = pk2(q[6], q[7]); return __builtin_bit_cast(bf16x8, r); }
DI bf16x8 ldvt(const bf16_t* vt, long ldv, int d, int key) { const u32x2 a = *(const u32x2*)(vt + (long)d * ldv + key), b = *(const u32x2*)(vt + (long)d * ldv + key + 8); u32x4 r; r.x = a.x; r.y = a.y; r.z = b.x; r.w = b.y; return __builtin_bit_cast(bf16x8, r); }

DI void nsa_item(CP p, int l, int item, LAS char* wl) {
    const int lane = tidx() & 63, r31 = lane & 31, hh = lane >> 5;
    item = __builtin_amdgcn_readfirstlane(item);
    const int qgi = item & 511, g = (item >> 9) & 3, b = item >> 11;
    const int s0 = qgi * 8, qi = r31 >> 2, rr = r31 & 3, tq = s0 + qi;
    const long tok = (long)b * SEQ + tq;
    LAS float* impL = (LAS float*)wl;
    bf16x8 qf[4];
    { const bf16_t* qp = p.qn + tok * 1024 + (g * 4 + rr) * 64 + 8 * hh;
#pragma unroll
      for (int s = 0; s < 4; ++s) qf[s] = ld8(qp + 16 * s); }
#pragma unroll
    for (int k = 0; k < 8; ++k) impL[k * 64 + lane] = 0.f;
    f32x16 outacc[2];
#pragma unroll
    for (int i = 0; i < 16; ++i) { outacc[0][i] = 0.f; outacc[1][i] = 0.f; }
    const float* gl = p.small + tok * NSMALL + 8 + g * 12 + rr * 3;
    const float gate_c = sigmoidf_(gl[0]), gate_s = sigmoidf_(gl[1]), gate_w = sigmoidf_(gl[2]);
    const f32x16 zero16 = {0.f, 0.f, 0.f, 0.f, 0.f, 0.f, 0.f, 0.f, 0.f, 0.f, 0.f, 0.f, 0.f, 0.f, 0.f, 0.f};
    {
        const bf16_t* kc = p.kcmp + ((long)(b * 4 + g) * 256) * 64; const bf16_t* vt = p.vcmpT + ((long)(b * 4 + g) * 64) * 256;
        const int nvmax = (s0 + 7 >= 31) ? ((s0 + 7 - 31) >> 4) + 1 : 0; const int ntile = (nvmax + 31) >> 5;
        const int nv = (tq >= 31) ? ((tq - 31) >> 4) + 1 : 0;
        float m = -1e30f, lsum = 0.f;
        for (int tI = 0; tI < ntile; ++tI) {
            const int key0 = tI * 32; f32x16 acc = zero16;
#pragma unroll
            for (int s = 0; s < 4; ++s) acc = MFMA32(ld8(kc + (long)(key0 + r31) * 64 + 16 * s + 8 * hh), qf[s], acc);
            settle(acc);
            float mx = -1e30f;
#pragma unroll
            for (int i = 0; i < 16; ++i) { const bool v = key0 + crow(i, hh) < nv; mx = fmaxf(mx, v ? acc[i] : -1e30f); }
            mx = fmaxf(mx, shflx<32>(mx));
            const float mn = fmaxf(m, mx); float ps = 0.f;
#pragma unroll
            for (int i = 0; i < 16; ++i) { const bool v = key0 + crow(i, hh) < nv; ps += v ? __expf(acc[i] - mn) : 0.f; }
            lsum = lsum * __expf(m - mn) + ps; m = mn;
        }
        lsum += shflx<32>(lsum);
        const float inv = lsum > 0.f ? 1.f / lsum : 0.f;
        f32x16 oc[2] = {zero16, zero16};
        for (int tI = 0; tI < ntile; ++tI) {
            const int key0 = tI * 32; f32x16 acc = zero16;
#pragma unroll
            for (int s = 0; s < 4; ++s) acc = MFMA32(ld8(kc + (long)(key0 + r31) * 64 + 16 * s + 8 * hh), qf[s], acc);
            settle(acc);
            float pr[16];
#pragma unroll
            for (int i = 0; i < 16; ++i) { const bool v = key0 + crow(i, hh) < nv; pr[i] = v ? __expf(acc[i] - m) * inv : 0.f; }
#pragma unroll
            for (int qd = 0; qd < 4; ++qd) { float mainv = pr[4 * qd] + pr[4 * qd + 1] + pr[4 * qd + 2] + 0.5f * pr[4 * qd + 3], sp = 0.5f * pr[4 * qd + 3];
                mainv += shflx<1>(mainv); mainv += shflx<2>(mainv); sp += shflx<1>(sp); sp += shflx<2>(sp);
                const int j = (key0 >> 2) + 2 * qd + hh;
                if (rr == 0) impL[qi * 64 + j] += mainv;
                lds_wait();
                if (rr == 0 && j + 1 < 64) impL[qi * 64 + j + 1] += sp;
                lds_wait(); }
#pragma unroll
            for (int s = 0; s < 2; ++s) { const bf16x8 pb = pack8(pr + 8 * s);
#pragma unroll
                for (int mb = 0; mb < 2; ++mb) oc[mb] = MFMA32(ldvt(vt, 256, 32 * mb + r31, key0 + 16 * s + 4 * hh), pb, oc[mb]); }
        }
        settle(oc[0], oc[1]);
#pragma unroll
        for (int i = 0; i < 16; ++i) { outacc[0][i] = gate_c * oc[0][i]; outacc[1][i] = gate_c * oc[1][i]; }
    }
    lds_wait();
    unsigned long long mymask = 0ull, un = 0ull;
    {
        const int cur = s0 >> 6;
#pragma unroll 1
        for (int q2 = 0; q2 < 8; ++q2) {
            const float v = impL[q2 * 64 + lane];
            const bool forced = (lane == 0) || (lane == cur) || (lane == cur - 1), started = lane <= cur;
            const float key = forced ? 1e9f : (started ? v : -1e9f);
            int rank = 0;
#pragma unroll 8
            for (int jj = 0; jj < 64; ++jj) { const float o = __builtin_bit_cast(float, __builtin_amdgcn_readlane(__builtin_bit_cast(int, key), jj)); rank += ((o > key) || (o == key && jj < lane)) ? 1 : 0; }
            const unsigned long long mk = __ballot(rank < 16 && started);
            if (qi == q2) mymask = mk;
            un |= mk;
        }
    }
    auto branch = [&](const bf16_t* kb, const bf16_t* vt, auto&& tiles, auto&& valid_fn, float gate) {
        float m = -1e30f, lsum = 0.f; f32x16 o[2] = {zero16, zero16};
        tiles([&](int key0) {
            f32x16 acc = zero16;
#pragma unroll
            for (int s = 0; s < 4; ++s) acc = MFMA32(ld8(kb + (long)(key0 + r31) * 64 + 16 * s + 8 * hh), qf[s], acc);
            settle(acc);
            float mx = -1e30f;
#pragma unroll
            for (int i = 0; i < 16; ++i) { const bool v = valid_fn(key0 + crow(i, hh)); mx = fmaxf(mx, v ? acc[i] : -1e30f); }
            mx = fmaxf(mx, shflx<32>(mx));
            const float mn = fmaxf(m, mx), alpha = __expf(m - mn); float ps = 0.f; float pr[16];
#pragma unroll
            for (int i = 0; i < 16; ++i) { const bool v = valid_fn(key0 + crow(i, hh)); pr[i] = v ? __expf(acc[i] - mn) : 0.f; ps += pr[i]; }
            lsum = lsum * alpha + ps; m = mn;
#pragma unroll
            for (int i = 0; i < 16; ++i) { o[0][i] *= alpha; o[1][i] *= alpha; }
#pragma unroll
            for (int s = 0; s < 2; ++s) { const bf16x8 pb = pack8(pr + 8 * s);
#pragma unroll
                for (int mb = 0; mb < 2; ++mb) o[mb] = MFMA32(ldvt(vt, SEQ, 32 * mb + r31, key0 + 16 * s + 4 * hh), pb, o[mb]); }
        });
        settle(o[0], o[1]);
        lsum += shflx<32>(lsum);
        const float sc = lsum > 0.f ? gate / lsum : 0.f;
#pragma unroll
        for (int i = 0; i < 16; ++i) { outacc[0][i] += sc * o[0][i]; outacc[1][i] += sc * o[1][i]; }
    };
    {
        const bf16_t* kb = p.ksn + ((long)(b * 4 + g) * SEQ) * 64; const bf16_t* vt = p.vsT + ((long)(b * 4 + g) * 64) * SEQ;
        const unsigned long long mm = mymask;
        branch(kb, vt, [&](auto&& body) {
            unsigned long long u = un;
            while (u) { const int j = __builtin_ctzll(u); u &= u - 1ull; body(64 * j); if (64 * j + 32 <= s0 + 7) body(64 * j + 32); }
        }, [&](int pos) { return ((mm >> (pos >> 6)) & 1ull) && pos <= tq; }, gate_s);
    }
    {
        const bf16_t* kb = p.kwn + ((long)(b * 4 + g) * SEQ) * 64; const bf16_t* vt = p.vwT + ((long)(b * 4 + g) * 64) * SEQ;
        const int t_lo = max(0, s0 - 511) >> 5, t_hi = (s0 + 7) >> 5;
        branch(kb, vt, [&](auto&& body) { for (int tI = t_lo; tI <= t_hi; ++tI) body(tI * 32); },
               [&](int pos) { return pos <= tq && pos > tq - 512; }, gate_w);
    }
    bf16_t* dst = p.mix + tok * D + 1024 + (g * 4 + rr) * 64;
#pragma unroll
    for (int mb = 0; mb < 2; ++mb)
#pragma unroll
        for (int qd = 0; qd < 4; ++qd) { u32x2 o; o.x = pk2(outacc[mb][4 * qd], outacc[mb][4 * qd + 1]); o.y = pk2(outacc[mb][4 * qd + 2], outacc[mb][4 * qd + 3]);
            *(u32x2*)(dst + 32 * mb + 8 * qd + 4 * hh) = o; }
    lds_wait();
}
DI void s5_glu_item(CP p, int l, int item, LAS char* lds) {
    const int tid = tidx(), lane = tid & 63, w = __builtin_amdgcn_readfirstlane(tid >> 6), fr = lane & 15, fq = lane >> 4;
    const long tok0 = (long)item * 64;
    LAS bf16_t* Ys = (LAS bf16_t*)lds;
    LAS float* red = (LAS float*)(lds + 64 * 520 * 2);
#pragma unroll
    for (int i = 0; i < 8; ++i) { const int e = tid + i * 512, r = e >> 6, c = e & 63; *(LAS u32x4*)(Ys + r * 520 + c * 8) = *(const u32x4*)(p.s5y + (tok0 + r) * 512 + c * 8); }
    __syncthreads();
    f32x4 acc[4][4];
#pragma unroll
    for (int mt = 0; mt < 4; ++mt)
#pragma unroll
        for (int nb = 0; nb < 4; ++nb) acc[mt][nb] = ZERO4;
    const bf16_t* gw = p.gluT + (long)(w * 64 + fr) * 512 + 8 * fq;
#pragma unroll 2
    for (int ks = 0; ks < 16; ++ks) {
        bf16x8 a[4], bb[4];
#pragma unroll
        for (int mt = 0; mt < 4; ++mt) a[mt] = ld8(Ys + (mt * 16 + fr) * 520 + ks * 32 + 8 * fq);
#pragma unroll
        for (int nb = 0; nb < 4; ++nb) bb[nb] = ld8(gw + (long)nb * 16 * 512 + ks * 32);
#pragma unroll
        for (int mt = 0; mt < 4; ++mt)
#pragma unroll
            for (int nb = 0; nb < 4; ++nb) acc[mt][nb] = MFMA16(a[mt], bb[nb], acc[mt][nb]);
    }
    settle(acc[0][0], acc[0][1], acc[0][2], acc[0][3], acc[1][0], acc[1][1], acc[1][2], acc[1][3]);
    settle(acc[2][0], acc[2][1], acc[2][2], acc[2][3], acc[3][0], acc[3][1], acc[3][2], acc[3][3]);
    float gb[4], gn[4];
#pragma unroll
    for (int nb = 0; nb < 4; ++nb) { gb[nb] = p.in[I_GLU_B][l * 512 + w * 64 + nb * 16 + fr]; gn[nb] = p.in[I_S5NORM][l * 512 + w * 64 + nb * 16 + fr]; }
#pragma unroll
    for (int mt = 0; mt < 4; ++mt)
#pragma unroll
        for (int j = 0; j < 4; ++j) { const int i = mt * 16 + 4 * fq + j; float s = 0.f;
#pragma unroll
            for (int nb = 0; nb < 4; ++nb) { const float y = bf2f(Ys[i * 520 + w * 64 + nb * 16 + fr]); const float v = y * sigmoidf_(acc[mt][nb][j] + gb[nb]); acc[mt][nb][j] = v; s += v * v; }
            s += shflx<1>(s); s += shflx<2>(s); s += shflx<4>(s); s += shflx<8>(s);
            if (fr == 0) red[w * 64 + i] = s; }
    __syncthreads();
#pragma unroll
    for (int mt = 0; mt < 4; ++mt)
#pragma unroll
        for (int j = 0; j < 4; ++j) { const int i = mt * 16 + 4 * fq + j; float tot = 0.f;
#pragma unroll
            for (int ww = 0; ww < 8; ++ww) tot += red[ww * 64 + i];
            const float rstd = rsqrtf(tot * (1.f / 512.f) + EPS);
#pragma unroll
            for (int nb = 0; nb < 4; ++nb) p.mix[(tok0 + i) * D + w * 64 + nb * 16 + fr] = f2bf(acc[mt][nb][j] * rstd * gn[nb]); }
    __syncthreads();
}

DI void nsa_outnorm(CP p, int l) {
    const int lane = tidx() & 63, gw = bidx() * 8 + __builtin_amdgcn_readfirstlane(tidx() >> 6), nw = gdim() * 8;
    const float* gain = p.in[I_NSA_NORM] + l * 1024 + lane * 16;
    for (int t = gw; t < T; t += nw) {
        bf16_t* row = p.mix + (long)t * D + 1024 + lane * 16;
        const bf16x8 v0 = ld8(row), v1 = ld8(row + 8); float x[16]; float ss = 0.f;
#pragma unroll
        for (int e = 0; e < 8; ++e) { x[e] = bf2f((bf16_t)v0[e]); x[8 + e] = bf2f((bf16_t)v1[e]); }
#pragma unroll
        for (int e = 0; e < 16; ++e) ss += x[e] * x[e];
        ss = wave_sum(ss);
        const float rstd = rsqrtf(ss * (1.f / 1024.f) + EPS);
        u32x4 o0, o1;
#pragma unroll
        for (int e = 0; e < 4; ++e) { o0[e] = pk2(x[2 * e] * rstd * gain[2 * e], x[2 * e + 1] * rstd * gain[2 * e + 1]); o1[e] = pk2(x[8 + 2 * e] * rstd * gain[8 + 2 * e], x[9 + 2 * e] * rstd * gain[9 + 2 * e]); }
        *(u32x4*)row = o0; *(u32x4*)(row + 8) = o1;
    }
}

DI void p6_outproj(CP p, int l, LAS char* lds) {
    unsigned aoff[2][2], boff[2];
#pragma unroll
    for (int i = 0; i < 2; ++i) { int R, C; g8::my_rc(i, R, C); boff[i] = (unsigned)(R * D + C) * 2u; aoff[0][i] = boff[i]; aoff[1][i] = (unsigned)((128 + R) * D + C) * 2u; }
    const float* xres = l == 0 ? p.in[I_X] : p.out;
    for (int u = bidx();; u += gdim()) {
        int pm, pn; if (!g8::unit_of(u, T / 256, D / 256, pm, pn)) break;
        float* hh = p.h; bf16_t* hb = p.xb;
        g8::gemm_tile(lds, (const char*)(p.mix + (long)pm * 256 * D), aoff, 128, (const char*)(p.WoutT + (long)pn * 256 * D), boff, 128L * D * 2, D / 64, [&](const Acc& acc, int rb, int cb) {
            ACC_FOR(ai, m, bj, n) { const int r = ai * 128 + m * 16 + rb, c = bj * 128 + n * 16 + cb; const long off = (long)(pm * 256 + r) * D + pn * 256 + c;
                const f32x4 v = acc[ai][bj][m][n] + *(const f32x4*)(xres + off);
                *(f32x4*)(hh + off) = v; u32x2 w; w.x = pk2(v[0], v[1]); w.y = pk2(v[2], v[3]); *(u32x2*)(hb + off) = w; }
        });
    }
}

DI void router_item(CP p, int l, int item, LAS char* wl) {
    const int lane = tidx() & 63, fr = lane & 15, fq = lane >> 4;
    item = __builtin_amdgcn_readfirstlane(item);
    const long t0 = (long)item * 16;
    LAS float* lg = (LAS float*)wl;
    f32x4 acc[3] = {ZERO4, ZERO4, ZERO4}; float ss = 0.f;
    const float* hr = p.h + (t0 + fr) * D + 4 * fq; const float* wr = p.Wr + (long)fr * D + 4 * fq;
#pragma unroll 2
    for (int k0 = 0; k0 < D; k0 += 16) {
        const f32x4 hv = *(const f32x4*)(hr + k0);
        f32x4 wv[3];
#pragma unroll
        for (int nb = 0; nb < 3; ++nb) wv[nb] = *(const f32x4*)(wr + (long)nb * 16 * D + k0);
        ss += hv[0] * hv[0] + hv[1] * hv[1] + hv[2] * hv[2] + hv[3] * hv[3];
#pragma unroll
        for (int jx = 0; jx < 4; ++jx)
#pragma unroll
            for (int nb = 0; nb < 3; ++nb) acc[nb] = __builtin_amdgcn_mfma_f32_16x16x4f32(hv[jx], wv[nb][jx], acc[nb], 0, 0, 0);
    }
    settle(acc[0], acc[1]); settle(acc[2]);
    ss += shflx<16>(ss); ss += shflx<32>(ss);
    const float rstd = rsqrtf(ss * (1.f / D) + EPS);
    if (fq == 0) lg[16 * 48 + fr] = rstd;
#pragma unroll
    for (int nb = 0; nb < 3; ++nb)
#pragma unroll
        for (int j = 0; j < 4; ++j) lg[(4 * fq + j) * 48 + nb * 16 + fr] = acc[nb][j];
    lds_wait();
    if (lane < 16) {
        const long t = t0 + lane; const float rs = lg[16 * 48 + lane]; const LAS float* q = lg + lane * 48;
        float gl[4]; int grp = 0; float gm = -3.4e38f;
#pragma unroll
        for (int i = 0; i < 4; ++i) { gl[i] = q[i] * rs + p.in[I_GROUP_B][l * 4 + i]; if (gl[i] > gm) { gm = gl[i]; grp = i; } }
        float se = 0.f;
#pragma unroll
        for (int i = 0; i < 4; ++i) se += expf(gl[i] - gm);
        const float pg = 1.f / se;
        float v0 = -3.4e38f, v1 = -3.4e38f; int i0 = 0, i1 = 0;
#pragma unroll
        for (int i = 0; i < 8; ++i) { const float e = q[4 + grp * 8 + i] * rs + p.in[I_EXPERT_B][l * 32 + grp * 8 + i];
            if (e > v0) { v1 = v0; i1 = i0; v0 = e; i0 = i; } else if (e > v1) { v1 = e; i1 = i; } }
        const float w0 = 1.f / (1.f + expf(v1 - v0)), w1 = 1.f - w0;
        const int e0 = grp * 8 + i0, e1 = grp * 8 + i1;
        int* cnt = p.cnt + l * 32;
        const int p0 = atomicAdd(cnt + e0, 1), p1 = atomicAdd(cnt + e1, 1);
        p.tok_list[e0 * T + p0] = (int)t; p.w_list[e0 * T + p0] = w0 * pg;
        p.tok_list[e1 * T + p1] = (int)t; p.w_list[e1 * T + p1] = w1 * pg;
        int* ti = p.tokinfo + t * 4; ti[0] = e0; ti[1] = p0; ti[2] = e1; ti[3] = p1;
        p.rstd_ffn[t] = rs;
    }
    lds_wait();
}

DI void moe_table(CP p, int l, LAS int* tab) {
    if (tidx() < 64) { const int lane = tidx(); const int c = lane < 32 ? p.cnt[l * 32 + lane] : 0; const int ntl = (c + 255) >> 8; int inc = ntl;
#pragma unroll
        for (int o = 1; o < 32; o <<= 1) { const int v = shfl_up_i(inc, o, lane); if ((lane & 31) >= o) inc += v; }
        if (lane < 32) { tab[lane] = inc - ntl; tab[64 + lane] = c; if (lane == 31) tab[32] = inc; } }
    __syncthreads();
}
DI void p8_moe_up(CP p, int l, LAS char* lds) {
    LAS int* tab = (LAS int*)(lds + 140 * 1024);
    moe_table(p, l, tab);
    const int ntiles = tab[32];
    unsigned aoff[2][2], boff[2];
#pragma unroll
    for (int i = 0; i < 2; ++i) { int R, C; g8::my_rc(i, R, C); boff[i] = (unsigned)(R * D + C) * 2u; }
    for (int u = bidx(); u < ntiles * 4; u += gdim()) {
        const int tile = u >> 2, pn = u & 3;
        const int e = __popcll(__ballot((tidx() & 63) < 32 && tab[tidx() & 31] <= tile)) - 1;
        const int mt = tile - tab[e], cnt_e = tab[64 + e];
        const int* tl = p.tok_list + e * T;
#pragma unroll
        for (int h = 0; h < 2; ++h)
#pragma unroll
            for (int i = 0; i < 2; ++i) { int R, C; g8::my_rc(i, R, C); const int pos = mt * 256 + h * 128 + R; const int tk = tl[pos < cnt_e ? pos : 0];
                aoff[h][i] = (unsigned)(((long)tk * D + C) * 2); }
        bf16_t* hid = p.hid; const float* rsf = p.rstd_ffn;
        g8::gemm_tile(lds, (const char*)p.xb, aoff, 128, (const char*)(p.WguT + ((long)e * 1024 + pn * 256) * D), boff, 128L * D * 2, D / 64, [&](const Acc& acc, int rb, int cb) {
#pragma unroll
            for (int ai = 0; ai < 2; ++ai)
#pragma unroll
                for (int m = 0; m < 4; ++m) { const int r = ai * 128 + m * 16 + rb; const int pos = mt * 256 + r; const float rs = rsf[tl[pos < cnt_e ? pos : 0]];
#pragma unroll
                    for (int n = 0; n < 2; ++n) { const f32x4 gt = acc[ai][0][m][n] * rs, up = acc[ai][1][m][n] * rs;
                        u32x2 o; o.x = pk2(siluf_(gt[0]) * up[0], siluf_(gt[1]) * up[1]); o.y = pk2(siluf_(gt[2]) * up[2], siluf_(gt[3]) * up[3]);
                        *(u32x2*)(hid + ((long)tile * 256 + r) * DEXP + pn * 128 + n * 16 + cb) = o; } }
        });
    }
}
DI void p9_moe_down(CP p, int l, LAS char* lds) {
    LAS int* tab = (LAS int*)(lds + 140 * 1024);
    moe_table(p, l, tab);
    const int ntiles = tab[32];
    unsigned aoff[2][2], boff[2];
#pragma unroll
    for (int i = 0; i < 2; ++i) { int R, C; g8::my_rc(i, R, C); boff[i] = (unsigned)(R * DEXP + C) * 2u; aoff[0][i] = boff[i]; aoff[1][i] = (unsigned)((128 + R) * DEXP + C) * 2u; }
    for (int u = bidx(); u < ntiles * 8; u += gdim()) {
        const int tile = u >> 3, pn = u & 7;
        const int e = __popcll(__ballot((tidx() & 63) < 32 && tab[tidx() & 31] <= tile)) - 1;
        const int mt = tile - tab[e], cnt_e = tab[64 + e];
        bf16_t* yb = p.ybuf; const float* wl_ = p.w_list + e * T;
        g8::gemm_tile(lds, (const char*)(p.hid + (long)tile * 256 * DEXP), aoff, 128, (const char*)(p.WdT + ((long)e * D + pn * 256) * DEXP), boff, 128L * DEXP * 2, DEXP / 64, [&](const Acc& acc, int rb, int cb) {
#pragma unroll
            for (int ai = 0; ai < 2; ++ai)
#pragma unroll
                for (int m = 0; m < 4; ++m) { const int r = ai * 128 + m * 16 + rb; const int pos = mt * 256 + r; const float wt = pos < cnt_e ? wl_[pos] : 0.f;
#pragma unroll
                    for (int bj = 0; bj < 2; ++bj)
#pragma unroll
                        for (int n = 0; n < 2; ++n) { const f32x4 v = acc[ai][bj][m][n] * wt; u32x2 o; o.x = pk2(v[0], v[1]); o.y = pk2(v[2], v[3]);
                            *(u32x2*)(yb + ((long)tile * 256 + r) * D + pn * 256 + bj * 128 + n * 16 + cb) = o; } }
        });
    }
}
constexpr int NPH = 19;
#ifndef PH_EN
#define PH_EN 0xffffffffu
#endif
#define EN(i) ((PH_EN >> (i)) & 1u)
#ifndef MULTI_LAUNCH
#define MULTI_LAUNCH 1
#endif
typedef const __attribute__((address_space(4))) Params* CPP;
template <int PH>
DI void run_phase(LAS char* lds_) {
    unsigned lbase = (unsigned)(size_t)lds_; asm volatile("" : "+s"(lbase)); LAS char* lds = (LAS char*)(size_t)lbase;
    CPP pp = (CPP)__builtin_amdgcn_kernarg_segment_ptr();
    asm volatile("" : "+s"(pp));
    CP p = *pp;
    const int tid = tidx(), w = __builtin_amdgcn_readfirstlane(tid >> 6), G = gdim();
    LAS char* wl = lds + w * 16384;
    const int gw = bidx() * 8 + w, nw = G * 8;
    if constexpr (PH == 0 || PH == 9) {
        if (EN(0)) p0_convert(p, PH == 9 ? 1 : 0, lds);
        if (PH == 0) p0_once(p);
        if (EN(1)) p1_rows(p, PH == 9 ? 1 : 0, 0);
    } else if constexpr (PH == 18) {
        if (EN(1)) p1_rows(p, 2, 1);
    } else {
        constexpr int l = PH >= 10 ? 1 : 0; constexpr int k = PH - (l ? 10 : 1);
        if constexpr (k == 0) { if (EN(2)) p2_inproj(p, lds); }
        else if constexpr (k == 1) {
            if (EN(3)) for (int u = bidx(); u < 32; u += G) nsa_cmp_unit(p, l, u, lds);
            if (EN(4)) for (int it = bidx(); it < 1024; it += G) gdn_prep_item(p, l, it, lds);
            __syncthreads();
            if (EN(5)) for (int it = gw; it < 8192; it += nw) s5_item(p, l, it, 1, wl);
            if (EN(6)) { nsa_prep_elem(p, l); nsa_vtrans(p, wl); }
        } else if constexpr (k == 2) {
            if (EN(7)) if (bidx() < 16) gdn_chain(p, bidx());
            if (EN(8)) for (int it = gw; it < 8192; it += nw) s5_item(p, l, it, 2, wl);
            LAS int* sh = (LAS int*)(lds + 150 * 1024);
            for (;;) {
                __syncthreads();
                if (tid == 0) sh[0] = atomicAdd(p.cnt + 64 + l, 1);
                __syncthreads();
                const int base = sh[0];
                if (base * 8 >= 8192) break;
                if (EN(9)) nsa_item(p, l, base * 8 + w, wl);
            }
        } else if constexpr (k == 3) {
            if (EN(10)) for (int it = bidx(); it < 256; it += G) s5_glu_item(p, l, it, lds);
            if (EN(11)) for (int it = bidx(); it < 1024; it += G) gdn_out_item(p, l, it, lds);
            if (EN(12)) nsa_outnorm(p, l);
        } else if constexpr (k == 4) { if (EN(13)) p6_outproj(p, l, lds); }
        else if constexpr (k == 5) { if (EN(14)) for (int it = gw; it < 1024; it += nw) router_item(p, l, it, wl); }
        else if constexpr (k == 6) { if (EN(15)) p8_moe_up(p, l, lds); }
        else { if (EN(16)) p9_moe_down(p, l, lds); }
    }
}
#if MULTI_LAUNCH
template <int PH>
__global__ void __launch_bounds__(512) phase_k(Params p_) {
    extern __shared__ __attribute__((aligned(16))) char smem_raw[];
    run_phase<PH>((LAS char*)smem_raw);
}
#ifndef DBG_STOP
#define DBG_STOP 99
#endif
#ifndef DBG_SRC
#define DBG_SRC 0
#endif
__global__ void dbg_copy(Params p) {
    const long n = (long)T * D;
    for (long i = (long)blockIdx.x * blockDim.x + threadIdx.x; i < n; i += (long)gridDim.x * blockDim.x) {
        const long t = i / D, c = i % D; float v;
        if (DBG_SRC == 0) v = p.h[i];
        else if (DBG_SRC == 1) v = bf2f(p.mix[i]);
        else if (DBG_SRC == 2) v = bf2f(p.proj[t * NPROJ + c]);
        else if (DBG_SRC == 3) v = bf2f(p.xb[i]);
        else if (DBG_SRC == 5) v = bf2f(p.proj[t * NPROJ + 2560 + c]);
        else if (DBG_SRC == 6) v = c < 512 ? bf2f(p.s5y[t * 512 + c]) : (c < 1536 ? bf2f(p.qn[t * 1024 + c - 512]) : bf2f(p.ksn[t * 256 + (c - 1536) % 256]));
        else if (DBG_SRC == 8) { const int* ti = p.tokinfo + t * 4; const int k = (int)(c & 3); v = k == 0 ? (float)ti[0] : k == 1 ? (float)ti[2] : k == 2 ? p.w_list[ti[0] * T + ti[1]] : p.w_list[ti[2] * T + ti[3]] + p.rstd_ffn[t]; }
        else if (DBG_SRC == 9) { const int* ti = p.tokinfo + t * 4; int ts0 = 0, ts1 = 0; for (int e = 0; e < 32; ++e) { const int nt_ = (p.cnt[e] + 255) >> 8; if (e < ti[0]) ts0 += nt_; if (e < ti[2]) ts1 += nt_; }
            const long s0 = (long)ts0 * 256 + ti[1], s1 = (long)ts1 * 256 + ti[3]; v = c < 1024 ? bf2f(p.hid[s0 * 512 + (c & 511)]) : bf2f(p.hid[s1 * 512 + (c & 511)]); }
        else if (DBG_SRC == 10) { const int* ti = p.tokinfo + t * 4; int ts0 = 0, ts1 = 0; for (int e = 0; e < 32; ++e) { const int nt_ = (p.cnt[e] + 255) >> 8; if (e < ti[0]) ts0 += nt_; if (e < ti[2]) ts1 += nt_; }
            const long s0 = (long)ts0 * 256 + ti[1], s1 = (long)ts1 * 256 + ti[3]; v = bf2f(p.ybuf[s0 * D + c]) + 3.f * bf2f(p.ybuf[s1 * D + c]); }
        else if (DBG_SRC == 13) v = p.small[t * NSMALL + (c % 56)];
        else if (DBG_SRC == 14) v = ((const float*)p.s5E)[i % (4L * 64 * 32 * 64 * 2)] - ((const float*)p.gRT)[i % (4L * 64 * 32 * 64 * 2)];
        else if (DBG_SRC == 11) v = ((const float*)p.s5E)[i % (4L * 64 * 32 * 64 * 2)];
        else if (DBG_SRC == 12) v = c < 1024 ? ((const float*)p.s5lam)[(t * 1024 + c) % 8192] : bf2f(((c & 1) ? p.s5Bt : p.s5Ct)[(t * 1024 + c) % 65536]);
        else v = 0.f;
#ifdef DBG_AMP
        v = v * DBG_AMP; v = v - floorf(v);
#endif
#ifdef DBG_C0
        if (c < DBG_C0 || c >= DBG_C1) v = 0.f;
#endif
        p.out[i] = v;
    }
}
template <int PH> static void launch_phases(const Params& p, int grid, hipStream_t stream) {
    if constexpr (PH < NPH && PH <= DBG_STOP) { hipLaunchKernelGGL(phase_k<PH>, dim3(grid), dim3(512), LDS_BYTES, stream, p); launch_phases<PH + 1>(p, grid, stream); }
    else if constexpr (PH < NPH && DBG_SRC != 7) hipLaunchKernelGGL(dbg_copy, dim3(1024), dim3(256), 0, stream, p);
}
template <int PH> static bool set_attr() {
    if constexpr (PH < NPH) { if (hipFuncSetAttribute((const void*)phase_k<PH>, hipFuncAttributeMaxDynamicSharedMemorySize, LDS_BYTES) != hipSuccess) return false; return set_attr<PH + 1>(); }
    return true;
}
#else
DI void grid_barrier(unsigned target) {
    CPP pp = (CPP)__builtin_amdgcn_kernarg_segment_ptr(); asm volatile("" : "+s"(pp));
    unsigned* ctr = pp->err;
    asm volatile("s_waitcnt vmcnt(0)" ::: "memory");
    __syncthreads();
    if (tidx() == 0) {
        __builtin_amdgcn_fence(__ATOMIC_RELEASE, "agent");
        asm volatile("s_waitcnt vmcnt(0)" ::: "memory");
        __hip_atomic_fetch_add(ctr, 1u, __ATOMIC_RELAXED, __HIP_MEMORY_SCOPE_AGENT);
        const unsigned want = target * (unsigned)gdim();
        while (__hip_atomic_load(ctr, __ATOMIC_RELAXED, __HIP_MEMORY_SCOPE_AGENT) < want) __builtin_amdgcn_s_sleep(2);
        __builtin_amdgcn_fence(__ATOMIC_ACQUIRE, "agent");
        asm volatile("s_waitcnt vmcnt(0)" ::: "memory");
    }
    __syncthreads();
}
template <int PH>
DI void run_from(LAS char* lds) {
    if constexpr (PH < NPH) { run_phase<PH>(lds); if constexpr (PH + 1 < NPH) grid_barrier(PH + 1); run_from<PH + 1>(lds); }
}
__global__ void __launch_bounds__(512) mega(Params p_) {
    extern __shared__ __attribute__((aligned(16))) char smem_raw[];
    cg::this_grid().sync();
    run_from<0>((LAS char*)smem_raw);
}
#endif

extern "C" void kernel_launch(void* const* d_in, const int* in_sizes, int n_in, void* d_out, int out_size, void* d_ws, size_t ws_size, hipStream_t stream) {
    static int grid = 0;
    if (grid == 0) {
        int dev = 0, cus = 0, per_cu = 0;
        (void)hipGetDevice(&dev); (void)hipDeviceGetAttribute(&cus, hipDeviceAttributeMultiprocessorCount, dev);
#if MULTI_LAUNCH
        if (!set_attr<0>()) { fprintf(stderr, "kernel_launch: hipFuncSetAttribute failed\n"); grid = -1; return; }
        per_cu = 1;
#else
        if (hipFuncSetAttribute((const void*)mega, hipFuncAttributeMaxDynamicSharedMemorySize, LDS_BYTES) != hipSuccess) { fprintf(stderr, "kernel_launch: hipFuncSetAttribute failed\n"); grid = -1; return; }
        if (hipOccupancyMaxActiveBlocksPerMultiprocessor(&per_cu, (const void*)mega, 512, LDS_BYTES) != hipSuccess || per_cu < 1) { fprintf(stderr, "kernel_launch: occupancy query says %d blocks/CU\n", per_cu); per_cu = 1; }
        (void)hipGetLastError();
#endif
        grid = cus;
        if (n_in != 33 || out_size != T * D) { fprintf(stderr, "kernel_launch: unexpected problem shape\n"); grid = -1; return; }
    }
    if (grid < 0) return;
    Params p{};
    for (int i = 0; i < 33; ++i) p.in[i] = (const float*)d_in[i];
    p.out = (float*)d_out;
    size_t off = 0;
    auto take = [&](size_t bytes) { void* r = (char*)d_ws + off; off += (bytes + 255) & ~(size_t)255; return r; };
    p.WinT = (bf16_t*)take((size_t)NPAD * D * 2); p.WoutT = (bf16_t*)take((size_t)D * D * 2); p.gluT = (bf16_t*)take(512 * 512 * 2);
    p.w1T = (bf16_t*)take(2 * 256 * 2048 * 2); p.w2T = (bf16_t*)take(2 * 64 * 256 * 2);
    p.WguT = (bf16_t*)take((size_t)NEXP * 1024 * D * 2); p.WdT = (bf16_t*)take((size_t)NEXP * D * DEXP * 2); p.Wr = (float*)take(48 * D * 4);
    p.s5Bt = (bf16_t*)take(32 * 128 * 32 * 2); p.s5Ct = (bf16_t*)take(32 * 16 * 128 * 2); p.s5lam = (f32x2*)take(2 * 2048 * 8); p.bias1 = (float*)take(512 * 4);
    p.rope = (f32x2*)take(4096 * 32 * 8);
    p.xb = (bf16_t*)take((size_t)T * D * 2); p.rstd_mix = (float*)take(T * 4); p.rstd_ffn = (float*)take(T * 4);
    p.h = (float*)take((size_t)T * D * 4); p.proj = (bf16_t*)take((size_t)T * NPROJ * 2); p.small = (float*)take((size_t)T * NSMALL * 4);
    p.mix = (bf16_t*)take((size_t)T * D * 2); p.s5y = (bf16_t*)take((size_t)T * 512 * 2); p.s5E = (f32x2*)take((size_t)4 * 64 * 32 * 64 * 8);
    p.qn = (bf16_t*)take((size_t)T * 1024 * 2); p.ksn = (bf16_t*)take((size_t)T * 256 * 2); p.kwn = (bf16_t*)take((size_t)T * 256 * 2);
    p.vsT = (bf16_t*)take((size_t)T * 256 * 2); p.vwT = (bf16_t*)take((size_t)T * 256 * 2);
    p.kcmp = (bf16_t*)take(16 * 256 * 64 * 2); p.vcmpT = (bf16_t*)take(16 * 64 * 256 * 2);
    p.gP = (bf16_t*)take((size_t)1024 * 16384 * 2); p.gRT = (float*)take((size_t)1024 * 16384 * 4); p.gQp = (bf16_t*)take((size_t)1024 * 8192 * 2);
    p.gOU = (float*)take((size_t)1024 * 8192 * 4); p.gST = (bf16_t*)take((size_t)1024 * 16384 * 2); p.gA = (float*)take(1024 * 4);
    p.tok_list = (int*)take((size_t)NEXP * T * 4); p.w_list = (float*)take((size_t)NEXP * T * 4); p.tokinfo = (int*)take((size_t)T * 16);
    p.cnt = (int*)take(256 * 4); p.err = (unsigned*)take(256);
    p.hid = (bf16_t*)p.gRT;
    p.ybuf = p.proj;
    if (hipMemsetAsync(p.cnt, 0, 256 * 4 + 256, stream) != hipSuccess) { fprintf(stderr, "kernel_launch: memset failed\n"); return; }
    if (off > ws_size) { fprintf(stderr, "kernel_launch: workspace too small: need %zu have %zu\n", off, ws_size); return; }
#if MULTI_LAUNCH
    launch_phases<0>(p, grid, stream);
#else
    void* args[] = {&p};
    hipError_t e = hipLaunchCooperativeKernel((const void*)mega, dim3(grid), dim3(512), args, LDS_BYTES, stream);
    if (e != hipSuccess) fprintf(stderr, "kernel_launch: cooperative launch failed: %s (grid %d)\n", hipGetErrorString(e), grid);
#endif
}
```

```cpp
#include <hip/hip_runtime.h>
#include <hip/hip_cooperative_groups.h>
#include <cstdio>
#include <cstdint>
namespace cg = cooperative_groups;

#define DI __device__ __forceinline__
extern "C" __device__ size_t __ockl_get_num_groups(unsigned);
#define LAS __attribute__((address_space(3)))
typedef unsigned short bf16_t;
typedef short bf16x8 __attribute__((ext_vector_type(8)));
typedef short s16x4 __attribute__((ext_vector_type(4)));
typedef float f32x4 __attribute__((ext_vector_type(4)));
typedef float f32x2 __attribute__((ext_vector_type(2)));
typedef float f32x16 __attribute__((ext_vector_type(16)));
typedef unsigned u32x4 __attribute__((ext_vector_type(4)));
typedef unsigned u32x2 __attribute__((ext_vector_type(2)));

constexpr int D = 2048, BATCH = 4, SEQ = 4096, T = BATCH * SEQ, DEPTH = 2;
constexpr int DIN = 5176, NPROJ = 5120, NPAD = 5376, NSMALL = 64;
constexpr int C_U = 0, C_QKV = 512, C_Z = 2048, C_NQ = 2560, C_NKV = 3584;
constexpr int NEXP = 32, DEXP = 512;
constexpr int MOE_TILES_MAX = 160;
constexpr int NCHUNK = 64;
constexpr int LDS_BYTES = 160 * 1024;
constexpr float EPS = 1e-6f;

struct Params {
    const float* in[33];
    float* out;
    bf16_t* WinT; bf16_t* WoutT; bf16_t* gluT; bf16_t* w1T; bf16_t* w2T; bf16_t* WguT; bf16_t* WdT; float* Wr;
    bf16_t* s5Bt; bf16_t* s5Ct; f32x2* s5lam; float* bias1; f32x2* rope;
    bf16_t* xb; float* rstd_mix; float* rstd_ffn; float* h; bf16_t* proj; float* small; bf16_t* mix;
    bf16_t* s5y; f32x2* s5E;
    bf16_t* qn; bf16_t* ksn; bf16_t* kwn; bf16_t* vsT; bf16_t* vwT; bf16_t* kcmp; bf16_t* vcmpT;
    bf16_t* gP; float* gRT; bf16_t* gQp; float* gOU; bf16_t* gST; float* gA;
    int* tok_list; float* w_list; int* tokinfo; int* cnt; bf16_t* hid; bf16_t* ybuf;
    unsigned* err;
};

typedef const __attribute__((address_space(4))) Params& CP;
enum { I_X = 0, I_LN_MIX, I_W_IN, I_LAM_RE, I_LAM_IM, I_B_RE, I_B_IM, I_C_RE, I_C_IM, I_S5D, I_S5LOGDT, I_GLU_W, I_GLU_B,
       I_S5NORM, I_CONV_W, I_A_LOG, I_DT_BIAS, I_GDN_NORM, I_QNORM, I_KNORM, I_CMP_PE, I_CMP_W1, I_CMP_W2, I_NSA_NORM,
       I_W_OUT, I_LN_FFN, I_GROUP_W, I_GROUP_B, I_EXPERT_W, I_EXPERT_B, I_W_GATE, I_W_UP, I_W_DOWN };

DI bf16_t f2bf(float x) { unsigned r; asm("v_cvt_pk_bf16_f32 %0, %1, %1" : "=v"(r) : "v"(x)); return (bf16_t)r; }
DI float bf2f(bf16_t x) { return __uint_as_float(((unsigned)x) << 16); }
DI unsigned pk2(float lo, float hi) { unsigned r; asm("v_cvt_pk_bf16_f32 %0, %1, %2" : "=v"(r) : "v"(lo), "v"(hi)); return r; }
DI unsigned pk2h(float lo, float hi) { unsigned r; asm("v_cvt_pk_bf16_f32 %0, %1, %2" : "=v"(r) : "v"(lo), "v"(hi)); return r; }
DI float sigmoidf_(float x) { return __builtin_amdgcn_rcpf(1.f + __expf(-x)); }
DI float siluf_(float x) { return x * __builtin_amdgcn_rcpf(1.f + __expf(-x)); }
DI float gelu_tanh(float x) { const float u = 0.7978845608028654f * (x + 0.044715f * x * x * x); const float e = __expf(2.f * u); const float th = 1.f - 2.f * __builtin_amdgcn_rcpf(e + 1.f); return 0.5f * x * (1.f + th); }
DI float softplusf_(float x) { return x > 20.f ? x : log1pf(__expf(x)); }
DI int my_lane() { int l = (int)__builtin_amdgcn_mbcnt_hi(~0u, __builtin_amdgcn_mbcnt_lo(~0u, 0u)); asm volatile("" : "+v"(l)); return l; }
template <int M> DI float shflx(float v) {
    if constexpr (M < 32) return __builtin_bit_cast(float, __builtin_amdgcn_ds_swizzle(__builtin_bit_cast(int, v), 0x1f | (M << 10)));
    else return __builtin_bit_cast(float, __builtin_amdgcn_ds_bpermute((my_lane() ^ M) << 2, __builtin_bit_cast(int, v)));
}
DI int shfl_up_i(int v, int o, int lane) { return __builtin_amdgcn_ds_bpermute(((lane - o) & 63) << 2, v); }
DI float shfl_up_f(float v, int o, int lane) { return __builtin_bit_cast(float, __builtin_amdgcn_ds_bpermute(((lane - o) & 63) << 2, __builtin_bit_cast(int, v))); }
DI int shfl_idx_i(int v, int src) { return __builtin_amdgcn_ds_bpermute(src << 2, v); }
DI float wave_sum(float v) {
    v += shflx<1>(v); v += shflx<2>(v); v += shflx<4>(v); v += shflx<8>(v); v += shflx<16>(v); v += shflx<32>(v);
    return v;
}
DI int tidx() { int t = __builtin_amdgcn_workitem_id_x(); asm volatile("" : "+v"(t)); return t; }
DI int bidx() { int b = __builtin_amdgcn_workgroup_id_x(); asm volatile("" : "+s"(b)); return b; }
DI int gdim() { int g = (int)__ockl_get_num_groups(0); asm volatile("" : "+s"(g)); return g; }
DI void lds_wait() { asm volatile("s_waitcnt lgkmcnt(0)" ::: "memory"); }
#define SETTLE_NOPS "s_nop 15\n\ts_nop 15"
DI void settle(f32x4& a) { asm volatile(SETTLE_NOPS : "+v"(a)); }
DI void settle(f32x4& a, f32x4& b) { asm volatile(SETTLE_NOPS : "+v"(a), "+v"(b)); }
DI void settle(f32x4& a, f32x4& b, f32x4& c, f32x4& d) { asm volatile(SETTLE_NOPS : "+v"(a), "+v"(b), "+v"(c), "+v"(d)); }
DI void settle(f32x4& a, f32x4& b, f32x4& c, f32x4& d, f32x4& e, f32x4& f, f32x4& g, f32x4& h) { asm volatile(SETTLE_NOPS : "+v"(a), "+v"(b), "+v"(c), "+v"(d), "+v"(e), "+v"(f), "+v"(g), "+v"(h)); }
DI void settle(f32x16& a) { asm volatile(SETTLE_NOPS : "+v"(a)); }
DI void settle(f32x16& a, f32x16& b) { asm volatile(SETTLE_NOPS : "+v"(a), "+v"(b)); }
#define MFMA16(a, b, c) __builtin_amdgcn_mfma_f32_16x16x32_bf16((a), (b), (c), 0, 0, 0)
#define MFMA32(a, b, c) __builtin_amdgcn_mfma_f32_32x32x16_bf16((a), (b), (c), 0, 0, 0)

namespace g8 {
constexpr int BM = 256, BK = 64, HALF = 128, HT = HALF * BK;
DI int lds_byte(int r, int c) { int st = (r >> 4) * 2 + (c >> 5), rr = r & 15, cc = c & 31, ob = rr * 64 + cc * 2; return st * 1024 + (ob ^ (((ob >> 9) & 1) << 5)); }
DI void stage_rc(int b, int& R, int& C) { int st = b / 1024, sb = b % 1024, swz = sb ^ (((sb >> 9) & 1) << 5); R = (st >> 1) * 16 + swz / 64; C = (st & 1) * 32 + (swz % 64) / 2; }

template <class Epi>
DI void gemm_tile(LAS char* lds, const char* aBase, const unsigned (&aoff)[2][2], long akt, const char* bBase, const unsigned (&boff)[2], long bhalf, int nt, Epi&& epi) {
    const int tid = tidx(), wid = __builtin_amdgcn_readfirstlane(tid >> 6), lane = tid & 63, wr = wid >> 2, wc = wid & 3, fr = lane & 15, fq = lane >> 4;
    const unsigned ldsw = (unsigned)wid * 1024u;
    const int lrA = lds_byte(wr * 64 + fr, fq * 8), lrB = lds_byte(wc * 32 + fr, fq * 8);
#define G8_SA(b, h) (((b) * 2 + (h)) * (HT * 2))
#define G8_SB(b, h) ((4 + (b) * 2 + (h)) * (HT * 2))
#define G8_STAGE_A(bufoff, h, kt) do { const char* _b = aBase + (long)(kt) * akt; _Pragma("unroll") for (int _i = 0; _i < 2; ++_i) \
        __builtin_amdgcn_global_load_lds((const unsigned*)(_b + aoff[h][_i]), (LAS unsigned*)(lds + (bufoff) + ldsw + _i * 8192), 16, 0, 0); } while (0)
#define G8_STAGE_B(bufoff, h, kt) do { const char* _b = bBase + (long)(h) * bhalf + (long)(kt) * 128; _Pragma("unroll") for (int _i = 0; _i < 2; ++_i) \
        __builtin_amdgcn_global_load_lds((const unsigned*)(_b + boff[_i]), (LAS unsigned*)(lds + (bufoff) + ldsw + _i * 8192), 16, 0, 0); } while (0)
#define G8_LDA(dst, b, h) do { _Pragma("unroll") for (int m = 0; m < 4; ++m) _Pragma("unroll") for (int k = 0; k < 2; ++k) dst[m][k] = *(const LAS bf16x8*)(lds + G8_SA(b, h) + lrA + m * 2048 + k * 1024); } while (0)
#define G8_LDB(dst, b, h) do { _Pragma("unroll") for (int n = 0; n < 2; ++n) _Pragma("unroll") for (int k = 0; k < 2; ++k) dst[n][k] = *(const LAS bf16x8*)(lds + G8_SB(b, h) + lrB + n * 2048 + k * 1024); } while (0)
#define G8_MMA(ai, bj, At, Bt) do { __builtin_amdgcn_s_setprio(1); _Pragma("unroll") for (int m = 0; m < 4; ++m) _Pragma("unroll") for (int n = 0; n < 2; ++n) _Pragma("unroll") for (int k = 0; k < 2; ++k) \
        acc[ai][bj][m][n] = MFMA16(Bt[n][k], At[m][k], acc[ai][bj][m][n]); __builtin_amdgcn_s_setprio(0); } while (0)
#define G8_WAIT_V(n) asm volatile("s_waitcnt vmcnt(" #n ")" ::: "memory")
#define G8_WAIT_L(n) asm volatile("s_waitcnt lgkmcnt(" #n ")" ::: "memory")
#define G8_BAR __builtin_amdgcn_s_barrier()
#define G8_SCHED __builtin_amdgcn_sched_barrier(0)
    f32x4 acc[2][2][4][2];
#pragma unroll
    for (int a = 0; a < 2; ++a)
#pragma unroll
        for (int b = 0; b < 2; ++b)
#pragma unroll
            for (int m = 0; m < 4; ++m)
#pragma unroll
                for (int n = 0; n < 2; ++n) acc[a][b][m][n] = (f32x4){0.f, 0.f, 0.f, 0.f};
    bf16x8 At[4][2], B0[2][2], B1[2][2];
    G8_STAGE_B(G8_SB(0, 0), 0, 0); G8_STAGE_A(G8_SA(0, 0), 0, 0); G8_STAGE_B(G8_SB(0, 1), 1, 0); G8_STAGE_A(G8_SA(0, 1), 1, 0);
    if (wr == 1) G8_BAR;
    G8_WAIT_V(4); G8_BAR;
    G8_STAGE_B(G8_SB(1, 0), 0, 1); G8_STAGE_A(G8_SA(1, 0), 0, 1); G8_STAGE_B(G8_SB(1, 1), 1, 1);
    G8_WAIT_V(6); G8_BAR;
    for (int t = 0; t < nt - 2; t += 2) {
        G8_LDB(B0, 0, 0); G8_SCHED; G8_LDA(At, 0, 0); G8_STAGE_A(G8_SA(1, 1), 1, t + 1);
        G8_WAIT_L(8); G8_BAR; G8_WAIT_L(0); G8_MMA(0, 0, At, B0); G8_BAR; G8_SCHED;
        G8_LDB(B1, 0, 1); G8_STAGE_B(G8_SB(0, 0), 0, t + 2);
        G8_BAR; G8_WAIT_L(0); G8_MMA(0, 1, At, B1); G8_BAR;
        G8_LDA(At, 0, 1); G8_STAGE_A(G8_SA(0, 0), 0, t + 2);
        G8_BAR; G8_WAIT_L(0); G8_MMA(1, 0, At, B0); G8_BAR; G8_SCHED;
        G8_STAGE_B(G8_SB(0, 1), 1, t + 2);
        G8_WAIT_V(6); G8_BAR; G8_MMA(1, 1, At, B1); G8_BAR;
        G8_LDB(B0, 1, 0); G8_SCHED; G8_LDA(At, 1, 0); G8_STAGE_A(G8_SA(0, 1), 1, t + 2);
        G8_WAIT_L(8); G8_BAR; G8_WAIT_L(0); G8_MMA(0, 0, At, B0); G8_BAR; G8_SCHED;
        G8_LDB(B1, 1, 1); G8_STAGE_B(G8_SB(1, 0), 0, t + 3);
        G8_BAR; G8_WAIT_L(0); G8_MMA(0, 1, At, B1); G8_BAR;
        G8_LDA(At, 1, 1); G8_STAGE_A(G8_SA(1, 0), 0, t + 3);
        G8_BAR; G8_WAIT_L(0); G8_MMA(1, 0, At, B0); G8_BAR; G8_SCHED;
        G8_STAGE_B(G8_SB(1, 1), 1, t + 3);
        G8_WAIT_V(6); G8_BAR; G8_MMA(1, 1, At, B1); G8_BAR;
    }
    { G8_LDB(B0, 0, 0); G8_LDA(At, 0, 0); G8_STAGE_A(G8_SA(1, 1), 1, nt - 1);
      G8_BAR; G8_WAIT_L(0); G8_MMA(0, 0, At, B0); G8_BAR;
      G8_LDB(B1, 0, 1); G8_BAR; G8_WAIT_L(0); G8_MMA(0, 1, At, B1); G8_BAR;
      G8_LDA(At, 0, 1); G8_WAIT_V(4); G8_BAR; G8_WAIT_L(0); G8_MMA(1, 0, At, B0); G8_MMA(1, 1, At, B1); G8_BAR; }
    { G8_LDB(B0, 1, 0); G8_LDA(At, 1, 0); G8_WAIT_V(2); G8_BAR; G8_WAIT_L(0); G8_MMA(0, 0, At, B0); G8_BAR;
      G8_LDB(B1, 1, 1); G8_WAIT_V(0); G8_BAR; G8_WAIT_L(0); G8_MMA(0, 1, At, B1); G8_BAR;
      G8_LDA(At, 1, 1); G8_BAR; G8_WAIT_L(0); G8_MMA(1, 0, At, B0); G8_MMA(1, 1, At, B1); G8_BAR; }
    if (wr == 0) G8_BAR;
    asm volatile(SETTLE_NOPS : "+v"(acc[0][0][0][0]), "+v"(acc[0][0][0][1]), "+v"(acc[0][0][1][0]), "+v"(acc[0][0][1][1]), "+v"(acc[0][0][2][0]), "+v"(acc[0][0][2][1]), "+v"(acc[0][0][3][0]), "+v"(acc[0][0][3][1]),
                 "+v"(acc[0][1][0][0]), "+v"(acc[0][1][0][1]), "+v"(acc[0][1][1][0]), "+v"(acc[0][1][1][1]), "+v"(acc[0][1][2][0]), "+v"(acc[0][1][2][1]), "+v"(acc[0][1][3][0]), "+v"(acc[0][1][3][1]));
    asm volatile("" : "+v"(acc[1][0][0][0]), "+v"(acc[1][0][0][1]), "+v"(acc[1][0][1][0]), "+v"(acc[1][0][1][1]), "+v"(acc[1][0][2][0]), "+v"(acc[1][0][2][1]), "+v"(acc[1][0][3][0]), "+v"(acc[1][0][3][1]),
                 "+v"(acc[1][1][0][0]), "+v"(acc[1][1][0][1]), "+v"(acc[1][1][1][0]), "+v"(acc[1][1][1][1]), "+v"(acc[1][1][2][0]), "+v"(acc[1][1][2][1]), "+v"(acc[1][1][3][0]), "+v"(acc[1][1][3][1]));
    epi(acc, wr * 64 + fr, wc * 32 + 4 * fq);
#undef G8_SA
#undef G8_SB
#undef G8_STAGE_A
#undef G8_STAGE_B
#undef G8_LDA
#undef G8_LDB
#undef G8_MMA
}
DI void my_rc(int i, int& R, int& C) { stage_rc(tidx() * 16 + i * 8192, R, C); }
DI bool unit_of(int L, int nM, int nN, int& pm, int& pn) {
    const int nwg = nM * nN; if (L >= nwg) return false;
    int wgid = L; { const int q = nwg / 8, r = nwg % 8, xcd = wgid % 8, off = wgid / 8; wgid = (xcd < r ? xcd * (q + 1) : r * (q + 1) + (xcd - r) * q) + off; }
    const int nig = 8 * nN, gid = wgid / nig, fm = gid * 8, gsz = (nM - fm) < 8 ? (nM - fm) : 8;
    pm = fm + ((wgid % nig) % gsz); pn = (wgid % nig) / gsz; return true;
}
}

typedef f32x4 Acc[2][2][4][2];
#define ACC_FOR(ai, m, bj, n) _Pragma("unroll") for (int ai = 0; ai < 2; ++ai) _Pragma("unroll") for (int m = 0; m < 4; ++m) _Pragma("unroll") for (int bj = 0; bj < 2; ++bj) _Pragma("unroll") for (int n = 0; n < 2; ++n)

DI bf16x8 ld8(const bf16_t* q) { return *(const bf16x8*)q; }
DI bf16x8 ld8(const LAS bf16_t* q) { return *(const LAS bf16x8*)q; }
template <int KS, class PA, class PB>
DI f32x4 mma_tile(PA arow, PB brow, f32x4 acc) {
#pragma unroll
    for (int ks = 0; ks < KS; ++ks) acc = MFMA16(ld8(arow + ks * 32), ld8(brow + ks * 32), acc);
    settle(acc);
    return acc;
}
#define ZERO4 ((f32x4){0.f, 0.f, 0.f, 0.f})

constexpr long LW_WIN = (long)NPAD * D, LW_WOUT = (long)D * D, LW_GLU = 512L * 512, LW_W1 = 2L * 256 * 2048, LW_W2 = 2L * 64 * 256, LW_WGU = (long)NEXP * 1024 * D, LW_WD = (long)NEXP * D * DEXP;
struct TDesc { const float* src; bf16_t* dst; int src_ld, dst_ld, nvalid, gu  , which, ntl; };
#ifndef TCONV_TAIL
#define TCONV_TAIL 2560
#endif
constexpr int TCONV_EARLY = 320 + 320 + 64, TCONV_FULL = TCONV_EARLY + 256 + 16 + 4096 + 2048, TCONV_TILES = TCONV_FULL + 72;
struct TBase { const float *win, *wout, *glu, *w1, *w2, *gate, *up, *down; bf16_t *WinT, *WoutT, *gluT, *w1T, *w2T, *WguT, *WdT; };
DI void tconv_base(CP p, int l, TBase& b) {
    b.win = p.in[I_W_IN] + (long)l * D * DIN; b.wout = p.in[I_W_OUT] + (long)l * D * D; b.glu = p.in[I_GLU_W] + (long)l * 512 * 512;
    b.w1 = p.in[I_CMP_W1] + (long)l * 2 * 2048 * 256; b.w2 = p.in[I_CMP_W2] + (long)l * 2 * 256 * 64;
    b.gate = p.in[I_W_GATE] + (long)l * NEXP * D * DEXP; b.up = p.in[I_W_UP] + (long)l * NEXP * D * DEXP; b.down = p.in[I_W_DOWN] + (long)l * NEXP * DEXP * D;
    b.WinT = p.WinT + l * LW_WIN; b.WoutT = p.WoutT + l * LW_WOUT; b.gluT = p.gluT + l * LW_GLU; b.w1T = p.w1T + l * LW_W1; b.w2T = p.w2T + l * LW_W2; b.WguT = p.WguT + l * LW_WGU; b.WdT = p.WdT + l * LW_WD;
}
DI void tconv_desc(const TBase& b, int idx, TDesc& d) {
    auto lin = [&](const float* src, int src_ld, bf16_t* dst, int dst_ld, int K, int N, int t) {
        const int nkt = K / 64, kt = t % nkt, ntl = t / nkt;
        d.src = src + (long)kt * 64 * src_ld + ntl * 256; d.src_ld = src_ld; d.nvalid = min(256, N - ntl * 256);
        d.dst = dst + (long)ntl * 256 * dst_ld + kt * 64; d.dst_ld = dst_ld; d.gu = 0; d.which = 0; d.ntl = ntl; };
    int t = idx;
    if (t < 320) { lin(b.win, DIN, b.WinT, D, D, 2560, t); return; } t -= 320;
    if (t < 320) { lin(b.win + 2568, DIN, b.WinT + 2560L * D, D, D, 2560, t); return; } t -= 320;
    if (t < 64) { const int kv = t >> 5; lin(b.w1 + (long)kv * 2048 * 256, 256, b.w1T + (long)kv * 256 * 2048, 2048, 2048, 256, t & 31); return; } t -= 64;
    if (t < 256) { lin(b.wout, D, b.WoutT, D, D, D, t); return; } t -= 256;
    if (t < 16) { lin(b.glu, 512, b.gluT, 512, 512, 512, t); return; } t -= 16;
    if (t < 4096) { const int e = t >> 7, which = (t >> 6) & 1, r = t & 63, kt = r & 31, ntl = r >> 5;
        d.src = (which ? b.up : b.gate) + (long)e * D * DEXP + (long)kt * 64 * DEXP + ntl * 256; d.src_ld = DEXP; d.nvalid = 256;
        d.dst = b.WguT + (long)e * 1024 * D + kt * 64; d.dst_ld = D; d.gu = 1; d.which = which; d.ntl = ntl; return; } t -= 4096;
    if (t < 2048) { const int e = t >> 6, r = t & 63; lin(b.down + (long)e * DEXP * D, D, b.WdT + (long)e * D * DEXP, DEXP, DEXP, D, r); return; } t -= 2048;
    if (t < 32) { lin(b.win + 2560, DIN, b.WinT + 5120L * D, D, D, 8, t); return; } t -= 32;
    if (t < 32) { lin(b.win + 5128, DIN, b.WinT + 5128L * D, D, D, 48, t); return; } t -= 32;
    { const int kv = t >> 2; lin(b.w2 + (long)kv * 256 * 64, 64, b.w2T + (long)kv * 64 * 256, 256, 256, 64, t & 3); }
}
DI void tconv_load(const TDesc& d, f32x4 (&v)[8]) {
    const int tid = tidx(), n4 = (tid & 63) * 4, kb = tid >> 6;
#pragma unroll
    for (int i = 0; i < 8; ++i) { const int kk = kb + 8 * i; const float* s = d.src + (long)kk * d.src_ld + n4;
        if (n4 + 3 < d.nvalid) v[i] = *(const f32x4*)s;
        else { v[i] = (f32x4){0.f, 0.f, 0.f, 0.f};
#pragma unroll
            for (int e = 0; e < 4; ++e) if (n4 + e < d.nvalid) v[i][e] = s[e]; } }
}
DI void tconv_store(LAS float* scr, const TDesc& d, f32x4 (&v)[8]) {
    const int tid = tidx(), n4 = (tid & 63) * 4, kb = tid >> 6;
    constexpr int LS = 260;
#pragma unroll
    for (int i = 0; i < 8; ++i) { const int kk = kb + 8 * i; *(LAS f32x4*)(scr + kk * LS + 4 * ((n4 >> 2) ^ ((kk >> 3) & 7))) = v[i]; }
    __syncthreads();
#pragma unroll
    for (int i = 0; i < 4; ++i) { const int q = tid + 512 * i, nn = q >> 3, c = q & 7;
        if (nn < d.nvalid) { u32x4 o; const LAS float* s = scr + (8 * c) * LS + 4 * ((nn >> 2) ^ c) + (nn & 3);
            o.x = pk2h(s[0], s[LS]); o.y = pk2h(s[2 * LS], s[3 * LS]); o.z = pk2h(s[4 * LS], s[5 * LS]); o.w = pk2h(s[6 * LS], s[7 * LS]);
            const int n = d.ntl * 256 + nn;
            bf16_t* row = d.gu ? d.dst + (long)((n >> 7) * 256 + d.which * 128 + (n & 127)) * d.dst_ld : d.dst + (long)nn * d.dst_ld;
            *(u32x4*)(row + 8 * c) = o; } }
    __syncthreads();
}
DI void tconv_issue(const TBase& b, int hidx, LAS char* buf) {
    TDesc d; tconv_desc(b, hidx >> 1, d);
    const int lane = my_lane(), w = __builtin_amdgcn_readfirstlane(tidx() >> 6);
    const float* s = d.src + (hidx & 1) * 128 + 4 * ((lane & 31) ^ w);
#pragma unroll
    for (int i = 0; i < 4; ++i) { const int r = 2 * (w * 4 + i) + (lane >> 5);
        __builtin_amdgcn_global_load_lds((const unsigned*)(s + (long)r * d.src_ld), (LAS unsigned*)(buf + (w * 4 + i) * 1024), 16, 0, 2); }
}
DI void tconv_emit(const TBase& b, int hidx, LAS char* buf) {
    TDesc d; tconv_desc(b, hidx >> 1, d);
    const int tid = tidx(), half = hidx & 1;
    const LAS float* sb = (const LAS float*)buf;
#pragma unroll
    for (int it = 0; it < 2; ++it) { const int q = tid + 512 * it, nn = q >> 3, c = q & 7;
        const LAS float* s = sb + (8 * c) * 128 + 4 * ((nn >> 2) ^ c) + (nn & 3);
        u32x4 o; o.x = pk2h(s[0], s[128]); o.y = pk2h(s[256], s[384]); o.z = pk2h(s[512], s[640]); o.w = pk2h(s[768], s[896]);
        const int nl = half * 128 + nn, n = d.ntl * 256 + nl;
        bf16_t* row = d.gu ? d.dst + (long)((n >> 7) * 256 + d.which * 128 + (n & 127)) * d.dst_ld : d.dst + (long)nl * d.dst_ld;
        *(u32x4*)(row + 8 * c) = o; }
}
DI void tconv_range(CP p, int l, int lo, int hi, int bi, int nb, LAS char* lds) {
    const int h0 = 2 * lo + bi, hN = 2 * hi;
    const int nk = h0 < hN ? (hN - 1 - h0) / nb + 1 : 0;
    if (nk <= 0) return;
    TBase b; tconv_base(p, l, b);
    __syncthreads();
#pragma unroll
    for (int j = 0; j < 4; ++j) tconv_issue(b, h0 + min(j, nk - 1) * nb, lds + j * 32768);
    for (int k = 0; k < nk; ++k) {
        if (k < 3) asm volatile("s_waitcnt vmcnt(12)" ::: "memory"); else asm volatile("s_waitcnt vmcnt(18)" ::: "memory");
        __builtin_amdgcn_s_barrier();
        tconv_emit(b, h0 + k * nb, lds + (k & 3) * 32768);
        asm volatile("s_waitcnt lgkmcnt(0)" ::: "memory");
        __builtin_amdgcn_s_barrier();
        tconv_issue(b, h0 + min(k + 4, nk - 1) * nb, lds + (k & 3) * 32768);
    }
    asm volatile("s_waitcnt vmcnt(0)" ::: "memory");
    __syncthreads();
}
DI void tconv_narrow(CP p, int l, int bi, int nb, LAS char* lds) {
    LAS float* scr = (LAS float*)lds;
    TBase b; tconv_base(p, l, b);
    for (int idx = TCONV_FULL + bi; idx < TCONV_TILES; idx += nb) { TDesc d; f32x4 v[8]; tconv_desc(b, idx, d); tconv_load(d, v); tconv_store(scr, d, v); }
    { unsigned* z = (unsigned*)(p.WinT + l * LW_WIN + (long)DIN * D); for (long i = (long)bi * 512 + tidx(); i < (long)(NPAD - DIN) * D / 2; i += (long)nb * 512) z[i] = 0u; }
}
DI void p0_tables(CP p, int l, LAS char* lds) {
    const float* lnf = p.in[I_LN_FFN] + l * D;
    const long gtid = (long)bidx() * 512 + tidx(), nth = (long)gdim() * 512;
    for (long i = gtid; i < 48L * D; i += nth) { const int n = (int)(i / D), k = (int)(i % D); float v = 0.f;
        if (n < 4) v = p.in[I_GROUP_W][((long)l * D + k) * 4 + n]; else if (n < 36) v = p.in[I_EXPERT_W][((long)l * D + k) * 32 + (n - 4)];
        p.Wr[i] = v * lnf[k]; }
    for (int blk = bidx(); blk < 64; blk += gdim()) {
        LAS float* cc = (LAS float*)lds;
        __syncthreads();
        if (tidx() < 32) { const int i = blk * 32 + tidx(), g = i >> 6, pp = i & 63;
            const float a = p.in[I_LAM_RE][(l * 32 + g) * 64 + pp], w = p.in[I_LAM_IM][(l * 32 + g) * 64 + pp], dt = __expf(p.in[I_S5LOGDT][l * 32 + g]);
            const float ea = expf(a * dt); float sn, cs; sincosf(w * dt, &sn, &cs);
            const float lr = ea * cs, li = ea * sn;
            const float sh = sinf(0.5f * w * dt); const float lr1 = expm1f(a * dt) * cs - 2.f * sh * sh;
            const float den = 1.f / (a * a + w * w);
            cc[2 * tidx()] = (lr1 * a + li * w) * den; cc[2 * tidx() + 1] = (li * a - lr1 * w) * den;
            p.s5lam[g * 64 + pp] = (f32x2){lr, li};
            { const float e64 = expf(a * dt * 64.f); float s6, c6; sincosf(w * dt * 64.f, &s6, &c6); p.s5lam[2048 + g * 64 + pp] = (f32x2){e64 * c6, e64 * s6}; } }
        __syncthreads();
        { const int pr = tidx() >> 4, hh = tidx() & 15, i = blk * 32 + pr, g = i >> 6, pp = i & 63;
            const float cr = cc[2 * pr], ci = cc[2 * pr + 1];
            const float br = p.in[I_B_RE][((long)(l * 32 + g) * 64 + pp) * 16 + hh], bi = p.in[I_B_IM][((long)(l * 32 + g) * 64 + pp) * 16 + hh];
            p.s5Bt[((long)g * 128 + pp) * 32 + hh] = f2bf(cr * br - ci * bi); p.s5Bt[((long)g * 128 + pp) * 32 + 16 + hh] = 0;
            p.s5Bt[((long)g * 128 + 64 + pp) * 32 + hh] = f2bf(cr * bi + ci * br); p.s5Bt[((long)g * 128 + 64 + pp) * 32 + 16 + hh] = 0;
            p.s5Ct[((long)g * 16 + hh) * 128 + pp] = f2bf(p.in[I_C_RE][((long)(l * 32 + g) * 16 + hh) * 64 + pp]);
            p.s5Ct[((long)g * 16 + hh) * 128 + 64 + pp] = f2bf(-p.in[I_C_IM][((long)(l * 32 + g) * 16 + hh) * 64 + pp]); }
    }
    __syncthreads();
    {
        const int gw = bidx() * 8 + __builtin_amdgcn_readfirstlane(tidx() >> 6), nw = gdim() * 8, lane = tidx() & 63;
        for (int o = gw; o < 512; o += nw) { const int kv = o >> 8, n = o & 255; float s = 0.f;
            const float* pe = p.in[I_CMP_PE] + (long)(l * 2 + kv) * 2048; const float* w1 = p.in[I_CMP_W1] + (long)(l * 2 + kv) * 2048 * 256 + n;
#pragma unroll
            for (int kk = 0; kk < 32; ++kk) { const int k = lane + 64 * kk; s += pe[k] * w1[(long)k * 256]; }
            s = wave_sum(s); if (lane == 0) p.bias1[o] = s; }
    }
}
DI void p0_once(CP p) {
    const long gtid = (long)bidx() * 512 + tidx(), nth = (long)gdim() * 512;
    for (long i = gtid; i < 4096L * 32; i += nth) { const int pos = (int)(i >> 5), k = (int)(i & 31);
        const float invf = exp2f(-(float)k * (13.287712379549449f / 32.f)); const float ang = (float)pos * invf; float s, c; sincosf(ang, &s, &c); p.rope[i] = (f32x2){c, s}; }
    for (long i = gtid; i < 256; i += nth) p.cnt[i] = 0;
}

DI void p1_rows(CP p, int mode, int lprev, int lnext) {
    const int lane = tidx() & 63, gw = bidx() * 8 + __builtin_amdgcn_readfirstlane(tidx() >> 6), nw = gdim() * 8;
    int ts = 0;
    if (mode > 0) { int c = lane < 32 ? p.cnt[lprev * 32 + lane] : 0; int ntl = (c + 255) >> 8; int inc = ntl;
#pragma unroll
        for (int o = 1; o < 32; o <<= 1) { int v = shfl_up_i(inc, o, lane); if ((lane & 31) >= o) inc += v; }
        ts = inc - ntl; }
    for (int t = gw; t < T; t += nw) {
        f32x4 v[8]; float ss = 0.f;
        if (mode == 0) {
            const f32x4* xr = (const f32x4*)(p.in[I_X] + (long)t * D);
#pragma unroll
            for (int j = 0; j < 8; ++j) v[j] = xr[j * 64 + lane];
        } else {
            const int* ti = p.tokinfo + (long)t * 4; const int e0 = ti[0], p0 = ti[1], e1 = ti[2], p1 = ti[3];
            const long s0 = (long)shfl_idx_i(ts, e0) * 256 + p0, s1 = (long)shfl_idx_i(ts, e1) * 256 + p1;
            const f32x4* hr = (const f32x4*)(p.h + (long)t * D);
            const u32x2* y0 = (const u32x2*)(p.ybuf + s0 * D); const u32x2* y1 = (const u32x2*)(p.ybuf + s1 * D);
#pragma unroll
            for (int j = 0; j < 8; ++j) { f32x4 a = hr[j * 64 + lane]; const u32x2 b0 = y0[j * 64 + lane], b1 = y1[j * 64 + lane];
                a[0] += __uint_as_float(b0.x << 16) + __uint_as_float(b1.x << 16); a[1] += __uint_as_float(b0.x & 0xffff0000u) + __uint_as_float(b1.x & 0xffff0000u);
                a[2] += __uint_as_float(b0.y << 16) + __uint_as_float(b1.y << 16); a[3] += __uint_as_float(b0.y & 0xffff0000u) + __uint_as_float(b1.y & 0xffff0000u);
                v[j] = a; }
        }
#ifdef TPROBE
        if (mode == 2) { const float sc = 1.f + (TPROBE_SEL == 5 ? 2e-3f * (float)p.err[3445] : 2e-5f * (float)p.err[3440]);
#pragma unroll
            for (int j = 0; j < 8; ++j) v[j] *= sc; }
#endif
        if (mode >= 1) { f32x4* o = (f32x4*)(p.out + (long)t * D);
#pragma unroll
            for (int j = 0; j < 8; ++j) o[j * 64 + lane] = v[j]; }
        if (mode <= 1) {
#pragma unroll
            for (int j = 0; j < 8; ++j) ss += v[j][0] * v[j][0] + v[j][1] * v[j][1] + v[j][2] * v[j][2] + v[j][3] * v[j][3];
            ss = wave_sum(ss);
            if (lane == 0) p.rstd_mix[t] = rsqrtf(ss * (1.f / D) + EPS);
            u32x2* xo = (u32x2*)(p.xb + (long)t * D); const f32x4* gn = (const f32x4*)(p.in[I_LN_MIX] + lnext * D);
#pragma unroll
            for (int j = 0; j < 8; ++j) { const f32x4 g4 = gn[j * 64 + lane]; u32x2 w; w.x = pk2h(v[j][0] * g4[0], v[j][1] * g4[1]); w.y = pk2h(v[j][2] * g4[2], v[j][3] * g4[3]); xo[j * 64 + lane] = w; }
        }
    }
}

DI void inproj_narrow(CP p, int l, LAS char* lds) {
    const int tid = tidx(), lane = tid & 63, w = __builtin_amdgcn_readfirstlane(tid >> 6), fr = lane & 15, fq = lane >> 4;
    constexpr int XS = 2056;
    LAS bf16_t* X = (LAS bf16_t*)lds;
    LAS float* red = (LAS float*)lds;
    bf16x8 bw[8][4];
    { const bf16_t* wb = p.WinT + l * LW_WIN + (long)(NPROJ + fr) * D + w * 256 + 8 * fq;
#pragma unroll
      for (int ks = 0; ks < 8; ++ks)
#pragma unroll
          for (int nt = 0; nt < 4; ++nt) bw[ks][nt] = ld8(wb + (long)nt * 16 * D + ks * 32); }
    const LAS bf16_t* xa = X + fr * XS + w * 256 + 8 * fq;
    for (int item = bidx(); item < T / 32; item += gdim()) {
        const long tok0 = (long)item * 32;
        __syncthreads();
#pragma unroll
        for (int i = 0; i < 16; ++i) { const int e = tid + i * 512, r = e >> 8, c = e & 255; *(LAS u32x4*)(X + r * XS + c * 8) = *(const u32x4*)(p.xb + (tok0 + r) * D + c * 8); }
        __syncthreads();
        f32x4 acc[2][4];
#pragma unroll
        for (int mt = 0; mt < 2; ++mt)
#pragma unroll
            for (int nt = 0; nt < 4; ++nt) acc[mt][nt] = ZERO4;
#pragma unroll
        for (int ks = 0; ks < 8; ++ks) {
            bf16x8 a[2];
#pragma unroll
            for (int mt = 0; mt < 2; ++mt) a[mt] = ld8(xa + mt * 16 * XS + ks * 32);
#pragma unroll
            for (int mt = 0; mt < 2; ++mt)
#pragma unroll
                for (int nt = 0; nt < 4; ++nt) acc[mt][nt] = MFMA16(bw[ks][nt], a[mt], acc[mt][nt]);
        }
        settle(acc[0][0], acc[0][1], acc[0][2], acc[0][3], acc[1][0], acc[1][1], acc[1][2], acc[1][3]);
        __syncthreads();
#pragma unroll
        for (int mt = 0; mt < 2; ++mt)
#pragma unroll
            for (int nt = 0; nt < 4; ++nt) *(LAS f32x4*)(red + (w * 32 + mt * 16 + fr) * 64 + nt * 16 + 4 * fq) = acc[mt][nt];
        __syncthreads();
        { const int r = tid >> 4, c4 = (tid & 15) * 4; f32x4 s = ZERO4;
#pragma unroll
          for (int ww = 0; ww < 8; ++ww) s += *(const LAS f32x4*)(red + (ww * 32 + r) * 64 + c4);
          if (c4 < 56) *(f32x4*)(p.small + (tok0 + r) * NSMALL + c4) = s * p.rstd_mix[tok0 + r]; }
    }
    __syncthreads();
}
DI void p2_inproj(CP p, int l, LAS char* lds) {
    unsigned aoff[2][2], boff[2];
#pragma unroll
    for (int i = 0; i < 2; ++i) { int R, C; g8::my_rc(i, R, C); boff[i] = (unsigned)(R * D + C) * 2u; aoff[0][i] = boff[i]; aoff[1][i] = (unsigned)((128 + R) * D + C) * 2u; }
    for (int u = bidx();; u += gdim()) {
        int pm, pn; if (!g8::unit_of(u, T / 256, NPROJ / 256, pm, pn)) break;
        const float* rs = p.rstd_mix + pm * 256; bf16_t* proj = p.proj;
        g8::gemm_tile(lds, (const char*)(p.xb + (long)pm * 256 * D), aoff, 128, (const char*)(p.WinT + l * LW_WIN + (long)pn * 256 * D), boff, 128L * D * 2, D / 64, [&](const Acc& acc, int rb, int cb) {
            ACC_FOR(ai, m, bj, n) { const int r = ai * 128 + m * 16 + rb, c = bj * 128 + n * 16 + cb; const long row = pm * 256 + r;
                f32x4 v = acc[ai][bj][m][n] * rs[r];
                u32x2 w; w.x = pk2h(v[0], v[1]); w.y = pk2h(v[2], v[3]); *(u32x2*)(proj + row * NPROJ + pn * 256 + c) = w; }
        });
    }
    inproj_narrow(p, l, lds);
    { const int G = gdim(), rem = ((T / 256) * (NPROJ / 256)) % G;
      if (rem != 0 && bidx() >= rem) tconv_range(p, l, TCONV_EARLY, TCONV_EARLY + TCONV_TAIL, bidx() - rem, G - rem, lds); }
}

DI void s5_item(CP p, int l, int item, int pass, LAS char* wl) {
    const int lane = tidx() & 63, fr = lane & 15, fq = lane >> 4;
    item = __builtin_amdgcn_readfirstlane(item);
    const int g = item & 31, c = (item >> 5) & 63, b = item >> 11;
    LAS float* BU = (LAS float*)wl;
    LAS bf16_t* X = (LAS bf16_t*)(wl + 8192);
    const f32x2 lam = p.s5lam[g * 64 + lane];
    float sre = 0.f, sim = 0.f;
    if (pass == 2) { const f32x2 l64 = p.s5lam[2048 + g * 64 + lane]; const f32x2* E = p.s5E + ((long)(b * 64) * 32 + g) * 64 + lane;
        for (int c0 = 0; c0 < c; c0 += 8) { f32x2 e[8];
#pragma unroll
            for (int k = 0; k < 8; ++k) e[k] = E[(long)min(c0 + k, c - 1) * 32 * 64];
#pragma unroll
            for (int k = 0; k < 8; ++k) if (c0 + k < c) { const float nr = l64.x * sre - l64.y * sim + e[k].x, ni = l64.x * sim + l64.y * sre + e[k].y; sre = nr; sim = ni; } } }
    bf16x8 bfr[8], cfr[4];
#pragma unroll
    for (int nb = 0; nb < 8; ++nb) bfr[nb] = *(const bf16x8*)(p.s5Bt + ((long)g * 128 + nb * 16 + fr) * 32 + 8 * fq);
    if (pass == 2) {
#pragma unroll
        for (int ks = 0; ks < 4; ++ks) cfr[ks] = *(const bf16x8*)(p.s5Ct + ((long)g * 16 + fr) * 128 + ks * 32 + 8 * fq);
    }
    const long tok0 = (long)b * SEQ + c * 64;
    const float dsk = p.in[I_S5D][l * 512 + g * 16 + fr];
    bf16x8 afr_nx = *(const bf16x8*)(p.proj + (tok0 + fr) * NPROJ + C_U + g * 16 + 8 * (fq & 1));
    for (int sub = 0; sub < 4; ++sub) {
        const long tb = tok0 + sub * 16;
        const bf16x8 afr = afr_nx;
        afr_nx = *(const bf16x8*)(p.proj + (tok0 + min(sub + 1, 3) * 16 + fr) * NPROJ + C_U + g * 16 + 8 * (fq & 1));
        bf16_t uu[4];
        if (pass == 2) {
#pragma unroll
            for (int j = 0; j < 4; ++j) uu[j] = p.proj[(tb + 4 * fq + j) * NPROJ + C_U + g * 16 + fr]; }
        f32x4 accs[8];
#pragma unroll
        for (int nb = 0; nb < 8; ++nb) { accs[nb] = (f32x4){0.f, 0.f, 0.f, 0.f}; accs[nb] = MFMA16(afr, bfr[nb], accs[nb]); }
        settle(accs[0], accs[1], accs[2], accs[3], accs[4], accs[5], accs[6], accs[7]);
#pragma unroll
        for (int nb = 0; nb < 8; ++nb)
#pragma unroll
            for (int j = 0; j < 4; ++j) BU[(4 * fq + j) * 128 + nb * 16 + fr] = accs[nb][j];
        lds_wait();
#pragma unroll
        for (int tt = 0; tt < 16; ++tt) { const float br = BU[tt * 128 + lane], bi = BU[tt * 128 + 64 + lane];
            const float nr = lam.x * sre - lam.y * sim + br, ni = lam.x * sim + lam.y * sre + bi; sre = nr; sim = ni;
            if (pass == 2) { X[tt * 136 + lane] = f2bf(sre); X[tt * 136 + 64 + lane] = f2bf(sim); } }
        if (pass == 2) {
            lds_wait();
            f32x4 acc = {0.f, 0.f, 0.f, 0.f};
            bf16x8 xa[4];
#pragma unroll
            for (int ks = 0; ks < 4; ++ks) xa[ks] = *(const LAS bf16x8*)(X + fr * 136 + ks * 32 + 8 * fq);
            lds_wait();
#pragma unroll
            for (int ks = 0; ks < 4; ++ks) acc = MFMA16(xa[ks], cfr[ks], acc);
            settle(acc);
            asm volatile("" :: "v"(xa[0]), "v"(xa[1]), "v"(xa[2]), "v"(xa[3]));
#pragma unroll
            for (int j = 0; j < 4; ++j) { const long tk = tb + 4 * fq + j; const float u = bf2f(uu[j]);
                p.s5y[tk * 512 + g * 16 + fr] = f2bf(gelu_tanh(acc[j] + dsk * u)); }
        }
        lds_wait();
    }
    if (pass == 1) { p.s5E[((long)(b * 64 + c) * 32 + g) * 64 + lane] = (f32x2){sre, sim};
#ifdef DBG_E2
        ((f32x2*)p.gRT)[((long)(b * 64 + c) * 32 + g) * 64 + lane] = (f32x2){sre, sim};
#endif
    }
}
constexpr int GP_QG = 0, GP_KN = 17408, GP_KB = 34816, GP_QN = 52224, GP_VBT = 69632, GP_KBGT = 88064, GP_KGT = 106496, GP_AM = 124928, GP_QK = 142336, GP_GT = 151552;
constexpr int GP_TM = 17408, GP_UT = 26624, GP_WT = 45056;
constexpr int SK = 136, ST = 72, SA = 68;

template <int SWA> DI f32x4 mma_tile2_sw(const LAS bf16_t* lin, const LAS bf16_t* sw, int fq, int x) {
    f32x4 acc = ZERO4;
#pragma unroll
    for (int ks = 0; ks < 2; ++ks) { const bf16x8 a = ld8(lin + ks * 32), s = ld8(sw + 8 * ((4 * ks + fq) ^ x)); acc = SWA ? MFMA16(s, a, acc) : MFMA16(a, s, acc); }
    settle(acc);
    return acc;
}
DI void gdn_prep_item(CP p, int l, int item, LAS char* lds) {
    const int tid = tidx(), lane = tid & 63, w = __builtin_amdgcn_readfirstlane(tid >> 6), fr = lane & 15, fq = lane >> 4;
    const int n = item & 63, h = (item >> 6) & 3, b = item >> 8;
    const long tok0 = (long)b * SEQ + n * 64;
    LAS bf16_t* Qg = (LAS bf16_t*)(lds + GP_QG); LAS bf16_t* Kn = (LAS bf16_t*)(lds + GP_KN); LAS bf16_t* Kb = (LAS bf16_t*)(lds + GP_KB); LAS bf16_t* Qn = (LAS bf16_t*)(lds + GP_QN);
    LAS bf16_t* VbT = (LAS bf16_t*)(lds + GP_VBT); LAS bf16_t* KbgT = (LAS bf16_t*)(lds + GP_KBGT); LAS bf16_t* KgT = (LAS bf16_t*)(lds + GP_KGT);
    LAS float* Am = (LAS float*)(lds + GP_AM); LAS bf16_t* QKm = (LAS bf16_t*)(lds + GP_QK); LAS float* gts = (LAS float*)(lds + GP_GT);
    LAS bf16_t* Tm = (LAS bf16_t*)(lds + GP_TM); LAS bf16_t* UT = (LAS bf16_t*)(lds + GP_UT); LAS bf16_t* WT = (LAS bf16_t*)(lds + GP_WT);
    if (tid < 64) {
        const float a = p.small[(tok0 + tid) * NSMALL + h], bb = p.small[(tok0 + tid) * NSMALL + 4 + h];
        const float g = -expf(p.in[I_A_LOG][l * 4 + h]) * softplusf_(a + p.in[I_DT_BIAS][l * 4 + h]);
        float inc = g;
#pragma unroll
        for (int o = 1; o < 64; o <<= 1) { const float v = shfl_up_f(inc, o, lane); if (lane >= o) inc += v; }
        gts[tid] = inc; gts[64 + tid] = sigmoidf_(bb);
    }
    LAS float* cw = Am;
    if (tid < 384) {
#pragma unroll
        for (int j = 0; j < 4; ++j) cw[j * 384 + tid] = p.in[I_CONV_W][(long)(l * 4 + j) * 1536 + (tid >> 7) * 512 + h * 128 + (tid & 127)]; }
    __syncthreads();
    {
        const int i = tid >> 3, sub = tid & 7;
        const float gc = gts[i], beta = gts[64 + i], glast = gts[63];
        const float eg = __expf(gc), egl = __expf(glast - gc);
        const int spos = n * 64 + i;
#pragma unroll
        for (int which = 0; which < 3; ++which) {
            const int cbase = which * 512 + h * 128 + sub * 16;
            float o[16];
#pragma unroll
            for (int cc = 0; cc < 16; ++cc) o[cc] = 0.f;
#pragma unroll
            for (int j = 0; j < 4; ++j) {
                if (spos - 3 + j >= 0) {
                    const bf16_t* xr = p.proj + (tok0 + i - 3 + j) * NPROJ + C_QKV + cbase;
                    const bf16x8 x0 = ld8(xr), x1 = ld8(xr + 8);
                    const LAS float* wr_ = cw + j * 384 + which * 128 + sub * 16;
#pragma unroll
                    for (int cc = 0; cc < 8; ++cc) { o[cc] += wr_[cc] * bf2f((bf16_t)x0[cc]); o[8 + cc] += wr_[8 + cc] * bf2f((bf16_t)x1[cc]); }
                }
            }
            float ss = 0.f;
#pragma unroll
            for (int cc = 0; cc < 16; ++cc) { o[cc] = siluf_(o[cc]); ss += o[cc] * o[cc]; }
            ss += shflx<1>(ss); ss += shflx<2>(ss); ss += shflx<4>(ss);
            if (which == 0) {
                const float sc = rsqrtf(ss + 1e-6f) * 0.08838834764831845f;
                u32x4 a0, a1, b0, b1;
#pragma unroll
                for (int cc = 0; cc < 4; ++cc) { a0[cc] = pk2(o[2 * cc] * sc, o[2 * cc + 1] * sc); a1[cc] = pk2(o[8 + 2 * cc] * sc, o[9 + 2 * cc] * sc);
                    b0[cc] = pk2(o[2 * cc] * sc * eg, o[2 * cc + 1] * sc * eg); b1[cc] = pk2(o[8 + 2 * cc] * sc * eg, o[9 + 2 * cc] * sc * eg); }
                *(LAS u32x4*)(Qn + i * SK + sub * 16) = a0; *(LAS u32x4*)(Qn + i * SK + sub * 16 + 8) = a1;
                *(LAS u32x4*)(Qg + i * SK + sub * 16) = b0; *(LAS u32x4*)(Qg + i * SK + sub * 16 + 8) = b1;
            } else if (which == 1) {
                const float sc = rsqrtf(ss + 1e-6f);
                u32x4 a0, a1, b0, b1;
#pragma unroll
                for (int cc = 0; cc < 4; ++cc) { a0[cc] = pk2(o[2 * cc] * sc, o[2 * cc + 1] * sc); a1[cc] = pk2(o[8 + 2 * cc] * sc, o[9 + 2 * cc] * sc);
                    b0[cc] = pk2(o[2 * cc] * sc * beta, o[2 * cc + 1] * sc * beta); b1[cc] = pk2(o[8 + 2 * cc] * sc * beta, o[9 + 2 * cc] * sc * beta); }
                *(LAS u32x4*)(Kn + i * SK + sub * 16) = a0; *(LAS u32x4*)(Kn + i * SK + sub * 16 + 8) = a1;
                *(LAS u32x4*)(Kb + i * SK + sub * 16) = b0; *(LAS u32x4*)(Kb + i * SK + sub * 16 + 8) = b1;
#pragma unroll
                for (int cc = 0; cc < 16; ++cc) { const float kn = o[cc] * sc; KbgT[(sub * 16 + cc) * ST + (i ^ (8 * sub))] = f2bf(kn * beta * eg); KgT[(sub * 16 + cc) * ST + (i ^ (8 * sub))] = f2bf(kn * egl); }
            } else {
#pragma unroll
                for (int cc = 0; cc < 16; ++cc) VbT[(sub * 16 + cc) * ST + (i ^ (8 * sub))] = f2bf(o[cc] * beta);
            }
        }
    }
    __syncthreads();
    for (int tl = w; tl < 16; tl += 8) {
        const int m0 = (tl >> 2) * 16, n0 = (tl & 3) * 16;
        const f32x4 a1 = mma_tile<4>(Kb + (m0 + fr) * SK + 8 * fq, Kn + (n0 + fr) * SK + 8 * fq, ZERO4);
        const f32x4 a2 = mma_tile<4>(Qn + (m0 + fr) * SK + 8 * fq, Kn + (n0 + fr) * SK + 8 * fq, ZERO4);
        const int jj = n0 + fr; const float gj = gts[jj];
#pragma unroll
        for (int j = 0; j < 4; ++j) { const int i = m0 + 4 * fq + j; const float dec = __expf(fminf(gts[i] - gj, 0.f));
            Am[i * SA + jj] = (jj < i) ? a1[j] * dec : 0.f;
            QKm[i * ST + jj] = f2bf((jj <= i) ? a2[j] * dec : 0.f); }
    }
    __syncthreads();
    if (w < 4) {
        const int q = lane & 3, c = 16 * w + (lane >> 2);
        float tq[16];
#pragma unroll
        for (int k = 0; k < 16; ++k) tq[k] = 0.f;
        const LAS float* Aq = Am + q;
#pragma unroll
        for (int i = 0; i < 64; ++i) {
            float acc = (q == 0 && i == c) ? 1.f : 0.f;
#pragma unroll
            for (int jj = 0; 4 * jj < i; ++jj) acc -= Aq[i * SA + 4 * jj] * tq[jj];
            acc += __builtin_bit_cast(float, __builtin_amdgcn_update_dpp(0, __builtin_bit_cast(int, acc), 0xB1, 0xF, 0xF, false));
            acc += __builtin_bit_cast(float, __builtin_amdgcn_update_dpp(0, __builtin_bit_cast(int, acc), 0x4E, 0xF, 0xF, false));
            tq[i >> 2] = (q == (i & 3)) ? acc : tq[i >> 2];
            if (q == 0) Tm[i * ST + c] = f2bf(acc);
        }
    }
    __syncthreads();
    for (int tl = w; tl < 32; tl += 8) {
        const int m0 = (tl >> 3) * 16, n0 = (tl & 7) * 16;
        const f32x4 u = mma_tile2_sw<0>(Tm + (m0 + fr) * ST + 8 * fq, VbT + (n0 + fr) * ST, fq, n0 >> 4);
        const f32x4 ww = mma_tile2_sw<0>(Tm + (m0 + fr) * ST + 8 * fq, KbgT + (n0 + fr) * ST, fq, n0 >> 4);
        u32x2 pu, pw; pu.x = pk2(u[0], u[1]); pu.y = pk2(u[2], u[3]); pw.x = pk2(ww[0], ww[1]); pw.y = pk2(ww[2], ww[3]);
        *(LAS u32x2*)(UT + (n0 + fr) * ST + m0 + 4 * fq) = pu; *(LAS u32x2*)(WT + (n0 + fr) * ST + m0 + 4 * fq) = pw;
    }
    __syncthreads();
    const long ib = item;
    for (int tl = w; tl < 64; tl += 8) {
        const int mt = tl >> 3, nt = tl & 7, m0 = mt * 16, n0 = nt * 16;
        const f32x4 pv = mma_tile2_sw<0>(WT + (m0 + fr) * ST + 8 * fq, KgT + (n0 + fr) * ST, fq, n0 >> 4);
        u32x2 pp; pp.x = pk2(-pv[0], -pv[1]); pp.y = pk2(-pv[2], -pv[3]);
        *(u32x2*)(p.gP + ib * 16384 + (n0 + fr) * 128 + (mt >> 1) * 32 + 8 * fq + (mt & 1) * 4) = pp;
        const f32x4 rv = mma_tile2_sw<1>(UT + (n0 + fr) * ST + 8 * fq, KgT + (m0 + fr) * ST, fq, m0 >> 4);
        *(f32x4*)(p.gRT + ib * 16384 + (n0 + fr) * 128 + m0 + 4 * fq) = rv;
    }
    for (int tl = w; tl < 32; tl += 8) {
        const int mt = tl >> 2, nt = tl & 3, m0 = mt * 16, n0 = nt * 16;
        const f32x4 qw = mma_tile<2>(WT + (m0 + fr) * ST + 8 * fq, QKm + (n0 + fr) * ST + 8 * fq, ZERO4);
        const f32x4 ou = mma_tile<2>(UT + (m0 + fr) * ST + 8 * fq, QKm + (n0 + fr) * ST + 8 * fq, ZERO4);
        const int i = n0 + fr, f = m0 + 4 * fq;
        const u32x2 qg = *(const LAS u32x2*)(Qg + i * SK + f);
        u32x2 qo; qo.x = pk2(__uint_as_float(qg.x << 16) - qw[0], __uint_as_float(qg.x & 0xffff0000u) - qw[1]);
        qo.y = pk2(__uint_as_float(qg.y << 16) - qw[2], __uint_as_float(qg.y & 0xffff0000u) - qw[3]);
        *(u32x2*)(p.gQp + ib * 8192 + i * 128 + f) = qo;
        *(f32x4*)(p.gOU + ib * 8192 + i * 128 + f) = ou;
    }
    if (tid == 0) p.gA[ib] = __expf(gts[63]);
    __syncthreads();
}

DI void gdn_chain(CP p, int ch, LAS char* lds) {
    const int tid = tidx(), lane = tid & 63, w = __builtin_amdgcn_readfirstlane(tid >> 6), fr = lane & 15, fq = lane >> 4;
    constexpr int PST = 136, PBUF = 128 * PST * 2;
    f32x4 acc[8];
#pragma unroll
    for (int mb = 0; mb < 8; ++mb) acc[mb] = ZERO4;
    u32x4 pp[4]; f32x4 rr[8]; float an;
    auto load_step = [&](int n) {
        const long ib = (long)ch * 64 + n;
#pragma unroll
        for (int i = 0; i < 4; ++i) { const int q = tid + 512 * i; pp[i] = *(const u32x4*)(p.gP + ib * 16384 + (q >> 4) * 128 + (q & 15) * 8); }
#pragma unroll
        for (int mb = 0; mb < 8; ++mb) rr[mb] = *(const f32x4*)(p.gRT + ib * 16384 + (w * 16 + fr) * 128 + mb * 16 + 4 * fq);
        an = p.gA[ib];
    };
    auto write_p = [&](int buf) {
#pragma unroll
        for (int i = 0; i < 4; ++i) { const int q = tid + 512 * i; *(LAS u32x4*)(lds + buf * PBUF + (q >> 4) * (PST * 2) + (q & 15) * 16) = pp[i]; }
    };
    __syncthreads();
    load_step(0); write_p(0);
    f32x4 rc[8]; float ac = an;
#pragma unroll
    for (int mb = 0; mb < 8; ++mb) rc[mb] = rr[mb];
    __syncthreads();
    for (int n = 0; n < 64; ++n) {
        const long ib = (long)ch * 64 + n;
        if (n + 1 < 64) load_step(n + 1);
        bf16x8 bfr[4];
#pragma unroll
        for (int ks = 0; ks < 4; ++ks) { u32x4 q; q.x = pk2(acc[2 * ks][0], acc[2 * ks][1]); q.y = pk2(acc[2 * ks][2], acc[2 * ks][3]); q.z = pk2(acc[2 * ks + 1][0], acc[2 * ks + 1][1]); q.w = pk2(acc[2 * ks + 1][2], acc[2 * ks + 1][3]);
            bfr[ks] = __builtin_bit_cast(bf16x8, q);
            bf16_t* sp = p.gST + ib * 16384 + (w * 16 + fr) * 128 + 4 * fq;
            u32x2 lo, hi; lo.x = q.x; lo.y = q.y; hi.x = q.z; hi.y = q.w;
            *(u32x2*)(sp + (2 * ks) * 16) = lo; *(u32x2*)(sp + (2 * ks + 1) * 16) = hi; }
#pragma unroll
        for (int mb = 0; mb < 8; ++mb) acc[mb] = acc[mb] * ac + rc[mb];
        const LAS bf16_t* pb = (const LAS bf16_t*)(lds + (n & 1) * PBUF);
#pragma unroll
        for (int mb = 0; mb < 8; ++mb)
#pragma unroll
            for (int ks = 0; ks < 4; ++ks) acc[mb] = MFMA16(ld8(pb + (mb * 16 + fr) * PST + ks * 32 + 8 * fq), bfr[ks], acc[mb]);
        settle(acc[0], acc[1], acc[2], acc[3], acc[4], acc[5], acc[6], acc[7]);
        if (n + 1 < 64) { write_p((n + 1) & 1); ac = an;
#pragma unroll
            for (int mb = 0; mb < 8; ++mb) rc[mb] = rr[mb]; }
        __syncthreads();
    }
}

DI void gdn_out_item(CP p, int l, int item, LAS char* lds) {
    const int tid = tidx(), lane = tid & 63, w = __builtin_amdgcn_readfirstlane(tid >> 6), fr = lane & 15, fq = lane >> 4;
    const int n = item & 63, h = (item >> 6) & 3, b = item >> 8;
    const long tok0 = (long)b * SEQ + n * 64, ib = item;
    LAS float* red = (LAS float*)lds;
    const int ib16 = (w & 3) * 16, mh = w >> 2, i = ib16 + fr;
    bf16x8 sfr[4][4], qfr[4]; f32x4 ouv[4], gwv[4]; u32x2 zzv[4];
#pragma unroll
    for (int ks = 0; ks < 4; ++ks) qfr[ks] = ld8(p.gQp + ib * 8192 + (ib16 + fr) * 128 + 8 * fq + ks * 32);
#pragma unroll
    for (int m4 = 0; m4 < 4; ++m4)
#pragma unroll
        for (int ks = 0; ks < 4; ++ks) sfr[m4][ks] = ld8(p.gST + ib * 16384 + ((mh * 4 + m4) * 16 + fr) * 128 + 8 * fq + ks * 32);
#pragma unroll
    for (int m4 = 0; m4 < 4; ++m4) { const int c0 = (mh * 4 + m4) * 16 + 4 * fq; ouv[m4] = *(const f32x4*)(p.gOU + ib * 8192 + i * 128 + c0);
        gwv[m4] = *(const f32x4*)(p.in[I_GDN_NORM] + l * 128 + c0); zzv[m4] = *(const u32x2*)(p.proj + (tok0 + i) * NPROJ + C_Z + h * 128 + c0); }
    f32x4 acc[4];
#pragma unroll
    for (int m4 = 0; m4 < 4; ++m4) { acc[m4] = ZERO4;
#pragma unroll
        for (int ks = 0; ks < 4; ++ks) acc[m4] = MFMA16(sfr[m4][ks], qfr[ks], acc[m4]); }
    settle(acc[0], acc[1], acc[2], acc[3]);
    float s = 0.f;
#pragma unroll
    for (int m4 = 0; m4 < 4; ++m4) { acc[m4] += ouv[m4];
        s += acc[m4][0] * acc[m4][0] + acc[m4][1] * acc[m4][1] + acc[m4][2] * acc[m4][2] + acc[m4][3] * acc[m4][3]; }
    s += shflx<16>(s); s += shflx<32>(s);
    if (fq == 0) red[mh * 64 + i] = s;
    __syncthreads();
    const float rstd = rsqrtf((red[i] + red[64 + i]) * (1.f / 128.f) + EPS);
#pragma unroll
    for (int m4 = 0; m4 < 4; ++m4) { const int c0 = (mh * 4 + m4) * 16 + 4 * fq;
        const f32x4 gw = gwv[m4]; const u32x2 zz = zzv[m4];
        const float z0 = __uint_as_float(zz.x << 16), z1 = __uint_as_float(zz.x & 0xffff0000u), z2 = __uint_as_float(zz.y << 16), z3 = __uint_as_float(zz.y & 0xffff0000u);
        u32x2 o; o.x = pk2(acc[m4][0] * rstd * gw[0] * siluf_(z0), acc[m4][1] * rstd * gw[1] * siluf_(z1)); o.y = pk2(acc[m4][2] * rstd * gw[2] * siluf_(z2), acc[m4][3] * rstd * gw[3] * siluf_(z3));
        *(u32x2*)(p.mix + (tok0 + i) * D + 512 + h * 128 + c0) = o; }
    __syncthreads();
}
DI void nsa_prep_elem(CP p, int l) {
    const long gtid = (long)bidx() * 512 + tidx(), nth = (long)gdim() * 512;
    for (long task = gtid; task < (long)T * 24; task += nth) {
        const long t = task / 24; const int k = (int)(task - t * 24);
        const int s = (int)(t & (SEQ - 1)), b = (int)(t >> 12);
        int col; const float* gain; bf16_t* dst; float osc = 1.f;
        if (k < 16) { col = C_NQ + k * 64; gain = p.in[I_QNORM] + l * 64; dst = p.qn + t * 1024 + k * 64; osc = 0.125f * 1.4426950408889634f; }
        else if (k < 20) { const int g = k - 16; col = C_NKV + 2 * 256 + g * 64; gain = p.in[I_KNORM] + (l * 3 + 1) * 64; dst = p.ksn + (((long)(b * 4 + g)) * SEQ + s) * 64; }
        else { const int g = k - 20; col = C_NKV + 4 * 256 + g * 64; gain = p.in[I_KNORM] + (l * 3 + 2) * 64; dst = p.kwn + (((long)(b * 4 + g)) * SEQ + s) * 64; }
        const bf16_t* src = p.proj + t * NPROJ + col;
        float x[64]; float ss = 0.f;
#pragma unroll
        for (int c = 0; c < 8; ++c) { const bf16x8 v = ld8(src + 8 * c);
#pragma unroll
            for (int e = 0; e < 8; ++e) { x[8 * c + e] = bf2f((bf16_t)v[e]); ss += x[8 * c + e] * x[8 * c + e]; } }
        const float rstd = rsqrtf(ss * (1.f / 64.f) + EPS) * osc;
        const f32x4* rp = (const f32x4*)(p.rope + s * 32);
        unsigned o1[16], o2[16];
#pragma unroll
        for (int i2 = 0; i2 < 16; ++i2) { const f32x4 cs = rp[i2]; const int i = 2 * i2;
            const float a1 = x[i] * rstd * gain[i], a2 = x[32 + i] * rstd * gain[32 + i], b1 = x[i + 1] * rstd * gain[i + 1], b2 = x[33 + i] * rstd * gain[33 + i];
            o1[i2] = pk2(a1 * cs[0] - a2 * cs[1], b1 * cs[2] - b2 * cs[3]); o2[i2] = pk2(a2 * cs[0] + a1 * cs[1], b2 * cs[2] + b1 * cs[3]); }
#pragma unroll
        for (int c = 0; c < 4; ++c) { u32x4 w1, w2;
#pragma unroll
            for (int e = 0; e < 4; ++e) { w1[e] = o1[4 * c + e]; w2[e] = o2[4 * c + e]; }
            *(u32x4*)(dst + 8 * c) = w1; *(u32x4*)(dst + 32 + 8 * c) = w2; }
    }
}
DI void nsa_vtrans(CP p, LAS char* wl) {
    const int lane = tidx() & 63, gw = bidx() * 8 + __builtin_amdgcn_readfirstlane(tidx() >> 6), nw = gdim() * 8;
    LAS bf16_t* tile = (LAS bf16_t*)wl;
    for (int item = gw; item < 2 * 4 * 4 * 64; item += nw) {
        const int tl = item & 63, g = (item >> 6) & 3, b = (item >> 8) & 3, which = item >> 10;
        const long t = (long)b * SEQ + tl * 64 + lane;
        const bf16_t* src = p.proj + t * NPROJ + C_NKV + (which ? 5 : 3) * 256 + g * 64;
#pragma unroll
        for (int c = 0; c < 8; ++c) { const bf16x8 v = ld8(src + 8 * c);
#pragma unroll
            for (int e = 0; e < 8; ++e) tile[lane * 66 + 8 * c + e] = (bf16_t)v[e]; }
        lds_wait();
        bf16_t* dst = (which ? p.vwT : p.vsT) + ((long)(b * 4 + g) * 64 + lane) * SEQ + tl * 64;
#pragma unroll
        for (int c = 0; c < 8; ++c) { u32x4 o;
#pragma unroll
            for (int e = 0; e < 4; ++e) o[e] = (unsigned)tile[(8 * c + 2 * e) * 66 + lane] | ((unsigned)tile[(8 * c + 2 * e + 1) * 66 + lane] << 16);
            *(u32x4*)(dst + 8 * c) = o; }
        lds_wait();
    }
}

DI void nsa_cmp_unit(CP p, int l, int unit, LAS char* lds) {
    const int kv = unit >> 4, mtile = unit & 15;
    const int tid = tidx(), lane = tid & 63, w = __builtin_amdgcn_readfirstlane(tid >> 6), fr = lane & 15, fq = lane >> 4;
    unsigned aoff[2][2], boff[2];
#pragma unroll
    for (int h = 0; h < 2; ++h)
#pragma unroll
        for (int i = 0; i < 2; ++i) { int R, C; g8::my_rc(i, R, C); const int row = mtile * 256 + h * 128 + R;
            const int b = row >> 10, n = min((row & 1023) >> 2, 254), g = row & 3;
            aoff[h][i] = (unsigned)((((long)b * SEQ + 16 * n) * NPROJ + C_NKV + kv * 256 + g * 64 + C) * 2);
            boff[i] = (unsigned)(R * 2048 + C) * 2u; }
    LAS bf16_t* Hs = (LAS bf16_t*)lds;
    const float* b1 = p.bias1 + kv * 256;
    g8::gemm_tile(lds, (const char*)p.proj, aoff, (long)NPROJ * 2, (const char*)(p.w1T + l * LW_W1 + (long)kv * 256 * 2048), boff, 128L * 2048 * 2, 32, [&](const Acc& acc, int rb, int cb) {
        ACC_FOR(ai, m, bj, n) { const int r = ai * 128 + m * 16 + rb, c = bj * 128 + n * 16 + cb; const f32x4 v = acc[ai][bj][m][n];
            u32x2 o; o.x = pk2(gelu_tanh(v[0] + b1[c]), gelu_tanh(v[1] + b1[c + 1])); o.y = pk2(gelu_tanh(v[2] + b1[c + 2]), gelu_tanh(v[3] + b1[c + 3]));
            *(LAS u32x2*)(Hs + r * 264 + c) = o; }
    });
    __syncthreads();
    const bf16_t* w2 = p.w2T + l * LW_W2 + (long)kv * 64 * 256;
    for (int rg = w; rg < 16; rg += 8) {
        f32x4 acc[4];
#pragma unroll
        for (int mt = 0; mt < 4; ++mt) acc[mt] = ZERO4;
#pragma unroll
        for (int ks = 0; ks < 8; ++ks) { const bf16x8 hb = ld8(Hs + (rg * 16 + fr) * 264 + ks * 32 + 8 * fq);
#pragma unroll
            for (int mt = 0; mt < 4; ++mt) acc[mt] = MFMA16(ld8(w2 + (mt * 16 + fr) * 256 + ks * 32 + 8 * fq), hb, acc[mt]); }
        settle(acc[0], acc[1], acc[2], acc[3]);
        const int row = mtile * 256 + rg * 16 + fr; const int b = row >> 10, n = (row & 1023) >> 2, g = row & 3;
        const bool valid = n < 255;
        if (kv == 0) {
            float ss = 0.f;
#pragma unroll
            for (int mt = 0; mt < 4; ++mt)
#pragma unroll
                for (int j = 0; j < 4; ++j) ss += acc[mt][j] * acc[mt][j];
            ss += shflx<16>(ss); ss += shflx<32>(ss);
            const float rstd = rsqrtf(ss * (1.f / 64.f) + EPS);
            const float* gain = p.in[I_KNORM] + (l * 3 + 0) * 64;
            const int pos = min(16 * n + 31, SEQ - 1);
            bf16_t* dst = p.kcmp + (((long)(b * 4 + g)) * 256 + n) * 64;
#pragma unroll
            for (int mt = 0; mt < 2; ++mt) { u32x2 lo, hi; float o1[4], o2[4];
#pragma unroll
                for (int j = 0; j < 4; ++j) { const int d = mt * 16 + 4 * fq + j; const f32x2 cs = p.rope[pos * 32 + d];
                    const float y1 = acc[mt][j] * rstd * gain[d], y2 = acc[mt + 2][j] * rstd * gain[32 + d];
                    o1[j] = valid ? y1 * cs.x - y2 * cs.y : 0.f; o2[j] = valid ? y2 * cs.x + y1 * cs.y : 0.f; }
                lo.x = pk2(o1[0], o1[1]); lo.y = pk2(o1[2], o1[3]); hi.x = pk2(o2[0], o2[1]); hi.y = pk2(o2[2], o2[3]);
                *(u32x2*)(dst + mt * 16 + 4 * fq) = lo; *(u32x2*)(dst + 32 + mt * 16 + 4 * fq) = hi; }
        } else {
            bf16_t* dst = p.vcmpT + (((long)(b * 4 + g)) * 64) * 256 + n;
#pragma unroll
            for (int mt = 0; mt < 4; ++mt)
#pragma unroll
                for (int j = 0; j < 4; ++j) dst[(long)(mt * 16 + 4 * fq + j) * 256] = f2bf(valid ? acc[mt][j] : 0.f);
        }
    }
    __syncthreads();
}

DI int crow(int i, int hh) { return (i & 3) + 8 * (i >> 2) + 4 * hh; }
DI bf16x8 pack8(const float* q) { u32x4 r; r.x = pk2(q[0], q[1]); r.y = pk2(q[2], q[3]); r.z = pk2(q[4], q[5]); r.w = pk2(q[6], q[7]); return __builtin_bit_cast(bf16x8, r); }
template <int S> DI bf16x8 pack_step(const f32x16& x) {
    u32x4 r;
    asm volatile("v_cvt_pk_bf16_f32 %0, %4, %5\n\tv_cvt_pk_bf16_f32 %1, %6, %7\n\tv_cvt_pk_bf16_f32 %2, %8, %9\n\tv_cvt_pk_bf16_f32 %3, %10, %11\n\ts_nop 1"
                 : "=&v"(r[0]), "=&v"(r[1]), "=&v"(r[2]), "=&v"(r[3])
                 : "v"(x[8 * S]), "v"(x[8 * S + 1]), "v"(x[8 * S + 2]), "v"(x[8 * S + 3]), "v"(x[8 * S + 4]), "v"(x[8 * S + 5]), "v"(x[8 * S + 6]), "v"(x[8 * S + 7]));
    return __builtin_bit_cast(bf16x8, r);
}
DI float exp2_(float x) { return __builtin_amdgcn_exp2f(x); }
DI float max16(const f32x16& a) { float m0 = fmaxf(fmaxf(a[0], a[1]), fmaxf(a[2], a[3])), m1 = fmaxf(fmaxf(a[4], a[5]), fmaxf(a[6], a[7])), m2 = fmaxf(fmaxf(a[8], a[9]), fmaxf(a[10], a[11])), m3 = fmaxf(fmaxf(a[12], a[13]), fmaxf(a[14], a[15])); return fmaxf(fmaxf(m0, m1), fmaxf(m2, m3)); }
DI bf16x8 ldvt(const bf16_t* vt, long ldv, int d, int key) { const u32x2 a = *(const u32x2*)(vt + (long)d * ldv + key), b = *(const u32x2*)(vt + (long)d * ldv + key + 8); u32x4 r; r.x = a.x; r.y = a.y; r.z = b.x; r.w = b.y; return __builtin_bit_cast(bf16x8, r); }

constexpr int NS_KC = 0, NS_VC = 36864, NS_KR = 70656, NS_VR = 89088, NS_IMP = 107520, NS_UN = 123904, NS_TL = 124160;
DI bf16x8 ldvt_l(const LAS bf16_t* q) { const u32x2 a = *(const LAS u32x2*)q, b = *(const LAS u32x2*)(q + 8); u32x4 r; r.x = a.x; r.y = a.y; r.z = b.x; r.w = b.y; return __builtin_bit_cast(bf16x8, r); }
DI void nsa_unit(CP p, int l, int unit, LAS char* lds) {
    const int tid = tidx(), lane = tid & 63, w = __builtin_amdgcn_readfirstlane(tid >> 6), r31 = lane & 31, hh = lane >> 5;
    unit = __builtin_amdgcn_readfirstlane(unit);
    const int ub = unit & 63, g = (unit >> 6) & 3, b = unit >> 8;
    const int S0 = ub * 64, s0 = S0 + 8 * w, qi = r31 >> 2, rr = r31 & 3, tq = s0 + qi;
    const long tok = (long)b * SEQ + tq;
    LAS bf16_t* Kc = (LAS bf16_t*)(lds + NS_KC);
    LAS bf16_t* Vc = (LAS bf16_t*)(lds + NS_VC);
    LAS bf16_t* Kr = (LAS bf16_t*)(lds + NS_KR);
    LAS bf16_t* Vr = (LAS bf16_t*)(lds + NS_VR);
    LAS float* impL = (LAS float*)(lds + NS_IMP + w * 2048);
    LAS unsigned long long* unL = (LAS unsigned long long*)(lds + NS_UN);
    LAS int* tl = (LAS int*)(lds + NS_TL);
#ifdef TPROBE
#define TP(k) do { if ((k) == TPROBE_A && tid == 0) ((LAS unsigned*)(lds + 157 * 1024))[0] = (unsigned)__builtin_amdgcn_s_memrealtime(); if ((k) == TPROBE_B && unit == TPROBE_UNIT && l == 0 && tid == 0) p.err[3440] = (unsigned)__builtin_amdgcn_s_memrealtime() - ((LAS unsigned*)(lds + 157 * 1024))[0]; } while (0)
    TP(0);
#endif
    bf16x8 qf[4];
    { const bf16_t* qp = p.qn + tok * 1024 + (g * 4 + rr) * 64 + 8 * hh;
#pragma unroll
      for (int s = 0; s < 4; ++s) qf[s] = ld8(qp + 16 * s); }
#pragma unroll
    for (int k = 0; k < 8; ++k) impL[k * 64 + lane] = 0.f;
    f32x16 outacc[2];
#pragma unroll
    for (int i = 0; i < 16; ++i) { outacc[0][i] = 0.f; outacc[1][i] = 0.f; }
    const float* gl = p.small + tok * NSMALL + 8 + g * 12 + rr * 3;
    const float gate_c = sigmoidf_(gl[0]), gate_s = sigmoidf_(gl[1]), gate_w = sigmoidf_(gl[2]);
    const f32x16 zero16 = {0.f, 0.f, 0.f, 0.f, 0.f, 0.f, 0.f, 0.f, 0.f, 0.f, 0.f, 0.f, 0.f, 0.f, 0.f, 0.f};
    auto qk = [&](const LAS bf16_t* kt  ) { f32x16 acc = zero16;
#pragma unroll
        for (int s = 0; s < 4; ++s) acc = MFMA32(ld8(kt + r31 * 72 + 16 * s + 8 * hh), qf[s], acc);
        settle(acc); return acc; };
    {
        const int nvB = (S0 + 63 >= 31) ? ((S0 + 63 - 31) >> 4) + 1 : 0; const int rows = ((nvB + 31) >> 5) * 32;
        const bf16_t* kc = p.kcmp + ((long)(b * 4 + g) * 256) * 64; const bf16_t* vt = p.vcmpT + ((long)(b * 4 + g) * 64) * 256;
        for (int q = tid; q < rows * 8; q += 512) { const int row = q >> 3, c = q & 7; *(LAS u32x4*)(Kc + row * 72 + c * 8) = *(const u32x4*)(kc + (long)row * 64 + c * 8); }
        const int pc = rows >> 3;
        for (int q = tid; q < 64 * pc; q += 512) { const int d = q / pc, c = q - d * pc; *(LAS u32x4*)(Vc + d * 264 + c * 8) = *(const u32x4*)(vt + (long)d * 256 + c * 8); }
        __syncthreads();
        const int nvmax = (s0 + 7 >= 31) ? ((s0 + 7 - 31) >> 4) + 1 : 0; const int ntile = (nvmax + 31) >> 5;
        const int nv = (tq >= 31) ? ((tq - 31) >> 4) + 1 : 0;
        const int nvmin = (s0 >= 31) ? ((s0 - 31) >> 4) + 1 : 0;
#ifndef REP_PA
#define REP_PA 1
#endif
        float m = -1e30f, lsum = 0.f;
        for (int rpa = 0; rpa < REP_PA; ++rpa) { m = -1e30f; lsum = 0.f;
        for (int tI = 0; tI < ntile; ++tI) {
            const int key0 = tI * 32; f32x16 acc = qk(Kc + key0 * 72);
            if (key0 + 32 > nvmin) {
#pragma unroll
                for (int i = 0; i < 16; ++i) acc[i] = (key0 + crow(i, hh) < nv) ? acc[i] : -1e30f; }
            float mx = max16(acc); mx = fmaxf(mx, shflx<32>(mx));
            const float mn = fmaxf(m, mx), ms = fmaxf(mn, -1e20f); float ps = 0.f;
#pragma unroll
            for (int i = 0; i < 16; ++i) ps += exp2_(acc[i] - ms);
            lsum = lsum * exp2_(m - mn) + ps; m = mn;
        } }
        lsum += shflx<32>(lsum);
        const float inv = lsum > 0.f ? 1.f / lsum : 0.f;
        const float mfin = fmaxf(m, -1e20f), linv = __builtin_amdgcn_logf(fmaxf(inv, 1e-37f));
        const float sub = mfin - linv;
        f32x16 oc[2] = {zero16, zero16};
        for (int tI = 0; tI < ntile; ++tI) {
            const int key0 = tI * 32; f32x16 acc = qk(Kc + key0 * 72);
            if (key0 + 32 > nvmin) {
#pragma unroll
                for (int i = 0; i < 16; ++i) acc[i] = (key0 + crow(i, hh) < nv) ? acc[i] : -1e30f; }
#pragma unroll
            for (int i = 0; i < 16; ++i) acc[i] = exp2_(acc[i] - sub);
#pragma unroll
            for (int qd = 0; qd < 4; ++qd) { float mainv = acc[4 * qd] + acc[4 * qd + 1] + acc[4 * qd + 2] + 0.5f * acc[4 * qd + 3], sp = 0.5f * acc[4 * qd + 3];
                mainv += shflx<1>(mainv); mainv += shflx<2>(mainv); sp += shflx<1>(sp); sp += shflx<2>(sp);
                const int j = (key0 >> 2) + 2 * qd + hh;
                if (rr == 0) { __hip_atomic_fetch_add(&impL[qi * 64 + j], mainv, __ATOMIC_RELAXED, __HIP_MEMORY_SCOPE_WORKGROUP);
                    if (j + 1 < 64) __hip_atomic_fetch_add(&impL[qi * 64 + j + 1], sp, __ATOMIC_RELAXED, __HIP_MEMORY_SCOPE_WORKGROUP); } }
            { const bf16x8 pb0 = pack_step<0>(acc), pb1 = pack_step<1>(acc);
#pragma unroll
              for (int mb = 0; mb < 2; ++mb) { oc[mb] = MFMA32(ldvt_l(Vc + (32 * mb + r31) * 264 + key0 + 4 * hh), pb0, oc[mb]); oc[mb] = MFMA32(ldvt_l(Vc + (32 * mb + r31) * 264 + key0 + 16 + 4 * hh), pb1, oc[mb]); } }
        }
        settle(oc[0], oc[1]);
#pragma unroll
        for (int i = 0; i < 16; ++i) { outacc[0][i] = gate_c * oc[0][i]; outacc[1][i] = gate_c * oc[1][i]; }
    }
    lds_wait();
#ifdef TPROBE
    TP(1);
#endif
    unsigned long long mymask = 0ull, un = 0ull;
    {
        const int cur = S0 >> 6;
        if (cur < 16) {
            mymask = un = (2ull << cur) - 1ull;
        } else {
#ifndef REP_SEL
#define REP_SEL 1
#endif
#pragma unroll 1
            for (int q2x = 0; q2x < 8 * REP_SEL; ++q2x) { const int q2 = q2x & 7; if (q2x >= 8 && q2 == 0) { un = 0ull; }
                const float v = impL[q2 * 64 + lane];
                const bool forced = (lane == 0) || (lane == cur) || (lane == cur - 1), started = lane <= cur;
                const unsigned key = forced ? (0xffffffc0u | (unsigned)(63 - lane)) : (started ? ((__float_as_uint(v) & ~63u) | (unsigned)(63 - lane)) : 0u);
                int rank = 0;
#pragma unroll 16
                for (int jj = 0; jj < 64; ++jj) { const unsigned o = (unsigned)__builtin_amdgcn_readlane((int)key, jj); rank += (o > key) ? 1 : 0; }
                const unsigned long long mk = __ballot(rank < 16 && started);
                if (qi == q2) mymask = mk;
                un |= mk;
            }
        }
    }
    if (lane == 0) unL[w] = un;
    __syncthreads();
    if (tid == 0) { unsigned long long U = 0ull; for (int k = 0; k < 8; ++k) U |= unL[k]; int n = 0; while (U) { const int j = __builtin_ctzll(U); U &= U - 1ull; tl[1 + n] = 64 * j; ++n; } tl[0] = n; }
    __syncthreads();
    const int nsl = __builtin_amdgcn_readfirstlane(tl[0]);
    LAS float* oL = (LAS float*)(lds + w * 8192);
#pragma unroll
    for (int mb = 0; mb < 2; ++mb)
#pragma unroll
        for (int i = 0; i < 16; ++i) oL[(mb * 16 + i) * 64 + lane] = outacc[mb][i];
#ifdef TPROBE
    TP(2);
#endif
    const int prow = tid >> 3, pcol = (tid & 7) * 8;
    auto branch = [&](const bf16_t* kb, const bf16_t* vt, int nt, auto&& k0of, auto&& need_fn, auto&& mask_fn, float gate, bool keep) {
        float m = -1e30f, lsum = 0.f; f32x16 o[2] = {zero16, zero16};
        auto gload = [&](int K0, u32x4& kr, u32x4& vr) { kr = *(const u32x4*)(kb + (long)(K0 + prow) * 64 + pcol); vr = *(const u32x4*)(vt + (long)prow * SEQ + K0 + pcol); };
        auto lwrite = [&](int slot, const u32x4& kr, const u32x4& vr) { *(LAS u32x4*)(Kr + slot * 4608 + prow * 72 + pcol) = kr; *(LAS u32x4*)(Vr + slot * 4608 + prow * 72 + pcol) = vr; };
        auto process = [&](int key0, const LAS bf16_t* kt, const LAS bf16_t* vtl  ) {
            f32x16 acc = qk(kt);
            const bool dead = mask_fn(key0, acc);
            float mx = dead ? -1e30f : max16(acc); mx = fmaxf(mx, shflx<32>(mx));
            const float mn = fmaxf(m, mx), alpha = exp2_(m - mn), ms = dead ? 1e30f : fmaxf(mn, -1e20f); float ps = 0.f;
#pragma unroll
            for (int i = 0; i < 16; ++i) { acc[i] = exp2_(acc[i] - ms); ps += acc[i]; }
            lsum = lsum * alpha + ps; m = mn;
            if (__any(alpha != 1.f)) {
#pragma unroll
                for (int i = 0; i < 16; ++i) { o[0][i] *= alpha; o[1][i] *= alpha; } }
            const bf16x8 pb0 = pack_step<0>(acc), pb1 = pack_step<1>(acc);
#pragma unroll
            for (int mb = 0; mb < 2; ++mb) o[mb] = MFMA32(ldvt_l(vtl + (32 * mb + r31) * 72 + 4 * hh), pb0, o[mb]);
#pragma unroll
            for (int mb = 0; mb < 2; ++mb) o[mb] = MFMA32(ldvt_l(vtl + (32 * mb + r31) * 72 + 16 + 4 * hh), pb1, o[mb]); };
        auto process2 = [&](int K0, const LAS bf16_t* kt, const LAS bf16_t* vtl) {
            f32x16 a0 = zero16, a1 = zero16;
#pragma unroll
            for (int s = 0; s < 4; ++s) { a0 = MFMA32(ld8(kt + r31 * 72 + 16 * s + 8 * hh), qf[s], a0); a1 = MFMA32(ld8(kt + (32 + r31) * 72 + 16 * s + 8 * hh), qf[s], a1); }
            settle(a0, a1);
            const bool d0 = mask_fn(K0, a0), d1 = mask_fn(K0 + 32, a1);
            float mx = fmaxf(d0 ? -1e30f : max16(a0), d1 ? -1e30f : max16(a1)); mx = fmaxf(mx, shflx<32>(mx));
            const float mn = fmaxf(m, mx), alpha = exp2_(m - mn), msv = fmaxf(mn, -1e20f), ms0 = d0 ? 1e30f : msv, ms1 = d1 ? 1e30f : msv; float ps = 0.f;
#pragma unroll
            for (int i = 0; i < 16; ++i) { a0[i] = exp2_(a0[i] - ms0); a1[i] = exp2_(a1[i] - ms1); ps += a0[i] + a1[i]; }
            lsum = lsum * alpha + ps; m = mn;
            if (__any(alpha != 1.f)) {
#pragma unroll
                for (int i = 0; i < 16; ++i) { o[0][i] *= alpha; o[1][i] *= alpha; } }
            const bf16x8 p00 = pack_step<0>(a0), p01 = pack_step<1>(a0), p10 = pack_step<0>(a1), p11 = pack_step<1>(a1);
#pragma unroll
            for (int mb = 0; mb < 2; ++mb) o[mb] = MFMA32(ldvt_l(vtl + (32 * mb + r31) * 72 + 4 * hh), p00, o[mb]);
#pragma unroll
            for (int mb = 0; mb < 2; ++mb) o[mb] = MFMA32(ldvt_l(vtl + (32 * mb + r31) * 72 + 16 + 4 * hh), p01, o[mb]);
#pragma unroll
            for (int mb = 0; mb < 2; ++mb) o[mb] = MFMA32(ldvt_l(vtl + (32 * mb + r31) * 72 + 32 + 4 * hh), p10, o[mb]);
#pragma unroll
            for (int mb = 0; mb < 2; ++mb) o[mb] = MFMA32(ldvt_l(vtl + (32 * mb + r31) * 72 + 48 + 4 * hh), p11, o[mb]); };
        auto gload_a = [&](int K0, u32x4& kr, u32x4& vr) {
            const bf16_t* kp = kb + (long)(K0 + prow) * 64 + pcol; const bf16_t* vp = vt + (long)prow * SEQ + K0 + pcol;
            asm volatile("global_load_dwordx4 %0, %2, off\n\tglobal_load_dwordx4 %1, %3, off" : "=&v"(kr), "=&v"(vr) : "v"(kp), "v"(vp) : "memory"); };
        auto step = [&](int i, u32x4& kNext, u32x4& vNext, u32x4& kFar, u32x4& vFar) {
            gload_a(k0of(min(i + 3, nt - 1)), kFar, vFar);
            const int K0 = k0of(i); const int slot = i & 1;
            const bool n0 = need_fn(K0), n1 = need_fn(K0 + 32);
            if (n0 && n1) process2(K0, Kr + slot * 4608, Vr + slot * 4608);
            else if (n0) process(K0, Kr + slot * 4608, Vr + slot * 4608);
            else if (n1) process(K0 + 32, Kr + slot * 4608 + 32 * 72, Vr + slot * 4608 + 32);
            asm volatile("s_waitcnt vmcnt(4)" : "+v"(kNext), "+v"(vNext) :: "memory");
            if (i + 1 < nt) lwrite((i + 1) & 1, kNext, vNext);
            __syncthreads(); };
        u32x4 k0r, v0r, k1r, v1r, k2r, v2r;
        if (nt > 0) {
            gload_a(k0of(0), k0r, v0r); gload_a(k0of(min(1, nt - 1)), k1r, v1r); gload_a(k0of(min(2, nt - 1)), k2r, v2r);
            asm volatile("s_waitcnt vmcnt(4)" : "+v"(k0r), "+v"(v0r) :: "memory");
            lwrite(0, k0r, v0r);
        }
        __syncthreads();
        for (int i = 0; i < nt; i += 3) {
            step(i, k1r, v1r, k0r, v0r);
            if (i + 1 < nt) step(i + 1, k2r, v2r, k1r, v1r);
            if (i + 2 < nt) step(i + 2, k0r, v0r, k2r, v2r);
        }
        if (nt > 0) asm volatile("s_waitcnt vmcnt(0)" : "+v"(k0r), "+v"(v0r), "+v"(k1r), "+v"(v1r), "+v"(k2r), "+v"(v2r) :: "memory");
        settle(o[0], o[1]);
        lsum += shflx<32>(lsum);
        const float sc = lsum > 0.f ? gate / lsum : 0.f;
#pragma unroll
        for (int mb = 0; mb < 2; ++mb)
#pragma unroll
            for (int i = 0; i < 16; ++i) oL[(mb * 16 + i) * 64 + lane] += keep ? sc * o[mb][i] : 0.f;
    };
    {
        const bf16_t* kb = p.ksn + ((long)(b * 4 + g) * SEQ) * 64; const bf16_t* vt = p.vsT + ((long)(b * 4 + g) * 64) * SEQ;
        const unsigned long long mm = mymask, myun = un;
#ifndef REP_SLC
#define REP_SLC 1
#define REP_WIN 1
#endif
        for (int rep = 0; rep < REP_SLC; ++rep)
        branch(kb, vt, nsl, [&](int i) { return __builtin_amdgcn_readfirstlane(tl[1 + i]); },
               [&](int key0) { return ((myun >> (key0 >> 6)) & 1ull) != 0ull && key0 <= s0 + 7; },
               [&](int key0, f32x16& acc) { const bool rowsel = ((mm >> (key0 >> 6)) & 1ull) != 0ull;
                   if (key0 + 31 <= s0) return !rowsel;
#pragma unroll
                   for (int i = 0; i < 16; ++i) acc[i] = (rowsel && key0 + crow(i, hh) <= tq) ? acc[i] : -1e30f;
                   return false; }, gate_s, rep == 0);
    }
#ifdef TPROBE
    TP(3);
#endif
    {
        const bf16_t* kb = p.kwn + ((long)(b * 4 + g) * SEQ) * 64; const bf16_t* vt = p.vwT + ((long)(b * 4 + g) * 64) * SEQ;
        const int T_lo = max(0, S0 - 511) >> 6, T_hi = (S0 + 63) >> 6;
        const int k_lo = (max(0, s0 - 511) >> 5) * 32, k_hi = ((s0 + 7) >> 5) * 32;
        for (int rep = 0; rep < REP_WIN; ++rep)
        branch(kb, vt, T_hi - T_lo + 1, [&](int i) { return (T_lo + i) * 64; },
               [&](int key0) { return key0 >= k_lo && key0 <= k_hi; },
               [&](int key0, f32x16& acc) {
                   if (!(key0 + 31 <= s0 && key0 > s0 + 7 - 512)) {
#pragma unroll
                       for (int i = 0; i < 16; ++i) { const int pos = key0 + crow(i, hh); acc[i] = (pos <= tq && pos > tq - 512) ? acc[i] : -1e30f; } }
                   return false; }, gate_w, rep == 0);
    }
    bf16_t* dst = p.mix + tok * D + 1024 + (g * 4 + rr) * 64;
#pragma unroll
    for (int mb = 0; mb < 2; ++mb)
#pragma unroll
        for (int qd = 0; qd < 4; ++qd) { const LAS float* q = oL + (mb * 16 + 4 * qd) * 64 + lane; u32x2 o; o.x = pk2(q[0], q[64]); o.y = pk2(q[128], q[192]);
            *(u32x2*)(dst + 32 * mb + 8 * qd + 4 * hh) = o; }
    __syncthreads();
#ifdef TPROBE
    TP(4);
    if (unit == TPROBE_UNIT && l == 0 && tid == 0) p.err[3445] = (unsigned)nsl;
#endif
}
DI void s5_glu_item(CP p, int l, int item, LAS char* lds) {
    const int tid = tidx(), lane = tid & 63, w = __builtin_amdgcn_readfirstlane(tid >> 6), fr = lane & 15, fq = lane >> 4;
    const long tok0 = (long)item * 64;
    LAS bf16_t* Ys = (LAS bf16_t*)lds;
    LAS float* red = (LAS float*)(lds + 64 * 520 * 2);
#pragma unroll
    for (int i = 0; i < 8; ++i) { const int e = tid + i * 512, r = e >> 6, c = e & 63; *(LAS u32x4*)(Ys + r * 520 + c * 8) = *(const u32x4*)(p.s5y + (tok0 + r) * 512 + c * 8); }
    __syncthreads();
    f32x4 acc[4][4];
#pragma unroll
    for (int nb = 0; nb < 4; ++nb)
#pragma unroll
        for (int it = 0; it < 4; ++it) acc[nb][it] = ZERO4;
    const bf16_t* gw = p.gluT + l * LW_GLU + (long)(w * 64 + fr) * 512 + 8 * fq;
#pragma unroll 8
    for (int ks = 0; ks < 16; ++ks) {
        bf16x8 a[4], bb[4];
#pragma unroll
        for (int it = 0; it < 4; ++it) a[it] = ld8(Ys + (it * 16 + fr) * 520 + ks * 32 + 8 * fq);
#pragma unroll
        for (int nb = 0; nb < 4; ++nb) bb[nb] = ld8(gw + (long)nb * 16 * 512 + ks * 32);
#pragma unroll
        for (int nb = 0; nb < 4; ++nb)
#pragma unroll
            for (int it = 0; it < 4; ++it) acc[nb][it] = MFMA16(bb[nb], a[it], acc[nb][it]);
    }
    settle(acc[0][0], acc[0][1], acc[0][2], acc[0][3], acc[1][0], acc[1][1], acc[1][2], acc[1][3]);
    settle(acc[2][0], acc[2][1], acc[2][2], acc[2][3], acc[3][0], acc[3][1], acc[3][2], acc[3][3]);
#pragma unroll
    for (int it = 0; it < 4; ++it) { const int i = it * 16 + fr; float s = 0.f;
#pragma unroll
        for (int nb = 0; nb < 4; ++nb) { const int n0 = w * 64 + nb * 16 + 4 * fq;
            const u32x2 yy = *(const LAS u32x2*)(Ys + i * 520 + n0); const f32x4 gb = *(const f32x4*)(p.in[I_GLU_B] + l * 512 + n0);
            const float y0 = __uint_as_float(yy.x << 16), y1 = __uint_as_float(yy.x & 0xffff0000u), y2 = __uint_as_float(yy.y << 16), y3 = __uint_as_float(yy.y & 0xffff0000u);
            f32x4 v = acc[nb][it]; v[0] = y0 * sigmoidf_(v[0] + gb[0]); v[1] = y1 * sigmoidf_(v[1] + gb[1]); v[2] = y2 * sigmoidf_(v[2] + gb[2]); v[3] = y3 * sigmoidf_(v[3] + gb[3]);
            acc[nb][it] = v; s += v[0] * v[0] + v[1] * v[1] + v[2] * v[2] + v[3] * v[3]; }
        s += shflx<16>(s); s += shflx<32>(s);
        if (fq == 0) red[w * 64 + i] = s; }
    __syncthreads();
#pragma unroll
    for (int it = 0; it < 4; ++it) { const int i = it * 16 + fr; float tot = 0.f;
#pragma unroll
        for (int ww = 0; ww < 8; ++ww) tot += red[ww * 64 + i];
        const float rstd = rsqrtf(tot * (1.f / 512.f) + EPS);
#pragma unroll
        for (int nb = 0; nb < 4; ++nb) { const int n0 = w * 64 + nb * 16 + 4 * fq; const f32x4 gn = *(const f32x4*)(p.in[I_S5NORM] + l * 512 + n0); const f32x4 v = acc[nb][it];
            u32x2 o; o.x = pk2(v[0] * rstd * gn[0], v[1] * rstd * gn[1]); o.y = pk2(v[2] * rstd * gn[2], v[3] * rstd * gn[3]);
            *(u32x2*)(p.mix + (tok0 + i) * D + n0) = o; } }
    __syncthreads();
}

DI void nsa_outnorm(CP p, int l) {
    const int lane = tidx() & 63, gw = bidx() * 8 + __builtin_amdgcn_readfirstlane(tidx() >> 6), nw = gdim() * 8;
    const float* gain = p.in[I_NSA_NORM] + l * 1024 + lane * 16;
    for (int t0 = gw; t0 < T; t0 += 4 * nw) {
        bf16x8 v0[4], v1[4]; float ss[4];
#pragma unroll
        for (int q = 0; q < 4; ++q) { const int t = min(t0 + q * nw, T - 1); const bf16_t* row = p.mix + (long)t * D + 1024 + lane * 16; v0[q] = ld8(row); v1[q] = ld8(row + 8); }
#pragma unroll
        for (int q = 0; q < 4; ++q) { float s = 0.f;
#pragma unroll
            for (int e = 0; e < 8; ++e) { const float a = bf2f((bf16_t)v0[q][e]), b = bf2f((bf16_t)v1[q][e]); s += a * a + b * b; }
            ss[q] = s; }
#pragma unroll
        for (int q = 0; q < 4; ++q) ss[q] += shflx<1>(ss[q]);
#pragma unroll
        for (int q = 0; q < 4; ++q) ss[q] += shflx<2>(ss[q]);
#pragma unroll
        for (int q = 0; q < 4; ++q) ss[q] += shflx<4>(ss[q]);
#pragma unroll
        for (int q = 0; q < 4; ++q) ss[q] += shflx<8>(ss[q]);
#pragma unroll
        for (int q = 0; q < 4; ++q) ss[q] += shflx<16>(ss[q]);
#pragma unroll
        for (int q = 0; q < 4; ++q) ss[q] += shflx<32>(ss[q]);
#pragma unroll
        for (int q = 0; q < 4; ++q) { const int t = t0 + q * nw; if (t < T) {
            bf16_t* row = p.mix + (long)t * D + 1024 + lane * 16;
            const float rstd = rsqrtf(ss[q] * (1.f / 1024.f) + EPS);
            u32x4 o0, o1;
#pragma unroll
            for (int e = 0; e < 4; ++e) { o0[e] = pk2(bf2f((bf16_t)v0[q][2 * e]) * rstd * gain[2 * e], bf2f((bf16_t)v0[q][2 * e + 1]) * rstd * gain[2 * e + 1]);
                o1[e] = pk2(bf2f((bf16_t)v1[q][2 * e]) * rstd * gain[8 + 2 * e], bf2f((bf16_t)v1[q][2 * e + 1]) * rstd * gain[9 + 2 * e]); }
            *(u32x4*)row = o0; *(u32x4*)(row + 8) = o1; } }
    }
}

DI void p6_outproj(CP p, int l, LAS char* lds) {
    unsigned aoff[2][2], boff[2];
#pragma unroll
    for (int i = 0; i < 2; ++i) { int R, C; g8::my_rc(i, R, C); boff[i] = (unsigned)(R * D + C) * 2u; aoff[0][i] = boff[i]; aoff[1][i] = (unsigned)((128 + R) * D + C) * 2u; }
    const float* xres = l == 0 ? p.in[I_X] : p.out; const float* lnf = p.in[I_LN_FFN] + l * D;
    for (int u = bidx();; u += gdim()) {
        int pm, pn; if (!g8::unit_of(u, T / 256, D / 256, pm, pn)) break;
        float* hh = p.h; bf16_t* hb = p.xb;
        g8::gemm_tile(lds, (const char*)(p.mix + (long)pm * 256 * D), aoff, 128, (const char*)(p.WoutT + l * LW_WOUT + (long)pn * 256 * D), boff, 128L * D * 2, D / 64, [&](const Acc& acc, int rb, int cb) {
            ACC_FOR(ai, m, bj, n) { const int r = ai * 128 + m * 16 + rb, c = bj * 128 + n * 16 + cb; const long off = (long)(pm * 256 + r) * D + pn * 256 + c;
                const f32x4 v = acc[ai][bj][m][n] + *(const f32x4*)(xres + off);
                *(f32x4*)(hh + off) = v; }
        });
    }
}

DI void router_phase(CP p, int l, LAS char* lds) {
    const int tid = tidx(), lane = tid & 63, w = __builtin_amdgcn_readfirstlane(tid >> 6), fr = lane & 15, fq = lane >> 4, half = w & 1;
    for (int tg0 = bidx() * 4; tg0 < T / 16; tg0 += gdim() * 4) {
        const long t0 = (long)(tg0 + (w >> 1)) * 16;
        f32x4 acc[3] = {ZERO4, ZERO4, ZERO4}; float ss = 0.f;
        const float* hr = p.h + (t0 + fr) * D + half * (D / 2) + 4 * fq; const float* wr = p.Wr + (long)fr * D + half * (D / 2) + 4 * fq;
        const float* lnf = p.in[I_LN_FFN] + l * D + half * (D / 2) + 4 * fq; bf16_t* hbr = p.xb + (t0 + fr) * D + half * (D / 2) + 4 * fq;
#pragma unroll 4
        for (int k0 = 0; k0 < D / 2; k0 += 16) {
            const f32x4 hv = *(const f32x4*)(hr + k0);
            { const f32x4 g4 = *(const f32x4*)(lnf + k0); u32x2 hw; hw.x = pk2h(hv[0] * g4[0], hv[1] * g4[1]); hw.y = pk2h(hv[2] * g4[2], hv[3] * g4[3]); *(u32x2*)(hbr + k0) = hw; }
            f32x4 wv[3];
#pragma unroll
            for (int nb = 0; nb < 3; ++nb) wv[nb] = *(const f32x4*)(wr + (long)nb * 16 * D + k0);
            ss += hv[0] * hv[0] + hv[1] * hv[1] + hv[2] * hv[2] + hv[3] * hv[3];
#pragma unroll
            for (int jx = 0; jx < 4; ++jx)
#pragma unroll
                for (int nb = 0; nb < 3; ++nb) acc[nb] = __builtin_amdgcn_mfma_f32_16x16x4f32(hv[jx], wv[nb][jx], acc[nb], 0, 0, 0);
        }
        settle(acc[0], acc[1]); settle(acc[2]);
        ss += shflx<16>(ss); ss += shflx<32>(ss);
        LAS float* lg = (LAS float*)(lds + w * 16384);
        if (fq == 0) lg[16 * 48 + fr] = ss;
#pragma unroll
        for (int nb = 0; nb < 3; ++nb)
#pragma unroll
            for (int j = 0; j < 4; ++j) lg[(4 * fq + j) * 48 + nb * 16 + fr] = acc[nb][j];
        __syncthreads();
        if (half == 0 && lane < 16) {
            const LAS float* q0 = lg + lane * 48; const LAS float* q1 = (const LAS float*)(lds + (w + 1) * 16384) + lane * 48;
            const long t = t0 + lane; const float rs = rsqrtf((lg[16 * 48 + lane] + ((const LAS float*)(lds + (w + 1) * 16384))[16 * 48 + lane]) * (1.f / D) + EPS);
            float gl[4]; int grp = 0; float gm = -3.4e38f;
#pragma unroll
            for (int i = 0; i < 4; ++i) { gl[i] = (q0[i] + q1[i]) * rs + p.in[I_GROUP_B][l * 4 + i]; if (gl[i] > gm) { gm = gl[i]; grp = i; } }
            float se = 0.f;
#pragma unroll
            for (int i = 0; i < 4; ++i) se += expf(gl[i] - gm);
            const float pg = 1.f / se;
            float v0 = -3.4e38f, v1 = -3.4e38f; int i0 = 0, i1 = 0;
#pragma unroll
            for (int i = 0; i < 8; ++i) { const float e = (q0[4 + grp * 8 + i] + q1[4 + grp * 8 + i]) * rs + p.in[I_EXPERT_B][l * 32 + grp * 8 + i];
                if (e > v0) { v1 = v0; i1 = i0; v0 = e; i0 = i; } else if (e > v1) { v1 = e; i1 = i; } }
            const float w0 = 1.f / (1.f + expf(v1 - v0)), w1 = 1.f - w0;
            const int e0 = grp * 8 + i0, e1 = grp * 8 + i1;
            int* cnt = p.cnt + l * 32;
            const int p0 = atomicAdd(cnt + e0, 1), p1 = atomicAdd(cnt + e1, 1);
            p.tok_list[e0 * T + p0] = (int)t; p.w_list[e0 * T + p0] = w0 * pg;
            p.tok_list[e1 * T + p1] = (int)t; p.w_list[e1 * T + p1] = w1 * pg;
            int* ti = p.tokinfo + t * 4; ti[0] = e0; ti[1] = p0; ti[2] = e1; ti[3] = p1;
            p.rstd_ffn[t] = rs;
        }
        __syncthreads();
    }
}

DI void moe_table(CP p, int l, LAS int* tab) {
    if (tidx() < 64) { const int lane = tidx(); const int c = lane < 32 ? p.cnt[l * 32 + lane] : 0; const int ntl = (c + 255) >> 8; int inc = ntl;
#pragma unroll
        for (int o = 1; o < 32; o <<= 1) { const int v = shfl_up_i(inc, o, lane); if ((lane & 31) >= o) inc += v; }
        if (lane < 32) { tab[lane] = inc - ntl; tab[64 + lane] = c; if (lane == 31) tab[32] = inc; } }
    __syncthreads();
}
DI void p8_moe_up(CP p, int l, LAS char* lds) {
    LAS int* tab = (LAS int*)(lds + 140 * 1024);
    moe_table(p, l, tab);
    const int ntiles = tab[32];
    unsigned aoff[2][2], boff[2];
#pragma unroll
    for (int i = 0; i < 2; ++i) { int R, C; g8::my_rc(i, R, C); boff[i] = (unsigned)(R * D + C) * 2u; }
    for (int u = bidx(); u < ntiles * 4; u += gdim()) {
        const int tile = u >> 2, pn = u & 3;
        const int e = __popcll(__ballot((tidx() & 63) < 32 && tab[tidx() & 31] <= tile)) - 1;
        const int mt = tile - tab[e], cnt_e = tab[64 + e];
        const int* tl = p.tok_list + e * T;
#pragma unroll
        for (int h = 0; h < 2; ++h)
#pragma unroll
            for (int i = 0; i < 2; ++i) { int R, C; g8::my_rc(i, R, C); const int pos = mt * 256 + h * 128 + R; const int tk = tl[pos < cnt_e ? pos : 0];
                aoff[h][i] = (unsigned)(((long)tk * D + C) * 2); }
        bf16_t* hid = p.hid; const float* rsf = p.rstd_ffn;
        g8::gemm_tile(lds, (const char*)p.xb, aoff, 128, (const char*)(p.WguT + l * LW_WGU + ((long)e * 1024 + pn * 256) * D), boff, 128L * D * 2, D / 64, [&](const Acc& acc, int rb, int cb) {
#pragma unroll
            for (int ai = 0; ai < 2; ++ai)
#pragma unroll
                for (int m = 0; m < 4; ++m) { const int r = ai * 128 + m * 16 + rb; const int pos = mt * 256 + r; const float rs = rsf[tl[pos < cnt_e ? pos : 0]];
#pragma unroll
                    for (int n = 0; n < 2; ++n) { const f32x4 gt = acc[ai][0][m][n] * rs, up = acc[ai][1][m][n] * rs;
                        u32x2 o; o.x = pk2h(siluf_(gt[0]) * up[0], siluf_(gt[1]) * up[1]); o.y = pk2h(siluf_(gt[2]) * up[2], siluf_(gt[3]) * up[3]);
                        *(u32x2*)(hid + ((long)tile * 256 + r) * DEXP + pn * 128 + n * 16 + cb) = o; } }
        });
    }
}
DI void p9_moe_down(CP p, int l, LAS char* lds) {
    LAS int* tab = (LAS int*)(lds + 140 * 1024);
    moe_table(p, l, tab);
    const int ntiles = tab[32];
    unsigned aoff[2][2], boff[2];
#pragma unroll
    for (int i = 0; i < 2; ++i) { int R, C; g8::my_rc(i, R, C); boff[i] = (unsigned)(R * DEXP + C) * 2u; aoff[0][i] = boff[i]; aoff[1][i] = (unsigned)((128 + R) * DEXP + C) * 2u; }
    for (int u = bidx(); u < ntiles * 8; u += gdim()) {
        const int tile = u >> 3, pn = u & 7;
        const int e = __popcll(__ballot((tidx() & 63) < 32 && tab[tidx() & 31] <= tile)) - 1;
        const int mt = tile - tab[e], cnt_e = tab[64 + e];
        bf16_t* yb = p.ybuf; const float* wl_ = p.w_list + e * T;
        g8::gemm_tile(lds, (const char*)(p.hid + (long)tile * 256 * DEXP), aoff, 128, (const char*)(p.WdT + l * LW_WD + ((long)e * D + pn * 256) * DEXP), boff, 128L * DEXP * 2, DEXP / 64, [&](const Acc& acc, int rb, int cb) {
#pragma unroll
            for (int ai = 0; ai < 2; ++ai)
#pragma unroll
                for (int m = 0; m < 4; ++m) { const int r = ai * 128 + m * 16 + rb; const int pos = mt * 256 + r; const float wt = pos < cnt_e ? wl_[pos] : 0.f;
#pragma unroll
                    for (int bj = 0; bj < 2; ++bj)
#pragma unroll
                        for (int n = 0; n < 2; ++n) { const f32x4 v = acc[ai][bj][m][n] * wt; u32x2 o; o.x = pk2h(v[0], v[1]); o.y = pk2h(v[2], v[3]);
                            *(u32x2*)(yb + ((long)tile * 256 + r) * D + pn * 256 + bj * 128 + n * 16 + cb) = o; } }
        });
    }
}
constexpr int NPH = 19;
#define XCD_BAR_WORDS 3456
#ifndef PH_EN
#define PH_EN 0xffffffffu
#endif
#define EN(i) ((PH_EN >> (i)) & 1u)
#ifndef REP_CV
#define REP_CV 1
#endif
#ifndef NCONV
#define NCONV 64
#endif
#ifndef MULTI_LAUNCH
#define MULTI_LAUNCH 0
#endif
typedef const __attribute__((address_space(4))) Params* CPP;
template <int PH>
DI void run_phase(LAS char* lds_) {
    unsigned lbase = (unsigned)(size_t)lds_; asm volatile("" : "+s"(lbase)); LAS char* lds = (LAS char*)(size_t)lbase;
    CPP pp = (CPP)__builtin_amdgcn_kernarg_segment_ptr();
    asm volatile("" : "+s"(pp));
    CP p = *pp;
    const int tid = tidx(), w = __builtin_amdgcn_readfirstlane(tid >> 6), G = gdim();
    LAS char* wl = lds + w * 16384;
    const int gw = bidx() * 8 + w, nw = G * 8;
    if constexpr (PH == 0 || PH == 9) {
        if (EN(0)) { if (PH == 0) { tconv_range(p, 0, 0, TCONV_EARLY, bidx(), G, lds); tconv_narrow(p, 0, bidx(), G, lds); } p0_tables(p, PH == 9 ? 1 : 0, lds); }
        if (PH == 0) p0_once(p);
        if (EN(1)) p1_rows(p, PH == 9 ? 1 : 0, 0, PH == 9 ? 1 : 0);
    } else if constexpr (PH == 18) {
        if (EN(1)) p1_rows(p, 2, 1, 0);
    } else {
        constexpr int l = PH >= 10 ? 1 : 0; constexpr int k = PH - (l ? 10 : 1);
        if constexpr (k == 0) { if (EN(2)) p2_inproj(p, l, lds); }
        else if constexpr (k == 1) {
#ifndef REP_A
#define REP_A 1
#define REP_B 1
#define REP_C 1
#define REP_D 1
#endif
            if (EN(3)) for (int rep = 0; rep < REP_A; ++rep) for (int u = bidx(); u < 32; u += G) nsa_cmp_unit(p, l, u, lds);
            if (EN(6)) for (int rep = 0; rep < REP_D; ++rep) { nsa_prep_elem(p, l); nsa_vtrans(p, wl); }
            LAS int* shp = (LAS int*)(lds + 156 * 1024);
            if (EN(4)) {
                for (;;) {
                    __syncthreads();
                    if (tid == 0) shp[0] = atomicAdd(p.cnt + 68 + l, 1);
                    __syncthreads();
                    const int it = shp[0];
                    if (it >= 1024 * REP_B) break;
                    gdn_prep_item(p, l, it & 1023, lds);
                }
            }
            if (EN(5)) for (;;) {
                __syncthreads();
                if (tid == 0) shp[0] = atomicAdd(p.cnt + 74 + l, 1);
                __syncthreads();
                const int base = shp[0];
                if (base >= 1024 * REP_C) break;
                s5_item(p, l, (base & 1023) * 8 + w, 1, wl);
            }
        } else if constexpr (k == 2) {
            if (EN(7)) if (bidx() < 16) gdn_chain(p, bidx(), lds);
            if (EN(0)) {
                const int cv0 = G >= 16 + NCONV ? 16 : 0, nb = G >= 16 + NCONV ? NCONV : G, bi = bidx() - cv0;
                if (bi >= 0 && bi < nb) {
                    tconv_range(p, l, TCONV_EARLY + (((T / 256) * (NPROJ / 256)) % G != 0 ? TCONV_TAIL : 0), TCONV_FULL, bi, nb, lds);
                    if (l == 0) { tconv_range(p, 1, 0, TCONV_EARLY, bi, nb, lds); tconv_narrow(p, 1, bi, nb, lds); }
                }
            }
            LAS int* sh = (LAS int*)(lds + 150 * 1024);
            __syncthreads();
#ifdef STATIC_ATT
#ifndef REP_ATT
#define REP_ATT 1
#endif
            if (EN(9)) for (int rep = 0; rep < REP_ATT; ++rep) for (int it = bidx(); it < 1024; it += G) { __syncthreads(); if (tid == 0) sh[0] = it; __syncthreads(); nsa_unit(p, l, sh[0], lds); }
#else
            const int q0 = (int)(__builtin_amdgcn_s_getreg((3 << 11) | 20) & 7u);
            for (int qq = 0; qq < 8; ++qq) { const int q = (q0 + qq) & 7;
                for (;;) {
                    __syncthreads();
                    if (tid == 0) sh[0] = atomicAdd(p.cnt + 96 + l * 8 + q, 1);
                    __syncthreads();
                    const int base = sh[0];
                    if (base >= 128) break;
                    if (EN(9)) nsa_unit(p, l, q * 128 + 127 - base, lds);
                } }
#endif
            for (;;) {
                __syncthreads();
                if (tid == 0) sh[0] = atomicAdd(p.cnt + 72 + l, 1);
                __syncthreads();
                const int base = sh[0];
                if (base >= 1024) break;
                if (EN(8)) s5_item(p, l, base * 8 + w, 2, wl);
            }
        } else if constexpr (k == 3) {
#ifndef REP_G
#define REP_G 1
#define REP_O 1
#endif
            if (EN(10)) for (int it = bidx(); it < 256 * REP_G; it += G) s5_glu_item(p, l, it & 255, lds);
            if (EN(11)) for (int it = bidx(); it < 1024 * REP_O; it += G) gdn_out_item(p, l, it & 1023, lds);
            if (EN(12)) nsa_outnorm(p, l);
        } else if constexpr (k == 4) { if (EN(13)) p6_outproj(p, l, lds); }
        else if constexpr (k == 5) { if (EN(14)) router_phase(p, l, lds); }
        else if constexpr (k == 6) { if (EN(15)) p8_moe_up(p, l, lds); }
        else { if (EN(16)) p9_moe_down(p, l, lds); }
    }
}
#if MULTI_LAUNCH
template <int PH>
__global__ void __launch_bounds__(512) phase_k(Params p_) {
    extern __shared__ __attribute__((aligned(16))) char smem_raw[];
    run_phase<PH>((LAS char*)smem_raw);
}
#ifndef DBG_STOP
#define DBG_STOP 99
#endif
#ifndef DBG_SRC
#define DBG_SRC 0
#endif
__global__ void dbg_copy(Params p) {
    const long n = (long)T * D;
    for (long i = (long)blockIdx.x * blockDim.x + threadIdx.x; i < n; i += (long)gridDim.x * blockDim.x) {
        const long t = i / D, c = i % D; float v;
        if (DBG_SRC == 0) v = p.h[i];
        else if (DBG_SRC == 1) v = bf2f(p.mix[i]);
        else if (DBG_SRC == 2) v = bf2f(p.proj[t * NPROJ + c]);
        else if (DBG_SRC == 3) v = bf2f(p.xb[i]);
        else if (DBG_SRC == 5) v = bf2f(p.proj[t * NPROJ + 2560 + c]);
        else if (DBG_SRC == 6) v = c < 512 ? bf2f(p.s5y[t * 512 + c]) : (c < 1536 ? bf2f(p.qn[t * 1024 + c - 512]) : bf2f(p.ksn[t * 256 + (c - 1536) % 256]));
        else if (DBG_SRC == 8) { const int* ti = p.tokinfo + t * 4; const int k = (int)(c & 3); v = k == 0 ? (float)ti[0] : k == 1 ? (float)ti[2] : k == 2 ? p.w_list[ti[0] * T + ti[1]] : p.w_list[ti[2] * T + ti[3]] + p.rstd_ffn[t]; }
        else if (DBG_SRC == 9) { const int* ti = p.tokinfo + t * 4; int ts0 = 0, ts1 = 0; for (int e = 0; e < 32; ++e) { const int nt_ = (p.cnt[e] + 255) >> 8; if (e < ti[0]) ts0 += nt_; if (e < ti[2]) ts1 += nt_; }
            const long s0 = (long)ts0 * 256 + ti[1], s1 = (long)ts1 * 256 + ti[3]; v = c < 1024 ? bf2f(p.hid[s0 * 512 + (c & 511)]) : bf2f(p.hid[s1 * 512 + (c & 511)]); }
        else if (DBG_SRC == 10) { const int* ti = p.tokinfo + t * 4; int ts0 = 0, ts1 = 0; for (int e = 0; e < 32; ++e) { const int nt_ = (p.cnt[e] + 255) >> 8; if (e < ti[0]) ts0 += nt_; if (e < ti[2]) ts1 += nt_; }
            const long s0 = (long)ts0 * 256 + ti[1], s1 = (long)ts1 * 256 + ti[3]; v = bf2f(p.ybuf[s0 * D + c]) + 3.f * bf2f(p.ybuf[s1 * D + c]); }
        else if (DBG_SRC == 13) v = p.small[t * NSMALL + (c % 56)];
        else if (DBG_SRC == 14) v = ((const float*)p.s5E)[i % (4L * 64 * 32 * 64 * 2)] - ((const float*)p.gRT)[i % (4L * 64 * 32 * 64 * 2)];
        else if (DBG_SRC == 11) v = ((const float*)p.s5E)[i % (4L * 64 * 32 * 64 * 2)];
        else if (DBG_SRC == 12) v = c < 1024 ? ((const float*)p.s5lam)[(t * 1024 + c) % 8192] : bf2f(((c & 1) ? p.s5Bt : p.s5Ct)[(t * 1024 + c) % 65536]);
        else v = 0.f;
#ifdef DBG_AMP
        v = v * DBG_AMP; v = v - floorf(v);
#endif
#ifdef DBG_C0
        if (c < DBG_C0 || c >= DBG_C1) v = 0.f;
#endif
        p.out[i] = v;
    }
}
template <int PH> static void launch_phases(const Params& p, int grid, hipStream_t stream) {
    if constexpr (PH < NPH && PH <= DBG_STOP) {
#ifdef REP_PH
        for (int rep = 0; rep < (PH == REP_PH ? REP_N : 0); ++rep) { hipLaunchKernelGGL(phase_k<PH>, dim3(grid), dim3(512), LDS_BYTES, stream, p); (void)hipMemsetAsync(p.cnt + 64, 0, 192 * 4, stream); }
#endif
        hipLaunchKernelGGL(phase_k<PH>, dim3(grid), dim3(512), LDS_BYTES, stream, p); launch_phases<PH + 1>(p, grid, stream); }
    else if constexpr (PH < NPH && DBG_SRC != 7) hipLaunchKernelGGL(dbg_copy, dim3(1024), dim3(256), 0, stream, p);
}
template <int PH> static bool set_attr() {
    if constexpr (PH < NPH) { if (hipFuncSetAttribute((const void*)phase_k<PH>, hipFuncAttributeMaxDynamicSharedMemorySize, LDS_BYTES) != hipSuccess) return false; return set_attr<PH + 1>(); }
    return true;
}
#else
#define XB_TMO      128
#define XB_XCNT(j)  (256  + 64 * (j))
#define XB_XSUB(j)  (1280 + 64 * (j))
#define XB_XGEN(j)  (2304 + 64 * (j))
#define XB_TOP      3328
#define XB_TOPGEN   3392
#define XB_SPIN_CAP (1u << 22)
DI unsigned xb_ld(unsigned* q) { return __hip_atomic_load(q, __ATOMIC_RELAXED, __HIP_MEMORY_SCOPE_AGENT); }
DI unsigned xb_add(unsigned* q, unsigned v) { return __hip_atomic_fetch_add(q, v, __ATOMIC_RELAXED, __HIP_MEMORY_SCOPE_AGENT); }
DI unsigned xb_xcc_id() { return (unsigned)__builtin_amdgcn_s_getreg((3 << 11) | 20) & 0xFu; }
#define XB_SPIN(cond, bar) do { unsigned _sp = 0; while (cond) { __builtin_amdgcn_s_sleep(1); \
    if ((++_sp & 255u) == 0u) { if (xb_ld(&(bar)[XB_TMO])) break; if (_sp > XB_SPIN_CAP) { atomicAdd(&(bar)[XB_TMO], 1u); break; } } } } while (0)
DI void xcd_post() {
    CPP pp = (CPP)__builtin_amdgcn_kernarg_segment_ptr(); asm volatile("" : "+s"(pp));
    if (tidx() == 0) (void)xb_add(&pp->err[XB_XCNT(xb_xcc_id())], 1u);
}
DI void grid_barrier(LAS char* lds_) {
    unsigned lbase = (unsigned)(size_t)lds_; asm volatile("" : "+s"(lbase));
    volatile LAS unsigned* st = (volatile LAS unsigned*)(size_t)(lbase + 159 * 1024);
    CPP pp = (CPP)__builtin_amdgcn_kernarg_segment_ptr(); asm volatile("" : "+s"(pp));
    unsigned* bar = pp->err;
    asm volatile("s_waitcnt vmcnt(0)" ::: "memory");
    __syncthreads();
    if (tidx() == 0) {
        __builtin_amdgcn_s_waitcnt(0);
        const unsigned x = xb_xcc_id();
        unsigned nloc = st[0], nx = st[1];
        if (nloc == 0u) {
            const unsigned G = (unsigned)gdim(); unsigned sum, cnt, mine, sp = 0u;
            for (;;) { sum = 0u; cnt = 0u; mine = 0u;
#pragma unroll
                for (unsigned j = 0; j < 16; ++j) { const unsigned c = xb_ld(&bar[XB_XCNT(j)]); sum += c; cnt += (c > 0u) ? 1u : 0u; mine = (j == x) ? c : mine; }
                if (sum == G) break;
                __builtin_amdgcn_s_sleep(1);
                if ((++sp & 255u) == 0u) { if (xb_ld(&bar[XB_TMO])) break; if (sp > XB_SPIN_CAP) { atomicAdd(&bar[XB_TMO], 1u); break; } } }
            nloc = mine > 0u ? mine : 1u; nx = cnt > 0u ? cnt : 1u; st[0] = nloc; st[1] = nx; }
        const unsigned old = xb_add(&bar[XB_XSUB(x)], 1u);
        const unsigned gen = old / nloc;
        if (old + 1u == (gen + 1u) * nloc) {
            __builtin_amdgcn_fence(__ATOMIC_RELEASE, "agent");
            asm volatile("s_waitcnt vmcnt(0)" ::: "memory");
            const unsigned og = xb_add(&bar[XB_TOP], 1u);
            const unsigned tg = og / nx;
            if (og + 1u == (tg + 1u) * nx) xb_add(&bar[XB_TOPGEN], 1u);
            else XB_SPIN(xb_ld(&bar[XB_TOPGEN]) == tg, bar);
            __builtin_amdgcn_fence(__ATOMIC_ACQUIRE, "agent");
            xb_add(&bar[XB_XGEN(x)], 1u);
            asm volatile("s_waitcnt vmcnt(0)" ::: "memory");
        } else {
            XB_SPIN(xb_ld(&bar[XB_XGEN(x)]) == gen, bar);
            __builtin_amdgcn_fence(__ATOMIC_ACQUIRE, "agent");
            asm volatile("s_waitcnt vmcnt(0)" ::: "memory");
        }
    }
    __syncthreads();
}
template <int PH>
DI void run_from(LAS char* lds) {
    if constexpr (PH < NPH) { run_phase<PH>(lds); if constexpr (PH + 1 < NPH) grid_barrier(lds); run_from<PH + 1>(lds); }
}
__global__ void __launch_bounds__(512) mega(Params p_) {
    extern __shared__ __attribute__((aligned(16))) char smem_raw[];
    if (tidx() < 2) ((LAS unsigned*)(smem_raw + 159 * 1024))[tidx()] = 0u;
    xcd_post();
    cg::this_grid().sync();
    run_from<0>((LAS char*)smem_raw);
}
#endif

extern "C" void kernel_launch(void* const* d_in, const int* in_sizes, int n_in, void* d_out, int out_size, void* d_ws, size_t ws_size, hipStream_t stream) {
    static int grid = 0;
    if (grid == 0) {
        int dev = 0, cus = 0, per_cu = 0;
        (void)hipGetDevice(&dev); (void)hipDeviceGetAttribute(&cus, hipDeviceAttributeMultiprocessorCount, dev);
#if MULTI_LAUNCH
        if (!set_attr<0>()) { fprintf(stderr, "kernel_launch: hipFuncSetAttribute failed\n"); grid = -1; return; }
        per_cu = 1;
#else
        if (hipFuncSetAttribute((const void*)mega, hipFuncAttributeMaxDynamicSharedMemorySize, LDS_BYTES) != hipSuccess) { fprintf(stderr, "kernel_launch: hipFuncSetAttribute failed\n"); grid = -1; return; }
        if (hipOccupancyMaxActiveBlocksPerMultiprocessor(&per_cu, (const void*)mega, 512, LDS_BYTES) != hipSuccess || per_cu < 1) { fprintf(stderr, "kernel_launch: occupancy query says %d blocks/CU\n", per_cu); per_cu = 1; }
        (void)hipGetLastError();
#endif
        grid = cus;
        if (n_in != 33 || out_size != T * D) { fprintf(stderr, "kernel_launch: unexpected problem shape\n"); grid = -1; return; }
    }
    if (grid < 0) return;
    Params p{};
    for (int i = 0; i < 33; ++i) p.in[i] = (const float*)d_in[i];
    p.out = (float*)d_out;
    size_t off = 0;
    auto take = [&](size_t bytes) { void* r = (char*)d_ws + off; off += (bytes + 255) & ~(size_t)255; return r; };
    p.WinT = (bf16_t*)take(2 * LW_WIN * 2); p.WoutT = (bf16_t*)take(2 * LW_WOUT * 2); p.gluT = (bf16_t*)take(2 * LW_GLU * 2);
    p.w1T = (bf16_t*)take(2 * LW_W1 * 2); p.w2T = (bf16_t*)take(2 * LW_W2 * 2);
    p.WguT = (bf16_t*)take(2 * LW_WGU * 2); p.WdT = (bf16_t*)take(2 * LW_WD * 2); p.Wr = (float*)take(48 * D * 4);
    p.s5Bt = (bf16_t*)take(32 * 128 * 32 * 2); p.s5Ct = (bf16_t*)take(32 * 16 * 128 * 2); p.s5lam = (f32x2*)take(2 * 2048 * 8); p.bias1 = (float*)take(512 * 4);
    p.rope = (f32x2*)take(4096 * 32 * 8);
    p.xb = (bf16_t*)take((size_t)T * D * 2); p.rstd_mix = (float*)take(T * 4); p.rstd_ffn = (float*)take(T * 4);
    p.h = p.out;        p.proj = (bf16_t*)take((size_t)T * NPROJ * 2); p.small = (float*)take((size_t)T * NSMALL * 4);
    p.mix = (bf16_t*)take((size_t)T * D * 2); p.s5y = (bf16_t*)take((size_t)T * 512 * 2); p.s5E = (f32x2*)take((size_t)4 * 64 * 32 * 64 * 8);
    p.qn = (bf16_t*)take((size_t)T * 1024 * 2); p.ksn = (bf16_t*)take((size_t)T * 256 * 2); p.kwn = (bf16_t*)take((size_t)T * 256 * 2);
    p.vsT = (bf16_t*)take((size_t)T * 256 * 2); p.vwT = (bf16_t*)take((size_t)T * 256 * 2);
    p.kcmp = (bf16_t*)take(16 * 256 * 64 * 2); p.vcmpT = (bf16_t*)take(16 * 64 * 256 * 2);
    p.gP = (bf16_t*)take((size_t)1024 * 16384 * 2); p.gRT = (float*)take((size_t)1024 * 16384 * 4); p.gQp = (bf16_t*)take((size_t)1024 * 8192 * 2);
    p.gOU = (float*)take((size_t)1024 * 8192 * 4); p.gST = (bf16_t*)take((size_t)1024 * 16384 * 2); p.gA = (float*)take(1024 * 4);
    p.tok_list = (int*)take((size_t)NEXP * T * 4); p.w_list = (float*)take((size_t)NEXP * T * 4); p.tokinfo = (int*)take((size_t)T * 16);
    p.cnt = (int*)take(256 * 4); p.err = (unsigned*)take(XCD_BAR_WORDS * 4);
    p.hid = (bf16_t*)p.gRT;
    p.ybuf = p.proj;
    if (hipMemsetAsync(p.cnt, 0, 256 * 4 + XCD_BAR_WORDS * 4, stream) != hipSuccess) { fprintf(stderr, "kernel_launch: memset failed\n"); return; }
    if (off > ws_size) { fprintf(stderr, "kernel_launch: workspace too small: need %zu have %zu\n", off, ws_size); return; }
#if MULTI_LAUNCH
    launch_phases<0>(p, grid, stream);
#else
    void* args[] = {&p};
    hipError_t e = hipLaunchCooperativeKernel((const void*)mega, dim3(grid), dim3(512), args, LDS_BYTES, stream);
    if (e != hipSuccess) fprintf(stderr, "kernel_launch: cooperative launch failed: %s (grid %d)\n", hipGetErrorString(e), grid);
#endif
}
```

```cpp
#include <hip/hip_runtime.h>
#include <hip/hip_cooperative_groups.h>
#include <cstdio>
#include <cstdint>
namespace cg = cooperative_groups;

#define DI __device__ __forceinline__
extern "C" __device__ size_t __ockl_get_num_groups(unsigned);
#define LAS __attribute__((address_space(3)))
typedef unsigned short bf16_t;
typedef short bf16x8 __attribute__((ext_vector_type(8)));
typedef short s16x4 __attribute__((ext_vector_type(4)));
typedef float f32x4 __attribute__((ext_vector_type(4)));
typedef float f32x2 __attribute__((ext_vector_type(2)));
typedef float f32x16 __attribute__((ext_vector_type(16)));
typedef unsigned u32x4 __attribute__((ext_vector_type(4)));
typedef unsigned u32x2 __attribute__((ext_vector_type(2)));

constexpr int D = 2048, BATCH = 4, SEQ = 4096, T = BATCH * SEQ, DEPTH = 2;
constexpr int DIN = 5176, NPROJ = 5120, NPAD = 5376, NSMALL = 64;
constexpr int C_U = 0, C_QKV = 512, C_Z = 2048, C_NQ = 2560, C_NKV = 3584;
constexpr int NEXP = 32, DEXP = 512;
constexpr int MOE_TILES_MAX = 160;
constexpr int NCHUNK = 64;
constexpr int LDS_BYTES = 160 * 1024;
constexpr float EPS = 1e-6f;

struct Params {
    const float* in[33];
    float* out;
    bf16_t* WinT; bf16_t* WoutT; bf16_t* gluT; bf16_t* w1T; bf16_t* w2T; bf16_t* WguT; bf16_t* WdT; float* Wr;
    bf16_t* s5Bt; bf16_t* s5Ct; f32x2* s5lam; float* bias1; f32x2* rope;
    bf16_t* xb; float* rstd_mix; float* rstd_ffn; float* h; bf16_t* proj; float* small; bf16_t* mix;
    bf16_t* s5y; f32x2* s5E;
    bf16_t* qn; bf16_t* ksn; bf16_t* kwn; bf16_t* vsT; bf16_t* vwT; bf16_t* kcmp; bf16_t* vcmpT;
    bf16_t* gP; float* gRT; bf16_t* gQp; float* gOU; bf16_t* gST; float* gA;
    int* tok_list; float* w_list; int* tokinfo; int* cnt; bf16_t* hid; bf16_t* ybuf;
    unsigned* err;
};

typedef const __attribute__((address_space(4))) Params& CP;
enum { I_X = 0, I_LN_MIX, I_W_IN, I_LAM_RE, I_LAM_IM, I_B_RE, I_B_IM, I_C_RE, I_C_IM, I_S5D, I_S5LOGDT, I_GLU_W, I_GLU_B,
       I_S5NORM, I_CONV_W, I_A_LOG, I_DT_BIAS, I_GDN_NORM, I_QNORM, I_KNORM, I_CMP_PE, I_CMP_W1, I_CMP_W2, I_NSA_NORM,
       I_W_OUT, I_LN_FFN, I_GROUP_W, I_GROUP_B, I_EXPERT_W, I_EXPERT_B, I_W_GATE, I_W_UP, I_W_DOWN };

DI bf16_t f2bf(float x) { unsigned r; asm("v_cvt_pk_bf16_f32 %0, %1, %1" : "=v"(r) : "v"(x)); return (bf16_t)r; }
DI float bf2f(bf16_t x) { return __uint_as_float(((unsigned)x) << 16); }
DI unsigned pk2(float lo, float hi) { unsigned r; asm("v_cvt_pk_bf16_f32 %0, %1, %2" : "=v"(r) : "v"(lo), "v"(hi)); return r; }
DI unsigned pk2h(float lo, float hi) { unsigned r; asm("v_cvt_pk_bf16_f32 %0, %1, %2" : "=v"(r) : "v"(lo), "v"(hi)); return r; }
DI float sigmoidf_(float x) { return __builtin_amdgcn_rcpf(1.f + __expf(-x)); }
DI float siluf_(float x) { return x * __builtin_amdgcn_rcpf(1.f + __expf(-x)); }
DI float gelu_tanh(float x) { const float u = 0.7978845608028654f * (x + 0.044715f * x * x * x); const float e = __expf(2.f * u); const float th = 1.f - 2.f * __builtin_amdgcn_rcpf(e + 1.f); return 0.5f * x * (1.f + th); }
DI float softplusf_(float x) { return x > 20.f ? x : log1pf(__expf(x)); }
DI int my_lane() { int l = (int)__builtin_amdgcn_mbcnt_hi(~0u, __builtin_amdgcn_mbcnt_lo(~0u, 0u)); asm volatile("" : "+v"(l)); return l; }
template <int M> DI float shflx(float v) {
    if constexpr (M < 32) return __builtin_bit_cast(float, __builtin_amdgcn_ds_swizzle(__builtin_bit_cast(int, v), 0x1f | (M << 10)));
    else return __builtin_bit_cast(float, __builtin_amdgcn_ds_bpermute((my_lane() ^ M) << 2, __builtin_bit_cast(int, v)));
}
DI int shfl_up_i(int v, int o, int lane) { return __builtin_amdgcn_ds_bpermute(((lane - o) & 63) << 2, v); }
DI float shfl_up_f(float v, int o, int lane) { return __builtin_bit_cast(float, __builtin_amdgcn_ds_bpermute(((lane - o) & 63) << 2, __builtin_bit_cast(int, v))); }
DI int shfl_idx_i(int v, int src) { return __builtin_amdgcn_ds_bpermute(src << 2, v); }
DI float wave_sum(float v) {
    v += shflx<1>(v); v += shflx<2>(v); v += shflx<4>(v); v += shflx<8>(v); v += shflx<16>(v); v += shflx<32>(v);
    return v;
}
DI int tidx() { int t = __builtin_amdgcn_workitem_id_x(); asm volatile("" : "+v"(t)); return t; }
DI int bidx() { int b = __builtin_amdgcn_workgroup_id_x(); asm volatile("" : "+s"(b)); return b; }
DI int gdim() { int g = (int)__ockl_get_num_groups(0); asm volatile("" : "+s"(g)); return g; }
DI void lds_wait() { asm volatile("s_waitcnt lgkmcnt(0)" ::: "memory"); }
#define SETTLE_NOPS "s_nop 15\n\ts_nop 15"
DI void settle(f32x4& a) { asm volatile(SETTLE_NOPS : "+v"(a)); }
DI void settle(f32x4& a, f32x4& b) { asm volatile(SETTLE_NOPS : "+v"(a), "+v"(b)); }
DI void settle(f32x4& a, f32x4& b, f32x4& c, f32x4& d) { asm volatile(SETTLE_NOPS : "+v"(a), "+v"(b), "+v"(c), "+v"(d)); }
DI void settle(f32x4& a, f32x4& b, f32x4& c, f32x4& d, f32x4& e, f32x4& f, f32x4& g, f32x4& h) { asm volatile(SETTLE_NOPS : "+v"(a), "+v"(b), "+v"(c), "+v"(d), "+v"(e), "+v"(f), "+v"(g), "+v"(h)); }
DI void settle(f32x16& a) { asm volatile(SETTLE_NOPS : "+v"(a)); }
DI void settle(f32x16& a, f32x16& b) { asm volatile(SETTLE_NOPS : "+v"(a), "+v"(b)); }
#define MFMA16(a, b, c) __builtin_amdgcn_mfma_f32_16x16x32_bf16((a), (b), (c), 0, 0, 0)
#define MFMA32(a, b, c) __builtin_amdgcn_mfma_f32_32x32x16_bf16((a), (b), (c), 0, 0, 0)

namespace g8 {
constexpr int BM = 256, BK = 64, HALF = 128, HT = HALF * BK;
DI int lds_byte(int r, int c) { int st = (r >> 4) * 2 + (c >> 5), rr = r & 15, cc = c & 31, ob = rr * 64 + cc * 2; return st * 1024 + (ob ^ (((ob >> 9) & 1) << 5)); }
DI void stage_rc(int b, int& R, int& C) { int st = b / 1024, sb = b % 1024, swz = sb ^ (((sb >> 9) & 1) << 5); R = (st >> 1) * 16 + swz / 64; C = (st & 1) * 32 + (swz % 64) / 2; }

template <class Epi>
DI void gemm_tile(LAS char* lds, const char* aBase, const unsigned (&aoff)[2][2], long akt, const char* bBase, const unsigned (&boff)[2], long bhalf, int nt, Epi&& epi) {
    const int tid = tidx(), wid = __builtin_amdgcn_readfirstlane(tid >> 6), lane = tid & 63, wr = wid >> 2, wc = wid & 3, fr = lane & 15, fq = lane >> 4;
    const unsigned ldsw = (unsigned)wid * 1024u;
    const int lrA = lds_byte(wr * 64 + fr, fq * 8), lrB = lds_byte(wc * 32 + fr, fq * 8);
#define G8_SA(b, h) (((b) * 2 + (h)) * (HT * 2))
#define G8_SB(b, h) ((4 + (b) * 2 + (h)) * (HT * 2))
#define G8_STAGE_A(bufoff, h, kt) do { const char* _b = aBase + (long)(kt) * akt; _Pragma("unroll") for (int _i = 0; _i < 2; ++_i) \
        __builtin_amdgcn_global_load_lds((const unsigned*)(_b + aoff[h][_i]), (LAS unsigned*)(lds + (bufoff) + ldsw + _i * 8192), 16, 0, 0); } while (0)
#define G8_STAGE_B(bufoff, h, kt) do { const char* _b = bBase + (long)(h) * bhalf + (long)(kt) * 128; _Pragma("unroll") for (int _i = 0; _i < 2; ++_i) \
        __builtin_amdgcn_global_load_lds((const unsigned*)(_b + boff[_i]), (LAS unsigned*)(lds + (bufoff) + ldsw + _i * 8192), 16, 0, 0); } while (0)
#define G8_LDA(dst, b, h) do { _Pragma("unroll") for (int m = 0; m < 4; ++m) _Pragma("unroll") for (int k = 0; k < 2; ++k) dst[m][k] = *(const LAS bf16x8*)(lds + G8_SA(b, h) + lrA + m * 2048 + k * 1024); } while (0)
#define G8_LDB(dst, b, h) do { _Pragma("unroll") for (int n = 0; n < 2; ++n) _Pragma("unroll") for (int k = 0; k < 2; ++k) dst[n][k] = *(const LAS bf16x8*)(lds + G8_SB(b, h) + lrB + n * 2048 + k * 1024); } while (0)
#define G8_MMA(ai, bj, At, Bt) do { __builtin_amdgcn_s_setprio(1); _Pragma("unroll") for (int m = 0; m < 4; ++m) _Pragma("unroll") for (int n = 0; n < 2; ++n) _Pragma("unroll") for (int k = 0; k < 2; ++k) \
        acc[ai][bj][m][n] = MFMA16(Bt[n][k], At[m][k], acc[ai][bj][m][n]); __builtin_amdgcn_s_setprio(0); } while (0)
#define G8_WAIT_V(n) asm volatile("s_waitcnt vmcnt(" #n ")" ::: "memory")
#define G8_WAIT_L(n) asm volatile("s_waitcnt lgkmcnt(" #n ")" ::: "memory")
#define G8_BAR __builtin_amdgcn_s_barrier()
#define G8_SCHED __builtin_amdgcn_sched_barrier(0)
    f32x4 acc[2][2][4][2];
#pragma unroll
    for (int a = 0; a < 2; ++a)
#pragma unroll
        for (int b = 0; b < 2; ++b)
#pragma unroll
            for (int m = 0; m < 4; ++m)
#pragma unroll
                for (int n = 0; n < 2; ++n) acc[a][b][m][n] = (f32x4){0.f, 0.f, 0.f, 0.f};
    bf16x8 At[4][2], B0[2][2], B1[2][2];
    G8_STAGE_B(G8_SB(0, 0), 0, 0); G8_STAGE_A(G8_SA(0, 0), 0, 0); G8_STAGE_B(G8_SB(0, 1), 1, 0); G8_STAGE_A(G8_SA(0, 1), 1, 0);
    if (wr == 1) G8_BAR;
    G8_WAIT_V(4); G8_BAR;
    G8_STAGE_B(G8_SB(1, 0), 0, 1); G8_STAGE_A(G8_SA(1, 0), 0, 1); G8_STAGE_B(G8_SB(1, 1), 1, 1);
    G8_WAIT_V(6); G8_BAR;
    for (int t = 0; t < nt - 2; t += 2) {
        G8_LDB(B0, 0, 0); G8_SCHED; G8_LDA(At, 0, 0); G8_STAGE_A(G8_SA(1, 1), 1, t + 1);
        G8_WAIT_L(8); G8_BAR; G8_WAIT_L(0); G8_MMA(0, 0, At, B0); G8_BAR; G8_SCHED;
        G8_LDB(B1, 0, 1); G8_STAGE_B(G8_SB(0, 0), 0, t + 2);
        G8_BAR; G8_WAIT_L(0); G8_MMA(0, 1, At, B1); G8_BAR;
        G8_LDA(At, 0, 1); G8_STAGE_A(G8_SA(0, 0), 0, t + 2);
        G8_BAR; G8_WAIT_L(0); G8_MMA(1, 0, At, B0); G8_BAR; G8_SCHED;
        G8_STAGE_B(G8_SB(0, 1), 1, t + 2);
        G8_WAIT_V(6); G8_BAR; G8_MMA(1, 1, At, B1); G8_BAR;
        G8_LDB(B0, 1, 0); G8_SCHED; G8_LDA(At, 1, 0); G8_STAGE_A(G8_SA(0, 1), 1, t + 2);
        G8_WAIT_L(8); G8_BAR; G8_WAIT_L(0); G8_MMA(0, 0, At, B0); G8_BAR; G8_SCHED;
        G8_LDB(B1, 1, 1); G8_STAGE_B(G8_SB(1, 0), 0, t + 3);
        G8_BAR; G8_WAIT_L(0); G8_MMA(0, 1, At, B1); G8_BAR;
        G8_LDA(At, 1, 1); G8_STAGE_A(G8_SA(1, 0), 0, t + 3);
        G8_BAR; G8_WAIT_L(0); G8_MMA(1, 0, At, B0); G8_BAR; G8_SCHED;
        G8_STAGE_B(G8_SB(1, 1), 1, t + 3);
        G8_WAIT_V(6); G8_BAR; G8_MMA(1, 1, At, B1); G8_BAR;
    }
    { G8_LDB(B0, 0, 0); G8_LDA(At, 0, 0); G8_STAGE_A(G8_SA(1, 1), 1, nt - 1);
      G8_BAR; G8_WAIT_L(0); G8_MMA(0, 0, At, B0); G8_BAR;
      G8_LDB(B1, 0, 1); G8_BAR; G8_WAIT_L(0); G8_MMA(0, 1, At, B1); G8_BAR;
      G8_LDA(At, 0, 1); G8_WAIT_V(4); G8_BAR; G8_WAIT_L(0); G8_MMA(1, 0, At, B0); G8_MMA(1, 1, At, B1); G8_BAR; }
    { G8_LDB(B0, 1, 0); G8_LDA(At, 1, 0); G8_WAIT_V(2); G8_BAR; G8_WAIT_L(0); G8_MMA(0, 0, At, B0); G8_BAR;
      G8_LDB(B1, 1, 1); G8_WAIT_V(0); G8_BAR; G8_WAIT_L(0); G8_MMA(0, 1, At, B1); G8_BAR;
      G8_LDA(At, 1, 1); G8_BAR; G8_WAIT_L(0); G8_MMA(1, 0, At, B0); G8_MMA(1, 1, At, B1); G8_BAR; }
    if (wr == 0) G8_BAR;
    asm volatile(SETTLE_NOPS : "+v"(acc[0][0][0][0]), "+v"(acc[0][0][0][1]), "+v"(acc[0][0][1][0]), "+v"(acc[0][0][1][1]), "+v"(acc[0][0][2][0]), "+v"(acc[0][0][2][1]), "+v"(acc[0][0][3][0]), "+v"(acc[0][0][3][1]),
                 "+v"(acc[0][1][0][0]), "+v"(acc[0][1][0][1]), "+v"(acc[0][1][1][0]), "+v"(acc[0][1][1][1]), "+v"(acc[0][1][2][0]), "+v"(acc[0][1][2][1]), "+v"(acc[0][1][3][0]), "+v"(acc[0][1][3][1]));
    asm volatile("" : "+v"(acc[1][0][0][0]), "+v"(acc[1][0][0][1]), "+v"(acc[1][0][1][0]), "+v"(acc[1][0][1][1]), "+v"(acc[1][0][2][0]), "+v"(acc[1][0][2][1]), "+v"(acc[1][0][3][0]), "+v"(acc[1][0][3][1]),
                 "+v"(acc[1][1][0][0]), "+v"(acc[1][1][0][1]), "+v"(acc[1][1][1][0]), "+v"(acc[1][1][1][1]), "+v"(acc[1][1][2][0]), "+v"(acc[1][1][2][1]), "+v"(acc[1][1][3][0]), "+v"(acc[1][1][3][1]));
    epi(acc, wr * 64 + fr, wc * 32 + 4 * fq);
#undef G8_SA
#undef G8_SB
#undef G8_STAGE_A
#undef G8_STAGE_B
#undef G8_LDA
#undef G8_LDB
#undef G8_MMA
}
DI void my_rc(int i, int& R, int& C) { stage_rc(tidx() * 16 + i * 8192, R, C); }
DI bool unit_of(int L, int nM, int nN, int& pm, int& pn) {
    const int nwg = nM * nN; if (L >= nwg) return false;
    int wgid = L; { const int q = nwg / 8, r = nwg % 8, xcd = wgid % 8, off = wgid / 8; wgid = (xcd < r ? xcd * (q + 1) : r * (q + 1) + (xcd - r) * q) + off; }
    const int nig = 8 * nN, gid = wgid / nig, fm = gid * 8, gsz = (nM - fm) < 8 ? (nM - fm) : 8;
    pm = fm + ((wgid % nig) % gsz); pn = (wgid % nig) / gsz; return true;
}
}

typedef f32x4 Acc[2][2][4][2];
#define ACC_FOR(ai, m, bj, n) _Pragma("unroll") for (int ai = 0; ai < 2; ++ai) _Pragma("unroll") for (int m = 0; m < 4; ++m) _Pragma("unroll") for (int bj = 0; bj < 2; ++bj) _Pragma("unroll") for (int n = 0; n < 2; ++n)

DI bf16x8 ld8(const bf16_t* q) { return *(const bf16x8*)q; }
DI bf16x8 ld8(const LAS bf16_t* q) { return *(const LAS bf16x8*)q; }
template <int KS, class PA, class PB>
DI f32x4 mma_tile(PA arow, PB brow, f32x4 acc) {
#pragma unroll
    for (int ks = 0; ks < KS; ++ks) acc = MFMA16(ld8(arow + ks * 32), ld8(brow + ks * 32), acc);
    settle(acc);
    return acc;
}
#define ZERO4 ((f32x4){0.f, 0.f, 0.f, 0.f})

constexpr long LW_WIN = (long)NPAD * D, LW_WOUT = (long)D * D, LW_GLU = 512L * 512, LW_W1 = 2L * 256 * 2048, LW_W2 = 2L * 64 * 256, LW_WGU = (long)NEXP * 1024 * D, LW_WD = (long)NEXP * D * DEXP;
struct TDesc { const float* src; bf16_t* dst; int src_ld, dst_ld, nvalid, gu  , which, ntl; };
#ifndef TCONV_TAIL
#define TCONV_TAIL 2560
#endif
constexpr int TCONV_EARLY = 320 + 320 + 64, TCONV_FULL = TCONV_EARLY + 256 + 16 + 4096 + 2048, TCONV_TILES = TCONV_FULL + 72;
struct TBase { const float *win, *wout, *glu, *w1, *w2, *gate, *up, *down; bf16_t *WinT, *WoutT, *gluT, *w1T, *w2T, *WguT, *WdT; };
DI void tconv_base(CP p, int l, TBase& b) {
    b.win = p.in[I_W_IN] + (long)l * D * DIN; b.wout = p.in[I_W_OUT] + (long)l * D * D; b.glu = p.in[I_GLU_W] + (long)l * 512 * 512;
    b.w1 = p.in[I_CMP_W1] + (long)l * 2 * 2048 * 256; b.w2 = p.in[I_CMP_W2] + (long)l * 2 * 256 * 64;
    b.gate = p.in[I_W_GATE] + (long)l * NEXP * D * DEXP; b.up = p.in[I_W_UP] + (long)l * NEXP * D * DEXP; b.down = p.in[I_W_DOWN] + (long)l * NEXP * DEXP * D;
    b.WinT = p.WinT + l * LW_WIN; b.WoutT = p.WoutT + l * LW_WOUT; b.gluT = p.gluT + l * LW_GLU; b.w1T = p.w1T + l * LW_W1; b.w2T = p.w2T + l * LW_W2; b.WguT = p.WguT + l * LW_WGU; b.WdT = p.WdT + l * LW_WD;
}
DI void tconv_desc(const TBase& b, int idx, TDesc& d) {
    auto lin = [&](const float* src, int src_ld, bf16_t* dst, int dst_ld, int K, int N, int t) {
        const int nkt = K / 64, kt = t % nkt, ntl = t / nkt;
        d.src = src + (long)kt * 64 * src_ld + ntl * 256; d.src_ld = src_ld; d.nvalid = min(256, N - ntl * 256);
        d.dst = dst + (long)ntl * 256 * dst_ld + kt * 64; d.dst_ld = dst_ld; d.gu = 0; d.which = 0; d.ntl = ntl; };
    int t = idx;
    if (t < 320) { lin(b.win, DIN, b.WinT, D, D, 2560, t); return; } t -= 320;
    if (t < 320) { lin(b.win + 2568, DIN, b.WinT + 2560L * D, D, D, 2560, t); return; } t -= 320;
    if (t < 64) { const int kv = t >> 5; lin(b.w1 + (long)kv * 2048 * 256, 256, b.w1T + (long)kv * 256 * 2048, 2048, 2048, 256, t & 31); return; } t -= 64;
    if (t < 256) { lin(b.wout, D, b.WoutT, D, D, D, t); return; } t -= 256;
    if (t < 16) { lin(b.glu, 512, b.gluT, 512, 512, 512, t); return; } t -= 16;
    if (t < 4096) { const int e = t >> 7, which = (t >> 6) & 1, r = t & 63, kt = r & 31, ntl = r >> 5;
        d.src = (which ? b.up : b.gate) + (long)e * D * DEXP + (long)kt * 64 * DEXP + ntl * 256; d.src_ld = DEXP; d.nvalid = 256;
        d.dst = b.WguT + (long)e * 1024 * D + kt * 64; d.dst_ld = D; d.gu = 1; d.which = which; d.ntl = ntl; return; } t -= 4096;
    if (t < 2048) { const int e = t >> 6, r = t & 63; lin(b.down + (long)e * DEXP * D, D, b.WdT + (long)e * D * DEXP, DEXP, DEXP, D, r); return; } t -= 2048;
    if (t < 32) { lin(b.win + 2560, DIN, b.WinT + 5120L * D, D, D, 8, t); return; } t -= 32;
    if (t < 32) { lin(b.win + 5128, DIN, b.WinT + 5128L * D, D, D, 48, t); return; } t -= 32;
    { const int kv = t >> 2; lin(b.w2 + (long)kv * 256 * 64, 64, b.w2T + (long)kv * 64 * 256, 256, 256, 64, t & 3); }
}
DI void tconv_load(const TDesc& d, f32x4 (&v)[8]) {
    const int tid = tidx(), n4 = (tid & 63) * 4, kb = tid >> 6;
#pragma unroll
    for (int i = 0; i < 8; ++i) { const int kk = kb + 8 * i; const float* s = d.src + (long)kk * d.src_ld + n4;
        if (n4 + 3 < d.nvalid) v[i] = *(const f32x4*)s;
        else { v[i] = (f32x4){0.f, 0.f, 0.f, 0.f};
#pragma unroll
            for (int e = 0; e < 4; ++e) if (n4 + e < d.nvalid) v[i][e] = s[e]; } }
}
DI void tconv_store(LAS float* scr, const TDesc& d, f32x4 (&v)[8]) {
    const int tid = tidx(), n4 = (tid & 63) * 4, kb = tid >> 6;
    constexpr int LS = 260;
#pragma unroll
    for (int i = 0; i < 8; ++i) { const int kk = kb + 8 * i; *(LAS f32x4*)(scr + kk * LS + 4 * ((n4 >> 2) ^ ((kk >> 3) & 7))) = v[i]; }
    __syncthreads();
#pragma unroll
    for (int i = 0; i < 4; ++i) { const int q = tid + 512 * i, nn = q >> 3, c = q & 7;
        if (nn < d.nvalid) { u32x4 o; const LAS float* s = scr + (8 * c) * LS + 4 * ((nn >> 2) ^ c) + (nn & 3);
            o.x = pk2h(s[0], s[LS]); o.y = pk2h(s[2 * LS], s[3 * LS]); o.z = pk2h(s[4 * LS], s[5 * LS]); o.w = pk2h(s[6 * LS], s[7 * LS]);
            const int n = d.ntl * 256 + nn;
            bf16_t* row = d.gu ? d.dst + (long)((n >> 7) * 256 + d.which * 128 + (n & 127)) * d.dst_ld : d.dst + (long)nn * d.dst_ld;
            *(u32x4*)(row + 8 * c) = o; } }
    __syncthreads();
}
DI void tconv_issue(const TBase& b, int hidx, LAS char* buf) {
    TDesc d; tconv_desc(b, hidx >> 1, d);
    const int lane = my_lane(), w = __builtin_amdgcn_readfirstlane(tidx() >> 6);
    const float* s = d.src + (hidx & 1) * 128 + 4 * ((lane & 31) ^ w);
#pragma unroll
    for (int i = 0; i < 4; ++i) { const int r = 2 * (w * 4 + i) + (lane >> 5);
        __builtin_amdgcn_global_load_lds((const unsigned*)(s + (long)r * d.src_ld), (LAS unsigned*)(buf + (w * 4 + i) * 1024), 16, 0, 2); }
}
DI void tconv_emit(const TBase& b, int hidx, LAS char* buf) {
    TDesc d; tconv_desc(b, hidx >> 1, d);
    const int tid = tidx(), half = hidx & 1;
    const LAS float* sb = (const LAS float*)buf;
#pragma unroll
    for (int it = 0; it < 2; ++it) { const int q = tid + 512 * it, nn = q >> 3, c = q & 7;
        const LAS float* s = sb + (8 * c) * 128 + 4 * ((nn >> 2) ^ c) + (nn & 3);
        u32x4 o; o.x = pk2h(s[0], s[128]); o.y = pk2h(s[256], s[384]); o.z = pk2h(s[512], s[640]); o.w = pk2h(s[768], s[896]);
        const int nl = half * 128 + nn, n = d.ntl * 256 + nl;
        bf16_t* row = d.gu ? d.dst + (long)((n >> 7) * 256 + d.which * 128 + (n & 127)) * d.dst_ld : d.dst + (long)nl * d.dst_ld;
        *(u32x4*)(row + 8 * c) = o; }
}
DI void tconv_range(CP p, int l, int lo, int hi, int bi, int nb, LAS char* lds) {
    const int h0 = 2 * lo + bi, hN = 2 * hi;
    const int nk = h0 < hN ? (hN - 1 - h0) / nb + 1 : 0;
    if (nk <= 0) return;
    TBase b; tconv_base(p, l, b);
    __syncthreads();
#pragma unroll
    for (int j = 0; j < 4; ++j) tconv_issue(b, h0 + min(j, nk - 1) * nb, lds + j * 32768);
    for (int k = 0; k < nk; ++k) {
        if (k < 3) asm volatile("s_waitcnt vmcnt(12)" ::: "memory"); else asm volatile("s_waitcnt vmcnt(18)" ::: "memory");
        __builtin_amdgcn_s_barrier();
        tconv_emit(b, h0 + k * nb, lds + (k & 3) * 32768);
        asm volatile("s_waitcnt lgkmcnt(0)" ::: "memory");
        __builtin_amdgcn_s_barrier();
        tconv_issue(b, h0 + min(k + 4, nk - 1) * nb, lds + (k & 3) * 32768);
    }
    asm volatile("s_waitcnt vmcnt(0)" ::: "memory");
    __syncthreads();
}
DI void tconv_narrow(CP p, int l, int bi, int nb, LAS char* lds) {
    LAS float* scr = (LAS float*)lds;
    TBase b; tconv_base(p, l, b);
    for (int idx = TCONV_FULL + bi; idx < TCONV_TILES; idx += nb) { TDesc d; f32x4 v[8]; tconv_desc(b, idx, d); tconv_load(d, v); tconv_store(scr, d, v); }
    { unsigned* z = (unsigned*)(p.WinT + l * LW_WIN + (long)DIN * D); for (long i = (long)bi * 512 + tidx(); i < (long)(NPAD - DIN) * D / 2; i += (long)nb * 512) z[i] = 0u; }
}
DI void p0_tables(CP p, int l, LAS char* lds) {
    const float* lnf = p.in[I_LN_FFN] + l * D;
    const long gtid = (long)bidx() * 512 + tidx(), nth = (long)gdim() * 512;
    for (long i = gtid; i < 48L * D; i += nth) { const int n = (int)(i / D), k = (int)(i % D); float v = 0.f;
        if (n < 4) v = p.in[I_GROUP_W][((long)l * D + k) * 4 + n]; else if (n < 36) v = p.in[I_EXPERT_W][((long)l * D + k) * 32 + (n - 4)];
        p.Wr[i] = v * lnf[k]; }
    for (int blk = bidx(); blk < 64; blk += gdim()) {
        LAS float* cc = (LAS float*)lds;
        __syncthreads();
        if (tidx() < 32) { const int i = blk * 32 + tidx(), g = i >> 6, pp = i & 63;
            const float a = p.in[I_LAM_RE][(l * 32 + g) * 64 + pp], w = p.in[I_LAM_IM][(l * 32 + g) * 64 + pp], dt = __expf(p.in[I_S5LOGDT][l * 32 + g]);
            const float ea = expf(a * dt); float sn, cs; sincosf(w * dt, &sn, &cs);
            const float lr = ea * cs, li = ea * sn;
            const float sh = sinf(0.5f * w * dt); const float lr1 = expm1f(a * dt) * cs - 2.f * sh * sh;
            const float den = 1.f / (a * a + w * w);
            cc[2 * tidx()] = (lr1 * a + li * w) * den; cc[2 * tidx() + 1] = (li * a - lr1 * w) * den;
            p.s5lam[g * 64 + pp] = (f32x2){lr, li};
            { const float e64 = expf(a * dt * 64.f); float s6, c6; sincosf(w * dt * 64.f, &s6, &c6); p.s5lam[2048 + g * 64 + pp] = (f32x2){e64 * c6, e64 * s6}; } }
        __syncthreads();
        { const int pr = tidx() >> 4, hh = tidx() & 15, i = blk * 32 + pr, g = i >> 6, pp = i & 63;
            const float cr = cc[2 * pr], ci = cc[2 * pr + 1];
            const float br = p.in[I_B_RE][((long)(l * 32 + g) * 64 + pp) * 16 + hh], bi = p.in[I_B_IM][((long)(l * 32 + g) * 64 + pp) * 16 + hh];
            p.s5Bt[((long)g * 128 + pp) * 32 + hh] = f2bf(cr * br - ci * bi); p.s5Bt[((long)g * 128 + pp) * 32 + 16 + hh] = 0;
            p.s5Bt[((long)g * 128 + 64 + pp) * 32 + hh] = f2bf(cr * bi + ci * br); p.s5Bt[((long)g * 128 + 64 + pp) * 32 + 16 + hh] = 0;
            p.s5Ct[((long)g * 16 + hh) * 128 + pp] = f2bf(p.in[I_C_RE][((long)(l * 32 + g) * 16 + hh) * 64 + pp]);
            p.s5Ct[((long)g * 16 + hh) * 128 + 64 + pp] = f2bf(-p.in[I_C_IM][((long)(l * 32 + g) * 16 + hh) * 64 + pp]); }
    }
    __syncthreads();
    {
        const int gw = bidx() * 8 + __builtin_amdgcn_readfirstlane(tidx() >> 6), nw = gdim() * 8, lane = tidx() & 63;
        for (int o = gw; o < 512; o += nw) { const int kv = o >> 8, n = o & 255; float s = 0.f;
            const float* pe = p.in[I_CMP_PE] + (long)(l * 2 + kv) * 2048; const float* w1 = p.in[I_CMP_W1] + (long)(l * 2 + kv) * 2048 * 256 + n;
#pragma unroll
            for (int kk = 0; kk < 32; ++kk) { const int k = lane + 64 * kk; s += pe[k] * w1[(long)k * 256]; }
            s = wave_sum(s); if (lane == 0) p.bias1[o] = s; }
    }
}
DI void p0_once(CP p) {
    const long gtid = (long)bidx() * 512 + tidx(), nth = (long)gdim() * 512;
    for (long i = gtid; i < 4096L * 32; i += nth) { const int pos = (int)(i >> 5), k = (int)(i & 31);
        const float invf = exp2f(-(float)k * (13.287712379549449f / 32.f)); const float ang = (float)pos * invf; float s, c; sincosf(ang, &s, &c); p.rope[i] = (f32x2){c, s}; }
    for (long i = gtid; i < 256; i += nth) p.cnt[i] = 0;
}

DI void p1_rows(CP p, int mode, int lprev, int lnext) {
    const int lane = tidx() & 63, gw = bidx() * 8 + __builtin_amdgcn_readfirstlane(tidx() >> 6), nw = gdim() * 8;
    int ts = 0;
    if (mode > 0) { int c = lane < 32 ? p.cnt[lprev * 32 + lane] : 0; int ntl = (c + 255) >> 8; int inc = ntl;
#pragma unroll
        for (int o = 1; o < 32; o <<= 1) { int v = shfl_up_i(inc, o, lane); if ((lane & 31) >= o) inc += v; }
        ts = inc - ntl; }
    for (int t = gw; t < T; t += nw) {
        f32x4 v[8]; float ss = 0.f;
        if (mode == 0) {
            const f32x4* xr = (const f32x4*)(p.in[I_X] + (long)t * D);
#pragma unroll
            for (int j = 0; j < 8; ++j) v[j] = xr[j * 64 + lane];
        } else {
            const int* ti = p.tokinfo + (long)t * 4; const int e0 = ti[0], p0 = ti[1], e1 = ti[2], p1 = ti[3];
            const long s0 = (long)shfl_idx_i(ts, e0) * 256 + p0, s1 = (long)shfl_idx_i(ts, e1) * 256 + p1;
            const f32x4* hr = (const f32x4*)(p.h + (long)t * D);
            const u32x2* y0 = (const u32x2*)(p.ybuf + s0 * D); const u32x2* y1 = (const u32x2*)(p.ybuf + s1 * D);
#pragma unroll
            for (int j = 0; j < 8; ++j) { f32x4 a = hr[j * 64 + lane]; const u32x2 b0 = y0[j * 64 + lane], b1 = y1[j * 64 + lane];
                a[0] += __uint_as_float(b0.x << 16) + __uint_as_float(b1.x << 16); a[1] += __uint_as_float(b0.x & 0xffff0000u) + __uint_as_float(b1.x & 0xffff0000u);
                a[2] += __uint_as_float(b0.y << 16) + __uint_as_float(b1.y << 16); a[3] += __uint_as_float(b0.y & 0xffff0000u) + __uint_as_float(b1.y & 0xffff0000u);
                v[j] = a; }
        }
#ifdef TPROBE
        if (mode == 2) { const float sc = 1.f + (TPROBE_SEL == 5 ? 2e-3f * (float)p.err[3445] : 2e-5f * (float)p.err[3440]);
#pragma unroll
            for (int j = 0; j < 8; ++j) v[j] *= sc; }
#endif
        if (mode >= 1) { f32x4* o = (f32x4*)(p.out + (long)t * D);
#pragma unroll
            for (int j = 0; j < 8; ++j) o[j * 64 + lane] = v[j]; }
        if (mode <= 1) {
#pragma unroll
            for (int j = 0; j < 8; ++j) ss += v[j][0] * v[j][0] + v[j][1] * v[j][1] + v[j][2] * v[j][2] + v[j][3] * v[j][3];
            ss = wave_sum(ss);
            if (lane == 0) p.rstd_mix[t] = rsqrtf(ss * (1.f / D) + EPS);
            u32x2* xo = (u32x2*)(p.xb + (long)t * D); const f32x4* gn = (const f32x4*)(p.in[I_LN_MIX] + lnext * D);
#pragma unroll
            for (int j = 0; j < 8; ++j) { const f32x4 g4 = gn[j * 64 + lane]; u32x2 w; w.x = pk2h(v[j][0] * g4[0], v[j][1] * g4[1]); w.y = pk2h(v[j][2] * g4[2], v[j][3] * g4[3]); xo[j * 64 + lane] = w; }
        }
    }
}

DI void inproj_narrow(CP p, int l, LAS char* lds) {
    const int tid = tidx(), lane = tid & 63, w = __builtin_amdgcn_readfirstlane(tid >> 6), fr = lane & 15, fq = lane >> 4;
    constexpr int XS = 2056;
    LAS bf16_t* X = (LAS bf16_t*)lds;
    LAS float* red = (LAS float*)lds;
    bf16x8 bw[8][4];
    { const bf16_t* wb = p.WinT + l * LW_WIN + (long)(NPROJ + fr) * D + w * 256 + 8 * fq;
#pragma unroll
      for (int ks = 0; ks < 8; ++ks)
#pragma unroll
          for (int nt = 0; nt < 4; ++nt) bw[ks][nt] = ld8(wb + (long)nt * 16 * D + ks * 32); }
    const LAS bf16_t* xa = X + fr * XS + w * 256 + 8 * fq;
    for (int item = bidx(); item < T / 32; item += gdim()) {
        const long tok0 = (long)item * 32;
        __syncthreads();
#pragma unroll
        for (int i = 0; i < 16; ++i) { const int e = tid + i * 512, r = e >> 8, c = e & 255; *(LAS u32x4*)(X + r * XS + c * 8) = *(const u32x4*)(p.xb + (tok0 + r) * D + c * 8); }
        __syncthreads();
        f32x4 acc[2][4];
#pragma unroll
        for (int mt = 0; mt < 2; ++mt)
#pragma unroll
            for (int nt = 0; nt < 4; ++nt) acc[mt][nt] = ZERO4;
#pragma unroll
        for (int ks = 0; ks < 8; ++ks) {
            bf16x8 a[2];
#pragma unroll
            for (int mt = 0; mt < 2; ++mt) a[mt] = ld8(xa + mt * 16 * XS + ks * 32);
#pragma unroll
            for (int mt = 0; mt < 2; ++mt)
#pragma unroll
                for (int nt = 0; nt < 4; ++nt) acc[mt][nt] = MFMA16(bw[ks][nt], a[mt], acc[mt][nt]);
        }
        settle(acc[0][0], acc[0][1], acc[0][2], acc[0][3], acc[1][0], acc[1][1], acc[1][2], acc[1][3]);
        __syncthreads();
#pragma unroll
        for (int mt = 0; mt < 2; ++mt)
#pragma unroll
            for (int nt = 0; nt < 4; ++nt) *(LAS f32x4*)(red + (w * 32 + mt * 16 + fr) * 64 + nt * 16 + 4 * fq) = acc[mt][nt];
        __syncthreads();
        { const int r = tid >> 4, c4 = (tid & 15) * 4; f32x4 s = ZERO4;
#pragma unroll
          for (int ww = 0; ww < 8; ++ww) s += *(const LAS f32x4*)(red + (ww * 32 + r) * 64 + c4);
          if (c4 < 56) *(f32x4*)(p.small + (tok0 + r) * NSMALL + c4) = s * p.rstd_mix[tok0 + r]; }
    }
    __syncthreads();
}
DI void p2_inproj(CP p, int l, LAS char* lds) {
    unsigned aoff[2][2], boff[2];
#pragma unroll
    for (int i = 0; i < 2; ++i) { int R, C; g8::my_rc(i, R, C); boff[i] = (unsigned)(R * D + C) * 2u; aoff[0][i] = boff[i]; aoff[1][i] = (unsigned)((128 + R) * D + C) * 2u; }
    const bool narrow_first = ((bidx() >> 3) & 1) != 0;
    if (narrow_first) inproj_narrow(p, l, lds);
    for (int u = bidx();; u += gdim()) {
        int pm, pn; if (!g8::unit_of(u, T / 256, NPROJ / 256, pm, pn)) break;
        const float* rs = p.rstd_mix + pm * 256; bf16_t* proj = p.proj;
        g8::gemm_tile(lds, (const char*)(p.xb + (long)pm * 256 * D), aoff, 128, (const char*)(p.WinT + l * LW_WIN + (long)pn * 256 * D), boff, 128L * D * 2, D / 64, [&](const Acc& acc, int rb, int cb) {
            ACC_FOR(ai, m, bj, n) { const int r = ai * 128 + m * 16 + rb, c = bj * 128 + n * 16 + cb; const long row = pm * 256 + r;
                f32x4 v = acc[ai][bj][m][n] * rs[r];
                u32x2 w; w.x = pk2h(v[0], v[1]); w.y = pk2h(v[2], v[3]); *(u32x2*)(proj + row * NPROJ + pn * 256 + c) = w; }
        });
    }
    if (!narrow_first) inproj_narrow(p, l, lds);
    { const int G = gdim(), rem = ((T / 256) * (NPROJ / 256)) % G;
      if (rem != 0 && bidx() >= rem) tconv_range(p, l, TCONV_EARLY, TCONV_EARLY + TCONV_TAIL, bidx() - rem, G - rem, lds); }
}

DI void s5_item(CP p, int l, int item, int pass, LAS char* wl) {
    const int lane = tidx() & 63, fr = lane & 15, fq = lane >> 4;
    item = __builtin_amdgcn_readfirstlane(item);
    const int g = item & 31, c = (item >> 5) & 63, b = item >> 11;
    LAS float* BU = (LAS float*)wl;
    LAS bf16_t* X = (LAS bf16_t*)(wl + 8192);
    const f32x2 lam = p.s5lam[g * 64 + lane];
    float sre = 0.f, sim = 0.f;
    if (pass == 2) { const f32x2 l64 = p.s5lam[2048 + g * 64 + lane]; const f32x2* E = p.s5E + ((long)(b * 64) * 32 + g) * 64 + lane;
        for (int c0 = 0; c0 < c; c0 += 8) { f32x2 e[8];
#pragma unroll
            for (int k = 0; k < 8; ++k) e[k] = E[(long)min(c0 + k, c - 1) * 32 * 64];
#pragma unroll
            for (int k = 0; k < 8; ++k) if (c0 + k < c) { const float nr = l64.x * sre - l64.y * sim + e[k].x, ni = l64.x * sim + l64.y * sre + e[k].y; sre = nr; sim = ni; } } }
    bf16x8 bfr[8], cfr[4];
#pragma unroll
    for (int nb = 0; nb < 8; ++nb) bfr[nb] = *(const bf16x8*)(p.s5Bt + ((long)g * 128 + nb * 16 + fr) * 32 + 8 * fq);
    if (pass == 2) {
#pragma unroll
        for (int ks = 0; ks < 4; ++ks) cfr[ks] = *(const bf16x8*)(p.s5Ct + ((long)g * 16 + fr) * 128 + ks * 32 + 8 * fq);
    }
    const long tok0 = (long)b * SEQ + c * 64;
    const float dsk = p.in[I_S5D][l * 512 + g * 16 + fr];
    bf16x8 afr_nx = *(const bf16x8*)(p.proj + (tok0 + fr) * NPROJ + C_U + g * 16 + 8 * (fq & 1));
    for (int sub = 0; sub < 4; ++sub) {
        const long tb = tok0 + sub * 16;
        const bf16x8 afr = afr_nx;
        afr_nx = *(const bf16x8*)(p.proj + (tok0 + min(sub + 1, 3) * 16 + fr) * NPROJ + C_U + g * 16 + 8 * (fq & 1));
        bf16_t uu[4];
        if (pass == 2) {
#pragma unroll
            for (int j = 0; j < 4; ++j) uu[j] = p.proj[(tb + 4 * fq + j) * NPROJ + C_U + g * 16 + fr]; }
        f32x4 accs[8];
#pragma unroll
        for (int nb = 0; nb < 8; ++nb) { accs[nb] = (f32x4){0.f, 0.f, 0.f, 0.f}; accs[nb] = MFMA16(afr, bfr[nb], accs[nb]); }
        settle(accs[0], accs[1], accs[2], accs[3], accs[4], accs[5], accs[6], accs[7]);
#pragma unroll
        for (int nb = 0; nb < 8; ++nb)
#pragma unroll
            for (int j = 0; j < 4; ++j) BU[(4 * fq + j) * 128 + nb * 16 + fr] = accs[nb][j];
        lds_wait();
#pragma unroll
        for (int tt = 0; tt < 16; ++tt) { const float br = BU[tt * 128 + lane], bi = BU[tt * 128 + 64 + lane];
            const float nr = lam.x * sre - lam.y * sim + br, ni = lam.x * sim + lam.y * sre + bi; sre = nr; sim = ni;
            if (pass == 2) { X[tt * 136 + lane] = f2bf(sre); X[tt * 136 + 64 + lane] = f2bf(sim); } }
        if (pass == 2) {
            lds_wait();
            f32x4 acc = {0.f, 0.f, 0.f, 0.f};
            bf16x8 xa[4];
#pragma unroll
            for (int ks = 0; ks < 4; ++ks) xa[ks] = *(const LAS bf16x8*)(X + fr * 136 + ks * 32 + 8 * fq);
            lds_wait();
#pragma unroll
            for (int ks = 0; ks < 4; ++ks) acc = MFMA16(xa[ks], cfr[ks], acc);
            settle(acc);
            asm volatile("" :: "v"(xa[0]), "v"(xa[1]), "v"(xa[2]), "v"(xa[3]));
#pragma unroll
            for (int j = 0; j < 4; ++j) { const long tk = tb + 4 * fq + j; const float u = bf2f(uu[j]);
                p.s5y[tk * 512 + g * 16 + fr] = f2bf(gelu_tanh(acc[j] + dsk * u)); }
        }
        lds_wait();
    }
    if (pass == 1) { p.s5E[((long)(b * 64 + c) * 32 + g) * 64 + lane] = (f32x2){sre, sim};
#ifdef DBG_E2
        ((f32x2*)p.gRT)[((long)(b * 64 + c) * 32 + g) * 64 + lane] = (f32x2){sre, sim};
#endif
    }
}
constexpr int GP_QG = 0, GP_KN = 17408, GP_KB = 34816, GP_QN = 52224, GP_VBT = 69632, GP_KBGT = 88064, GP_KGT = 106496, GP_AM = 124928, GP_QK = 142336, GP_GT = 151552;
constexpr int GP_TM = 17408, GP_UT = 26624, GP_WT = 45056;
constexpr int SK = 136, ST = 72, SA = 68;

template <int SWA> DI f32x4 mma_tile2_sw(const LAS bf16_t* lin, const LAS bf16_t* sw, int fq, int x) {
    f32x4 acc = ZERO4;
#pragma unroll
    for (int ks = 0; ks < 2; ++ks) { const bf16x8 a = ld8(lin + ks * 32), s = ld8(sw + 8 * ((4 * ks + fq) ^ x)); acc = SWA ? MFMA16(s, a, acc) : MFMA16(a, s, acc); }
    settle(acc);
    return acc;
}
DI void gdn_prep_item(CP p, int l, int item, LAS char* lds) {
    const int tid = tidx(), lane = tid & 63, w = __builtin_amdgcn_readfirstlane(tid >> 6), fr = lane & 15, fq = lane >> 4;
    const int n = item & 63, h = (item >> 6) & 3, b = item >> 8;
    const long tok0 = (long)b * SEQ + n * 64;
    LAS bf16_t* Qg = (LAS bf16_t*)(lds + GP_QG); LAS bf16_t* Kn = (LAS bf16_t*)(lds + GP_KN); LAS bf16_t* Kb = (LAS bf16_t*)(lds + GP_KB); LAS bf16_t* Qn = (LAS bf16_t*)(lds + GP_QN);
    LAS bf16_t* VbT = (LAS bf16_t*)(lds + GP_VBT); LAS bf16_t* KbgT = (LAS bf16_t*)(lds + GP_KBGT); LAS bf16_t* KgT = (LAS bf16_t*)(lds + GP_KGT);
    LAS float* Am = (LAS float*)(lds + GP_AM); LAS bf16_t* QKm = (LAS bf16_t*)(lds + GP_QK); LAS float* gts = (LAS float*)(lds + GP_GT);
    LAS bf16_t* Tm = (LAS bf16_t*)(lds + GP_TM); LAS bf16_t* UT = (LAS bf16_t*)(lds + GP_UT); LAS bf16_t* WT = (LAS bf16_t*)(lds + GP_WT);
    if (tid < 64) {
        const float a = p.small[(tok0 + tid) * NSMALL + h], bb = p.small[(tok0 + tid) * NSMALL + 4 + h];
        const float g = -expf(p.in[I_A_LOG][l * 4 + h]) * softplusf_(a + p.in[I_DT_BIAS][l * 4 + h]);
        float inc = g;
#pragma unroll
        for (int o = 1; o < 64; o <<= 1) { const float v = shfl_up_f(inc, o, lane); if (lane >= o) inc += v; }
        gts[tid] = inc; gts[64 + tid] = sigmoidf_(bb);
    }
    LAS float* cw = Am;
    if (tid < 384) {
#pragma unroll
        for (int j = 0; j < 4; ++j) cw[j * 384 + tid] = p.in[I_CONV_W][(long)(l * 4 + j) * 1536 + (tid >> 7) * 512 + h * 128 + (tid & 127)]; }
    __syncthreads();
    {
        const int i = tid >> 3, sub = tid & 7;
        const float gc = gts[i], beta = gts[64 + i], glast = gts[63];
        const float eg = __expf(gc), egl = __expf(glast - gc);
        const int spos = n * 64 + i;
#pragma unroll
        for (int which = 0; which < 3; ++which) {
            const int cbase = which * 512 + h * 128 + sub * 16;
            float o[16];
#pragma unroll
            for (int cc = 0; cc < 16; ++cc) o[cc] = 0.f;
#pragma unroll
            for (int j = 0; j < 4; ++j) {
                if (spos - 3 + j >= 0) {
                    const bf16_t* xr = p.proj + (tok0 + i - 3 + j) * NPROJ + C_QKV + cbase;
                    const bf16x8 x0 = ld8(xr), x1 = ld8(xr + 8);
                    const LAS float* wr_ = cw + j * 384 + which * 128 + sub * 16;
#pragma unroll
                    for (int cc = 0; cc < 8; ++cc) { o[cc] += wr_[cc] * bf2f((bf16_t)x0[cc]); o[8 + cc] += wr_[8 + cc] * bf2f((bf16_t)x1[cc]); }
                }
            }
            float ss = 0.f;
#pragma unroll
            for (int cc = 0; cc < 16; ++cc) { o[cc] = siluf_(o[cc]); ss += o[cc] * o[cc]; }
            ss += shflx<1>(ss); ss += shflx<2>(ss); ss += shflx<4>(ss);
            if (which == 0) {
                const float sc = rsqrtf(ss + 1e-6f) * 0.08838834764831845f;
                u32x4 a0, a1, b0, b1;
#pragma unroll
                for (int cc = 0; cc < 4; ++cc) { a0[cc] = pk2(o[2 * cc] * sc, o[2 * cc + 1] * sc); a1[cc] = pk2(o[8 + 2 * cc] * sc, o[9 + 2 * cc] * sc);
                    b0[cc] = pk2(o[2 * cc] * sc * eg, o[2 * cc + 1] * sc * eg); b1[cc] = pk2(o[8 + 2 * cc] * sc * eg, o[9 + 2 * cc] * sc * eg); }
                *(LAS u32x4*)(Qn + i * SK + sub * 16) = a0; *(LAS u32x4*)(Qn + i * SK + sub * 16 + 8) = a1;
                *(LAS u32x4*)(Qg + i * SK + sub * 16) = b0; *(LAS u32x4*)(Qg + i * SK + sub * 16 + 8) = b1;
            } else if (which == 1) {
                const float sc = rsqrtf(ss + 1e-6f);
                u32x4 a0, a1, b0, b1;
#pragma unroll
                for (int cc = 0; cc < 4; ++cc) { a0[cc] = pk2(o[2 * cc] * sc, o[2 * cc + 1] * sc); a1[cc] = pk2(o[8 + 2 * cc] * sc, o[9 + 2 * cc] * sc);
                    b0[cc] = pk2(o[2 * cc] * sc * beta, o[2 * cc + 1] * sc * beta); b1[cc] = pk2(o[8 + 2 * cc] * sc * beta, o[9 + 2 * cc] * sc * beta); }
                *(LAS u32x4*)(Kn + i * SK + sub * 16) = a0; *(LAS u32x4*)(Kn + i * SK + sub * 16 + 8) = a1;
                *(LAS u32x4*)(Kb + i * SK + sub * 16) = b0; *(LAS u32x4*)(Kb + i * SK + sub * 16 + 8) = b1;
#pragma unroll
                for (int cc = 0; cc < 16; ++cc) { const float kn = o[cc] * sc; KbgT[(sub * 16 + cc) * ST + (i ^ (8 * sub))] = f2bf(kn * beta * eg); KgT[(sub * 16 + cc) * ST + (i ^ (8 * sub))] = f2bf(kn * egl); }
            } else {
#pragma unroll
                for (int cc = 0; cc < 16; ++cc) VbT[(sub * 16 + cc) * ST + (i ^ (8 * sub))] = f2bf(o[cc] * beta);
            }
        }
    }
    __syncthreads();
    for (int tl = w; tl < 16; tl += 8) {
        const int m0 = (tl >> 2) * 16, n0 = (tl & 3) * 16;
        const f32x4 a1 = mma_tile<4>(Kb + (m0 + fr) * SK + 8 * fq, Kn + (n0 + fr) * SK + 8 * fq, ZERO4);
        const f32x4 a2 = mma_tile<4>(Qn + (m0 + fr) * SK + 8 * fq, Kn + (n0 + fr) * SK + 8 * fq, ZERO4);
        const int jj = n0 + fr; const float gj = gts[jj];
#pragma unroll
        for (int j = 0; j < 4; ++j) { const int i = m0 + 4 * fq + j; const float dec = __expf(fminf(gts[i] - gj, 0.f));
            Am[i * SA + jj] = (jj < i) ? a1[j] * dec : 0.f;
            QKm[i * ST + jj] = f2bf((jj <= i) ? a2[j] * dec : 0.f); }
    }
    __syncthreads();
    if (w < 4) {
        const int q = lane & 3, c = 16 * w + (lane >> 2);
        float tq[16];
#pragma unroll
        for (int k = 0; k < 16; ++k) tq[k] = 0.f;
        const LAS float* Aq = Am + q;
#pragma unroll
        for (int i = 0; i < 64; ++i) {
            float acc = (q == 0 && i == c) ? 1.f : 0.f;
#pragma unroll
            for (int jj = 0; 4 * jj < i; ++jj) acc -= Aq[i * SA + 4 * jj] * tq[jj];
            acc += __builtin_bit_cast(float, __builtin_amdgcn_update_dpp(0, __builtin_bit_cast(int, acc), 0xB1, 0xF, 0xF, false));
            acc += __builtin_bit_cast(float, __builtin_amdgcn_update_dpp(0, __builtin_bit_cast(int, acc), 0x4E, 0xF, 0xF, false));
            tq[i >> 2] = (q == (i & 3)) ? acc : tq[i >> 2];
            if (q == 0) Tm[i * ST + c] = f2bf(acc);
        }
    }
    __syncthreads();
    for (int tl = w; tl < 32; tl += 8) {
        const int m0 = (tl >> 3) * 16, n0 = (tl & 7) * 16;
        const f32x4 u = mma_tile2_sw<0>(Tm + (m0 + fr) * ST + 8 * fq, VbT + (n0 + fr) * ST, fq, n0 >> 4);
        const f32x4 ww = mma_tile2_sw<0>(Tm + (m0 + fr) * ST + 8 * fq, KbgT + (n0 + fr) * ST, fq, n0 >> 4);
        u32x2 pu, pw; pu.x = pk2(u[0], u[1]); pu.y = pk2(u[2], u[3]); pw.x = pk2(ww[0], ww[1]); pw.y = pk2(ww[2], ww[3]);
        *(LAS u32x2*)(UT + (n0 + fr) * ST + m0 + 4 * fq) = pu; *(LAS u32x2*)(WT + (n0 + fr) * ST + m0 + 4 * fq) = pw;
    }
    __syncthreads();
    const long ib = item;
    for (int tl = w; tl < 64; tl += 8) {
        const int mt = tl >> 3, nt = tl & 7, m0 = mt * 16, n0 = nt * 16;
        const f32x4 pv = mma_tile2_sw<0>(WT + (m0 + fr) * ST + 8 * fq, KgT + (n0 + fr) * ST, fq, n0 >> 4);
        u32x2 pp; pp.x = pk2(-pv[0], -pv[1]); pp.y = pk2(-pv[2], -pv[3]);
        *(u32x2*)(p.gP + ib * 16384 + (n0 + fr) * 128 + (mt >> 1) * 32 + 8 * fq + (mt & 1) * 4) = pp;
        const f32x4 rv = mma_tile2_sw<1>(UT + (n0 + fr) * ST + 8 * fq, KgT + (m0 + fr) * ST, fq, m0 >> 4);
        *(f32x4*)(p.gRT + ib * 16384 + (n0 + fr) * 128 + m0 + 4 * fq) = rv;
    }
    for (int tl = w; tl < 32; tl += 8) {
        const int mt = tl >> 2, nt = tl & 3, m0 = mt * 16, n0 = nt * 16;
        const f32x4 qw = mma_tile<2>(WT + (m0 + fr) * ST + 8 * fq, QKm + (n0 + fr) * ST + 8 * fq, ZERO4);
        const f32x4 ou = mma_tile<2>(UT + (m0 + fr) * ST + 8 * fq, QKm + (n0 + fr) * ST + 8 * fq, ZERO4);
        const int i = n0 + fr, f = m0 + 4 * fq;
        const u32x2 qg = *(const LAS u32x2*)(Qg + i * SK + f);
        u32x2 qo; qo.x = pk2(__uint_as_float(qg.x << 16) - qw[0], __uint_as_float(qg.x & 0xffff0000u) - qw[1]);
        qo.y = pk2(__uint_as_float(qg.y << 16) - qw[2], __uint_as_float(qg.y & 0xffff0000u) - qw[3]);
        *(u32x2*)(p.gQp + ib * 8192 + i * 128 + f) = qo;
        *(f32x4*)(p.gOU + ib * 8192 + i * 128 + f) = ou;
    }
    if (tid == 0) p.gA[ib] = __expf(gts[63]);
    __syncthreads();
}

DI void gdn_chain(CP p, int ch, LAS char* lds) {
    const int tid = tidx(), lane = tid & 63, w = __builtin_amdgcn_readfirstlane(tid >> 6), fr = lane & 15, fq = lane >> 4;
    constexpr int PST = 136, PBUF = 128 * PST * 2;
    f32x4 acc[8];
#pragma unroll
    for (int mb = 0; mb < 8; ++mb) acc[mb] = ZERO4;
    u32x4 pp[4]; f32x4 rr[8]; float an;
    auto load_step = [&](int n) {
        const long ib = (long)ch * 64 + n;
#pragma unroll
        for (int i = 0; i < 4; ++i) { const int q = tid + 512 * i; pp[i] = *(const u32x4*)(p.gP + ib * 16384 + (q >> 4) * 128 + (q & 15) * 8); }
#pragma unroll
        for (int mb = 0; mb < 8; ++mb) rr[mb] = *(const f32x4*)(p.gRT + ib * 16384 + (w * 16 + fr) * 128 + mb * 16 + 4 * fq);
        an = p.gA[ib];
    };
    auto write_p = [&](int buf) {
#pragma unroll
        for (int i = 0; i < 4; ++i) { const int q = tid + 512 * i; *(LAS u32x4*)(lds + buf * PBUF + (q >> 4) * (PST * 2) + (q & 15) * 16) = pp[i]; }
    };
    __syncthreads();
    load_step(0); write_p(0);
    f32x4 rc[8]; float ac = an;
#pragma unroll
    for (int mb = 0; mb < 8; ++mb) rc[mb] = rr[mb];
    __syncthreads();
    for (int n = 0; n < 64; ++n) {
        const long ib = (long)ch * 64 + n;
        if (n + 1 < 64) load_step(n + 1);
        bf16x8 bfr[4];
#pragma unroll
        for (int ks = 0; ks < 4; ++ks) { u32x4 q; q.x = pk2(acc[2 * ks][0], acc[2 * ks][1]); q.y = pk2(acc[2 * ks][2], acc[2 * ks][3]); q.z = pk2(acc[2 * ks + 1][0], acc[2 * ks + 1][1]); q.w = pk2(acc[2 * ks + 1][2], acc[2 * ks + 1][3]);
            bfr[ks] = __builtin_bit_cast(bf16x8, q);
            bf16_t* sp = p.gST + ib * 16384 + (w * 16 + fr) * 128 + 4 * fq;
            u32x2 lo, hi; lo.x = q.x; lo.y = q.y; hi.x = q.z; hi.y = q.w;
            *(u32x2*)(sp + (2 * ks) * 16) = lo; *(u32x2*)(sp + (2 * ks + 1) * 16) = hi; }
#pragma unroll
        for (int mb = 0; mb < 8; ++mb) acc[mb] = acc[mb] * ac + rc[mb];
        const LAS bf16_t* pb = (const LAS bf16_t*)(lds + (n & 1) * PBUF);
#pragma unroll
        for (int mb = 0; mb < 8; ++mb)
#pragma unroll
            for (int ks = 0; ks < 4; ++ks) acc[mb] = MFMA16(ld8(pb + (mb * 16 + fr) * PST + ks * 32 + 8 * fq), bfr[ks], acc[mb]);
        settle(acc[0], acc[1], acc[2], acc[3], acc[4], acc[5], acc[6], acc[7]);
        if (n + 1 < 64) { write_p((n + 1) & 1); ac = an;
#pragma unroll
            for (int mb = 0; mb < 8; ++mb) rc[mb] = rr[mb]; }
        __syncthreads();
    }
}

DI void gdn_out_item(CP p, int l, int item, LAS char* lds) {
    const int tid = tidx(), lane = tid & 63, w = __builtin_amdgcn_readfirstlane(tid >> 6), fr = lane & 15, fq = lane >> 4;
    const int n = item & 63, h = (item >> 6) & 3, b = item >> 8;
    const long tok0 = (long)b * SEQ + n * 64, ib = item;
    LAS float* red = (LAS float*)lds;
    const int ib16 = (w & 3) * 16, mh = w >> 2, i = ib16 + fr;
    bf16x8 sfr[4][4], qfr[4]; f32x4 ouv[4], gwv[4]; u32x2 zzv[4];
#pragma unroll
    for (int ks = 0; ks < 4; ++ks) qfr[ks] = ld8(p.gQp + ib * 8192 + (ib16 + fr) * 128 + 8 * fq + ks * 32);
#pragma unroll
    for (int m4 = 0; m4 < 4; ++m4)
#pragma unroll
        for (int ks = 0; ks < 4; ++ks) sfr[m4][ks] = ld8(p.gST + ib * 16384 + ((mh * 4 + m4) * 16 + fr) * 128 + 8 * fq + ks * 32);
#pragma unroll
    for (int m4 = 0; m4 < 4; ++m4) { const int c0 = (mh * 4 + m4) * 16 + 4 * fq; ouv[m4] = *(const f32x4*)(p.gOU + ib * 8192 + i * 128 + c0);
        gwv[m4] = *(const f32x4*)(p.in[I_GDN_NORM] + l * 128 + c0); zzv[m4] = *(const u32x2*)(p.proj + (tok0 + i) * NPROJ + C_Z + h * 128 + c0); }
    f32x4 acc[4];
#pragma unroll
    for (int m4 = 0; m4 < 4; ++m4) { acc[m4] = ZERO4;
#pragma unroll
        for (int ks = 0; ks < 4; ++ks) acc[m4] = MFMA16(sfr[m4][ks], qfr[ks], acc[m4]); }
    settle(acc[0], acc[1], acc[2], acc[3]);
    float s = 0.f;
#pragma unroll
    for (int m4 = 0; m4 < 4; ++m4) { acc[m4] += ouv[m4];
        s += acc[m4][0] * acc[m4][0] + acc[m4][1] * acc[m4][1] + acc[m4][2] * acc[m4][2] + acc[m4][3] * acc[m4][3]; }
    s += shflx<16>(s); s += shflx<32>(s);
    if (fq == 0) red[mh * 64 + i] = s;
    __syncthreads();
    const float rstd = rsqrtf((red[i] + red[64 + i]) * (1.f / 128.f) + EPS);
#pragma unroll
    for (int m4 = 0; m4 < 4; ++m4) { const int c0 = (mh * 4 + m4) * 16 + 4 * fq;
        const f32x4 gw = gwv[m4]; const u32x2 zz = zzv[m4];
        const float z0 = __uint_as_float(zz.x << 16), z1 = __uint_as_float(zz.x & 0xffff0000u), z2 = __uint_as_float(zz.y << 16), z3 = __uint_as_float(zz.y & 0xffff0000u);
        u32x2 o; o.x = pk2(acc[m4][0] * rstd * gw[0] * siluf_(z0), acc[m4][1] * rstd * gw[1] * siluf_(z1)); o.y = pk2(acc[m4][2] * rstd * gw[2] * siluf_(z2), acc[m4][3] * rstd * gw[3] * siluf_(z3));
        *(u32x2*)(p.mix + (tok0 + i) * D + 512 + h * 128 + c0) = o; }
    __syncthreads();
}
DI void nsa_prep_elem(CP p, int l) {
    const long gtid = (long)bidx() * 512 + tidx(), nth = (long)gdim() * 512;
    for (long task = gtid; task < (long)T * 24; task += nth) {
        const long t = task / 24; const int k = (int)(task - t * 24);
        const int s = (int)(t & (SEQ - 1)), b = (int)(t >> 12);
        int col; const float* gain; bf16_t* dst; float osc = 1.f;
        if (k < 16) { col = C_NQ + k * 64; gain = p.in[I_QNORM] + l * 64; dst = p.qn + t * 1024 + k * 64; osc = 0.125f * 1.4426950408889634f; }
        else if (k < 20) { const int g = k - 16; col = C_NKV + 2 * 256 + g * 64; gain = p.in[I_KNORM] + (l * 3 + 1) * 64; dst = p.ksn + (((long)(b * 4 + g)) * SEQ + s) * 64; }
        else { const int g = k - 20; col = C_NKV + 4 * 256 + g * 64; gain = p.in[I_KNORM] + (l * 3 + 2) * 64; dst = p.kwn + (((long)(b * 4 + g)) * SEQ + s) * 64; }
        const bf16_t* src = p.proj + t * NPROJ + col;
        float x[64]; float ss = 0.f;
#pragma unroll
        for (int c = 0; c < 8; ++c) { const bf16x8 v = ld8(src + 8 * c);
#pragma unroll
            for (int e = 0; e < 8; ++e) { x[8 * c + e] = bf2f((bf16_t)v[e]); ss += x[8 * c + e] * x[8 * c + e]; } }
        const float rstd = rsqrtf(ss * (1.f / 64.f) + EPS) * osc;
        const f32x4* rp = (const f32x4*)(p.rope + s * 32);
        unsigned o1[16], o2[16];
#pragma unroll
        for (int i2 = 0; i2 < 16; ++i2) { const f32x4 cs = rp[i2]; const int i = 2 * i2;
            const float a1 = x[i] * rstd * gain[i], a2 = x[32 + i] * rstd * gain[32 + i], b1 = x[i + 1] * rstd * gain[i + 1], b2 = x[33 + i] * rstd * gain[33 + i];
            o1[i2] = pk2(a1 * cs[0] - a2 * cs[1], b1 * cs[2] - b2 * cs[3]); o2[i2] = pk2(a2 * cs[0] + a1 * cs[1], b2 * cs[2] + b1 * cs[3]); }
#pragma unroll
        for (int c = 0; c < 4; ++c) { u32x4 w1, w2;
#pragma unroll
            for (int e = 0; e < 4; ++e) { w1[e] = o1[4 * c + e]; w2[e] = o2[4 * c + e]; }
            *(u32x4*)(dst + 8 * c) = w1; *(u32x4*)(dst + 32 + 8 * c) = w2; }
    }
}
DI void nsa_vtrans(CP p, LAS char* wl) {
    const int lane = tidx() & 63, gw = bidx() * 8 + __builtin_amdgcn_readfirstlane(tidx() >> 6), nw = gdim() * 8;
    LAS bf16_t* tile = (LAS bf16_t*)wl;
    for (int item = gw; item < 2 * 4 * 4 * 64; item += nw) {
        const int tl = item & 63, g = (item >> 6) & 3, b = (item >> 8) & 3, which = item >> 10;
        const long t = (long)b * SEQ + tl * 64 + lane;
        const bf16_t* src = p.proj + t * NPROJ + C_NKV + (which ? 5 : 3) * 256 + g * 64;
#pragma unroll
        for (int c = 0; c < 8; ++c) { const bf16x8 v = ld8(src + 8 * c);
#pragma unroll
            for (int e = 0; e < 8; ++e) tile[lane * 66 + 8 * c + e] = (bf16_t)v[e]; }
        lds_wait();
        bf16_t* dst = (which ? p.vwT : p.vsT) + ((long)(b * 4 + g) * 64 + lane) * SEQ + tl * 64;
#pragma unroll
        for (int c = 0; c < 8; ++c) { u32x4 o;
#pragma unroll
            for (int e = 0; e < 4; ++e) o[e] = (unsigned)tile[(8 * c + 2 * e) * 66 + lane] | ((unsigned)tile[(8 * c + 2 * e + 1) * 66 + lane] << 16);
            *(u32x4*)(dst + 8 * c) = o; }
        lds_wait();
    }
}

DI void nsa_cmp_unit(CP p, int l, int unit, LAS char* lds) {
    const int kv = unit >> 4, mtile = unit & 15;
    const int tid = tidx(), lane = tid & 63, w = __builtin_amdgcn_readfirstlane(tid >> 6), fr = lane & 15, fq = lane >> 4;
    unsigned aoff[2][2], boff[2];
#pragma unroll
    for (int h = 0; h < 2; ++h)
#pragma unroll
        for (int i = 0; i < 2; ++i) { int R, C; g8::my_rc(i, R, C); const int row = mtile * 256 + h * 128 + R;
            const int b = row >> 10, n = min((row & 1023) >> 2, 254), g = row & 3;
            aoff[h][i] = (unsigned)((((long)b * SEQ + 16 * n) * NPROJ + C_NKV + kv * 256 + g * 64 + C) * 2);
            boff[i] = (unsigned)(R * 2048 + C) * 2u; }
    LAS bf16_t* Hs = (LAS bf16_t*)lds;
    const float* b1 = p.bias1 + kv * 256;
    g8::gemm_tile(lds, (const char*)p.proj, aoff, (long)NPROJ * 2, (const char*)(p.w1T + l * LW_W1 + (long)kv * 256 * 2048), boff, 128L * 2048 * 2, 32, [&](const Acc& acc, int rb, int cb) {
        ACC_FOR(ai, m, bj, n) { const int r = ai * 128 + m * 16 + rb, c = bj * 128 + n * 16 + cb; const f32x4 v = acc[ai][bj][m][n];
            u32x2 o; o.x = pk2(gelu_tanh(v[0] + b1[c]), gelu_tanh(v[1] + b1[c + 1])); o.y = pk2(gelu_tanh(v[2] + b1[c + 2]), gelu_tanh(v[3] + b1[c + 3]));
            *(LAS u32x2*)(Hs + r * 264 + c) = o; }
    });
    __syncthreads();
    const bf16_t* w2 = p.w2T + l * LW_W2 + (long)kv * 64 * 256;
    for (int rg = w; rg < 16; rg += 8) {
        f32x4 acc[4];
#pragma unroll
        for (int mt = 0; mt < 4; ++mt) acc[mt] = ZERO4;
#pragma unroll
        for (int ks = 0; ks < 8; ++ks) { const bf16x8 hb = ld8(Hs + (rg * 16 + fr) * 264 + ks * 32 + 8 * fq);
#pragma unroll
            for (int mt = 0; mt < 4; ++mt) acc[mt] = MFMA16(ld8(w2 + (mt * 16 + fr) * 256 + ks * 32 + 8 * fq), hb, acc[mt]); }
        settle(acc[0], acc[1], acc[2], acc[3]);
        const int row = mtile * 256 + rg * 16 + fr; const int b = row >> 10, n = (row & 1023) >> 2, g = row & 3;
        const bool valid = n < 255;
        if (kv == 0) {
            float ss = 0.f;
#pragma unroll
            for (int mt = 0; mt < 4; ++mt)
#pragma unroll
                for (int j = 0; j < 4; ++j) ss += acc[mt][j] * acc[mt][j];
            ss += shflx<16>(ss); ss += shflx<32>(ss);
            const float rstd = rsqrtf(ss * (1.f / 64.f) + EPS);
            const float* gain = p.in[I_KNORM] + (l * 3 + 0) * 64;
            const int pos = min(16 * n + 31, SEQ - 1);
            bf16_t* dst = p.kcmp + (((long)(b * 4 + g)) * 256 + n) * 64;
#pragma unroll
            for (int mt = 0; mt < 2; ++mt) { u32x2 lo, hi; float o1[4], o2[4];
#pragma unroll
                for (int j = 0; j < 4; ++j) { const int d = mt * 16 + 4 * fq + j; const f32x2 cs = p.rope[pos * 32 + d];
                    const float y1 = acc[mt][j] * rstd * gain[d], y2 = acc[mt + 2][j] * rstd * gain[32 + d];
                    o1[j] = valid ? y1 * cs.x - y2 * cs.y : 0.f; o2[j] = valid ? y2 * cs.x + y1 * cs.y : 0.f; }
                lo.x = pk2(o1[0], o1[1]); lo.y = pk2(o1[2], o1[3]); hi.x = pk2(o2[0], o2[1]); hi.y = pk2(o2[2], o2[3]);
                *(u32x2*)(dst + mt * 16 + 4 * fq) = lo; *(u32x2*)(dst + 32 + mt * 16 + 4 * fq) = hi; }
        } else {
            bf16_t* dst = p.vcmpT + (((long)(b * 4 + g)) * 64) * 256 + n;
#pragma unroll
            for (int mt = 0; mt < 4; ++mt)
#pragma unroll
                for (int j = 0; j < 4; ++j) dst[(long)(mt * 16 + 4 * fq + j) * 256] = f2bf(valid ? acc[mt][j] : 0.f);
        }
    }
    __syncthreads();
}

DI int crow(int i, int hh) { return (i & 3) + 8 * (i >> 2) + 4 * hh; }
DI bf16x8 pack8(const float* q) { u32x4 r; r.x = pk2(q[0], q[1]); r.y = pk2(q[2], q[3]); r.z = pk2(q[4], q[5]); r.w = pk2(q[6], q[7]); return __builtin_bit_cast(bf16x8, r); }
template <int S> DI bf16x8 pack_step(const f32x16& x) {
    u32x4 r;
    asm volatile("v_cvt_pk_bf16_f32 %0, %4, %5\n\tv_cvt_pk_bf16_f32 %1, %6, %7\n\tv_cvt_pk_bf16_f32 %2, %8, %9\n\tv_cvt_pk_bf16_f32 %3, %10, %11\n\ts_nop 1"
                 : "=&v"(r[0]), "=&v"(r[1]), "=&v"(r[2]), "=&v"(r[3])
                 : "v"(x[8 * S]), "v"(x[8 * S + 1]), "v"(x[8 * S + 2]), "v"(x[8 * S + 3]), "v"(x[8 * S + 4]), "v"(x[8 * S + 5]), "v"(x[8 * S + 6]), "v"(x[8 * S + 7]));
    return __builtin_bit_cast(bf16x8, r);
}
DI float exp2_(float x) { return __builtin_amdgcn_exp2f(x); }
DI float max16(const f32x16& a) { float m0 = fmaxf(fmaxf(a[0], a[1]), fmaxf(a[2], a[3])), m1 = fmaxf(fmaxf(a[4], a[5]), fmaxf(a[6], a[7])), m2 = fmaxf(fmaxf(a[8], a[9]), fmaxf(a[10], a[11])), m3 = fmaxf(fmaxf(a[12], a[13]), fmaxf(a[14], a[15])); return fmaxf(fmaxf(m0, m1), fmaxf(m2, m3)); }
DI bf16x8 ldvt(const bf16_t* vt, long ldv, int d, int key) { const u32x2 a = *(const u32x2*)(vt + (long)d * ldv + key), b = *(const u32x2*)(vt + (long)d * ldv + key + 8); u32x4 r; r.x = a.x; r.y = a.y; r.z = b.x; r.w = b.y; return __builtin_bit_cast(bf16x8, r); }

constexpr int NS_KC = 0, NS_VC = 36864, NS_KR = 70656, NS_VR = 89088, NS_IMP = 107520, NS_UN = 123904, NS_TL = 124160;
DI bf16x8 ldvt_l(const LAS bf16_t* q) { const u32x2 a = *(const LAS u32x2*)q, b = *(const LAS u32x2*)(q + 8); u32x4 r; r.x = a.x; r.y = a.y; r.z = b.x; r.w = b.y; return __builtin_bit_cast(bf16x8, r); }
DI void nsa_unit(CP p, int l, int unit, LAS char* lds) {
    const int tid = tidx(), lane = tid & 63, w = __builtin_amdgcn_readfirstlane(tid >> 6), r31 = lane & 31, hh = lane >> 5;
    unit = __builtin_amdgcn_readfirstlane(unit);
    const int ub = unit & 63, g = (unit >> 6) & 3, b = unit >> 8;
    const int S0 = ub * 64, s0 = S0 + 8 * w, qi = r31 >> 2, rr = r31 & 3, tq = s0 + qi;
    const long tok = (long)b * SEQ + tq;
    LAS bf16_t* Kc = (LAS bf16_t*)(lds + NS_KC);
    LAS bf16_t* Vc = (LAS bf16_t*)(lds + NS_VC);
    LAS bf16_t* Kr = (LAS bf16_t*)(lds + NS_KR);
    LAS bf16_t* Vr = (LAS bf16_t*)(lds + NS_VR);
    LAS float* impL = (LAS float*)(lds + NS_IMP + w * 2048);
    LAS unsigned long long* unL = (LAS unsigned long long*)(lds + NS_UN);
    LAS int* tl = (LAS int*)(lds + NS_TL);
#ifdef TPROBE
#define TP(k) do { if ((k) == TPROBE_A && tid == 0) ((LAS unsigned*)(lds + 157 * 1024))[0] = (unsigned)__builtin_amdgcn_s_memrealtime(); if ((k) == TPROBE_B && unit == TPROBE_UNIT && l == 0 && tid == 0) p.err[3440] = (unsigned)__builtin_amdgcn_s_memrealtime() - ((LAS unsigned*)(lds + 157 * 1024))[0]; } while (0)
    TP(0);
#endif
    bf16x8 qf[4];
    { const bf16_t* qp = p.qn + tok * 1024 + (g * 4 + rr) * 64 + 8 * hh;
#pragma unroll
      for (int s = 0; s < 4; ++s) qf[s] = ld8(qp + 16 * s); }
#pragma unroll
    for (int k = 0; k < 8; ++k) impL[k * 64 + lane] = 0.f;
    f32x16 outacc[2];
#pragma unroll
    for (int i = 0; i < 16; ++i) { outacc[0][i] = 0.f; outacc[1][i] = 0.f; }
    const float* gl = p.small + tok * NSMALL + 8 + g * 12 + rr * 3;
    const float gate_c = sigmoidf_(gl[0]), gate_s = sigmoidf_(gl[1]), gate_w = sigmoidf_(gl[2]);
    const f32x16 zero16 = {0.f, 0.f, 0.f, 0.f, 0.f, 0.f, 0.f, 0.f, 0.f, 0.f, 0.f, 0.f, 0.f, 0.f, 0.f, 0.f};
    auto qk = [&](const LAS bf16_t* kt  ) { f32x16 acc = zero16;
#pragma unroll
        for (int s = 0; s < 4; ++s) acc = MFMA32(ld8(kt + r31 * 72 + 16 * s + 8 * hh), qf[s], acc);
        settle(acc); return acc; };
    {
        const int nvB = (S0 + 63 >= 31) ? ((S0 + 63 - 31) >> 4) + 1 : 0; const int rows = ((nvB + 31) >> 5) * 32;
        const bf16_t* kc = p.kcmp + ((long)(b * 4 + g) * 256) * 64; const bf16_t* vt = p.vcmpT + ((long)(b * 4 + g) * 64) * 256;
        for (int q = tid; q < rows * 8; q += 512) { const int row = q >> 3, c = q & 7; *(LAS u32x4*)(Kc + row * 72 + c * 8) = *(const u32x4*)(kc + (long)row * 64 + c * 8); }
        const int pc = rows >> 3;
        for (int q = tid; q < 64 * pc; q += 512) { const int d = q / pc, c = q - d * pc; *(LAS u32x4*)(Vc + d * 264 + c * 8) = *(const u32x4*)(vt + (long)d * 256 + c * 8); }
        __syncthreads();
        const int nvmax = (s0 + 7 >= 31) ? ((s0 + 7 - 31) >> 4) + 1 : 0; const int ntile = (nvmax + 31) >> 5;
        const int nv = (tq >= 31) ? ((tq - 31) >> 4) + 1 : 0;
        const int nvmin = (s0 >= 31) ? ((s0 - 31) >> 4) + 1 : 0;
#ifndef REP_PA
#define REP_PA 1
#endif
        float m = -1e30f, lsum = 0.f;
        for (int rpa = 0; rpa < REP_PA; ++rpa) { m = -1e30f; lsum = 0.f;
        for (int tI = 0; tI < ntile; ++tI) {
            const int key0 = tI * 32; f32x16 acc = qk(Kc + key0 * 72);
            if (key0 + 32 > nvmin) {
#pragma unroll
                for (int i = 0; i < 16; ++i) acc[i] = (key0 + crow(i, hh) < nv) ? acc[i] : -1e30f; }
            float mx = max16(acc); mx = fmaxf(mx, shflx<32>(mx));
            const float mn = fmaxf(m, mx), ms = fmaxf(mn, -1e20f); float ps = 0.f;
#pragma unroll
            for (int i = 0; i < 16; ++i) ps += exp2_(acc[i] - ms);
            lsum = lsum * exp2_(m - mn) + ps; m = mn;
        } }
        lsum += shflx<32>(lsum);
        const float inv = lsum > 0.f ? 1.f / lsum : 0.f;
        const float mfin = fmaxf(m, -1e20f), linv = __builtin_amdgcn_logf(fmaxf(inv, 1e-37f));
        const float sub = mfin - linv;
        f32x16 oc[2] = {zero16, zero16};
        for (int tI = 0; tI < ntile; ++tI) {
            const int key0 = tI * 32; f32x16 acc = qk(Kc + key0 * 72);
            if (key0 + 32 > nvmin) {
#pragma unroll
                for (int i = 0; i < 16; ++i) acc[i] = (key0 + crow(i, hh) < nv) ? acc[i] : -1e30f; }
#pragma unroll
            for (int i = 0; i < 16; ++i) acc[i] = exp2_(acc[i] - sub);
#pragma unroll
            for (int qd = 0; qd < 4; ++qd) { float mainv = acc[4 * qd] + acc[4 * qd + 1] + acc[4 * qd + 2] + 0.5f * acc[4 * qd + 3], sp = 0.5f * acc[4 * qd + 3];
                mainv += shflx<1>(mainv); mainv += shflx<2>(mainv); sp += shflx<1>(sp); sp += shflx<2>(sp);
                const int j = (key0 >> 2) + 2 * qd + hh;
                if (rr == 0) { __hip_atomic_fetch_add(&impL[qi * 64 + j], mainv, __ATOMIC_RELAXED, __HIP_MEMORY_SCOPE_WORKGROUP);
                    if (j + 1 < 64) __hip_atomic_fetch_add(&impL[qi * 64 + j + 1], sp, __ATOMIC_RELAXED, __HIP_MEMORY_SCOPE_WORKGROUP); } }
            { const bf16x8 pb0 = pack_step<0>(acc), pb1 = pack_step<1>(acc);
#pragma unroll
              for (int mb = 0; mb < 2; ++mb) { oc[mb] = MFMA32(ldvt_l(Vc + (32 * mb + r31) * 264 + key0 + 4 * hh), pb0, oc[mb]); oc[mb] = MFMA32(ldvt_l(Vc + (32 * mb + r31) * 264 + key0 + 16 + 4 * hh), pb1, oc[mb]); } }
        }
        settle(oc[0], oc[1]);
#pragma unroll
        for (int i = 0; i < 16; ++i) { outacc[0][i] = gate_c * oc[0][i]; outacc[1][i] = gate_c * oc[1][i]; }
    }
    lds_wait();
#ifdef TPROBE
    TP(1);
#endif
    unsigned long long mymask = 0ull, un = 0ull;
    {
        const int cur = S0 >> 6;
        if (cur < 16) {
            mymask = un = (2ull << cur) - 1ull;
        } else {
#ifndef REP_SEL
#define REP_SEL 1
#endif
#pragma unroll 1
            for (int q2x = 0; q2x < 8 * REP_SEL; ++q2x) { const int q2 = q2x & 7; if (q2x >= 8 && q2 == 0) { un = 0ull; }
                const float v = impL[q2 * 64 + lane];
                const bool forced = (lane == 0) || (lane == cur) || (lane == cur - 1), started = lane <= cur;
                const unsigned key = forced ? (0xffffffc0u | (unsigned)(63 - lane)) : (started ? ((__float_as_uint(v) & ~63u) | (unsigned)(63 - lane)) : 0u);
                int rank = 0;
#pragma unroll 16
                for (int jj = 0; jj < 64; ++jj) { const unsigned o = (unsigned)__builtin_amdgcn_readlane((int)key, jj); rank += (o > key) ? 1 : 0; }
                const unsigned long long mk = __ballot(rank < 16 && started);
                if (qi == q2) mymask = mk;
                un |= mk;
            }
        }
    }
    if (lane == 0) unL[w] = un;
    __syncthreads();
    if (tid == 0) { unsigned long long U = 0ull; for (int k = 0; k < 8; ++k) U |= unL[k]; int n = 0; while (U) { const int j = __builtin_ctzll(U); U &= U - 1ull; tl[1 + n] = 64 * j; ++n; } tl[0] = n; }
    __syncthreads();
    const int nsl = __builtin_amdgcn_readfirstlane(tl[0]);
    LAS float* oL = (LAS float*)(lds + w * 8192);
#pragma unroll
    for (int mb = 0; mb < 2; ++mb)
#pragma unroll
        for (int i = 0; i < 16; ++i) oL[(mb * 16 + i) * 64 + lane] = outacc[mb][i];
#ifdef TPROBE
    TP(2);
#endif
    const int prow = tid >> 3, pcol = (tid & 7) * 8;
    auto branch = [&](const bf16_t* kb, const bf16_t* vt, int nt, auto&& k0of, auto&& need_fn, auto&& mask_fn, float gate, bool keep) {
        float m = -1e30f, lsum = 0.f; f32x16 o[2] = {zero16, zero16};
        auto gload = [&](int K0, u32x4& kr, u32x4& vr) { kr = *(const u32x4*)(kb + (long)(K0 + prow) * 64 + pcol); vr = *(const u32x4*)(vt + (long)prow * SEQ + K0 + pcol); };
        auto lwrite = [&](int slot, const u32x4& kr, const u32x4& vr) { *(LAS u32x4*)(Kr + slot * 4608 + prow * 72 + pcol) = kr; *(LAS u32x4*)(Vr + slot * 4608 + prow * 72 + pcol) = vr; };
        auto process = [&](int key0, const LAS bf16_t* kt, const LAS bf16_t* vtl  ) {
            f32x16 acc = qk(kt);
            const bool dead = mask_fn(key0, acc);
            float mx = dead ? -1e30f : max16(acc); mx = fmaxf(mx, shflx<32>(mx));
            const float mn = fmaxf(m, mx), alpha = exp2_(m - mn), ms = dead ? 1e30f : fmaxf(mn, -1e20f); float ps = 0.f;
#pragma unroll
            for (int i = 0; i < 16; ++i) { acc[i] = exp2_(acc[i] - ms); ps += acc[i]; }
            lsum = lsum * alpha + ps; m = mn;
            if (__any(alpha != 1.f)) {
#pragma unroll
                for (int i = 0; i < 16; ++i) { o[0][i] *= alpha; o[1][i] *= alpha; } }
            const bf16x8 pb0 = pack_step<0>(acc), pb1 = pack_step<1>(acc);
#pragma unroll
            for (int mb = 0; mb < 2; ++mb) o[mb] = MFMA32(ldvt_l(vtl + (32 * mb + r31) * 72 + 4 * hh), pb0, o[mb]);
#pragma unroll
            for (int mb = 0; mb < 2; ++mb) o[mb] = MFMA32(ldvt_l(vtl + (32 * mb + r31) * 72 + 16 + 4 * hh), pb1, o[mb]); };
        auto process2 = [&](int K0, const LAS bf16_t* kt, const LAS bf16_t* vtl) {
            f32x16 a0 = zero16, a1 = zero16;
#pragma unroll
            for (int s = 0; s < 4; ++s) { a0 = MFMA32(ld8(kt + r31 * 72 + 16 * s + 8 * hh), qf[s], a0); a1 = MFMA32(ld8(kt + (32 + r31) * 72 + 16 * s + 8 * hh), qf[s], a1); }
            settle(a0, a1);
            const bool d0 = mask_fn(K0, a0), d1 = mask_fn(K0 + 32, a1);
            float mx = fmaxf(d0 ? -1e30f : max16(a0), d1 ? -1e30f : max16(a1)); mx = fmaxf(mx, shflx<32>(mx));
            const float mn = fmaxf(m, mx), alpha = exp2_(m - mn), msv = fmaxf(mn, -1e20f), ms0 = d0 ? 1e30f : msv, ms1 = d1 ? 1e30f : msv; float ps = 0.f;
#pragma unroll
            for (int i = 0; i < 16; ++i) { a0[i] = exp2_(a0[i] - ms0); a1[i] = exp2_(a1[i] - ms1); ps += a0[i] + a1[i]; }
            lsum = lsum * alpha + ps; m = mn;
            if (__any(alpha != 1.f)) {
#pragma unroll
                for (int i = 0; i < 16; ++i) { o[0][i] *= alpha; o[1][i] *= alpha; } }
            const bf16x8 p00 = pack_step<0>(a0), p01 = pack_step<1>(a0), p10 = pack_step<0>(a1), p11 = pack_step<1>(a1);
#pragma unroll
            for (int mb = 0; mb < 2; ++mb) o[mb] = MFMA32(ldvt_l(vtl + (32 * mb + r31) * 72 + 4 * hh), p00, o[mb]);
#pragma unroll
            for (int mb = 0; mb < 2; ++mb) o[mb] = MFMA32(ldvt_l(vtl + (32 * mb + r31) * 72 + 16 + 4 * hh), p01, o[mb]);
#pragma unroll
            for (int mb = 0; mb < 2; ++mb) o[mb] = MFMA32(ldvt_l(vtl + (32 * mb + r31) * 72 + 32 + 4 * hh), p10, o[mb]);
#pragma unroll
            for (int mb = 0; mb < 2; ++mb) o[mb] = MFMA32(ldvt_l(vtl + (32 * mb + r31) * 72 + 48 + 4 * hh), p11, o[mb]); };
        auto gload_a = [&](int K0, u32x4& kr, u32x4& vr) {
            const bf16_t* kp = kb + (long)(K0 + prow) * 64 + pcol; const bf16_t* vp = vt + (long)prow * SEQ + K0 + pcol;
            asm volatile("global_load_dwordx4 %0, %2, off\n\tglobal_load_dwordx4 %1, %3, off" : "=&v"(kr), "=&v"(vr) : "v"(kp), "v"(vp) : "memory"); };
        auto step = [&](int i, u32x4& kNext, u32x4& vNext, u32x4& kFar, u32x4& vFar) {
            gload_a(k0of(min(i + 3, nt - 1)), kFar, vFar);
            const int K0 = k0of(i); const int slot = i & 1;
            const bool n0 = need_fn(K0), n1 = need_fn(K0 + 32);
            if (n0 && n1) process2(K0, Kr + slot * 4608, Vr + slot * 4608);
            else if (n0) process(K0, Kr + slot * 4608, Vr + slot * 4608);
            else if (n1) process(K0 + 32, Kr + slot * 4608 + 32 * 72, Vr + slot * 4608 + 32);
            asm volatile("s_waitcnt vmcnt(4)" : "+v"(kNext), "+v"(vNext) :: "memory");
            if (i + 1 < nt) lwrite((i + 1) & 1, kNext, vNext);
            __syncthreads(); };
        u32x4 k0r, v0r, k1r, v1r, k2r, v2r;
        if (nt > 0) {
            gload_a(k0of(0), k0r, v0r); gload_a(k0of(min(1, nt - 1)), k1r, v1r); gload_a(k0of(min(2, nt - 1)), k2r, v2r);
            asm volatile("s_waitcnt vmcnt(4)" : "+v"(k0r), "+v"(v0r) :: "memory");
            lwrite(0, k0r, v0r);
        }
        __syncthreads();
        for (int i = 0; i < nt; i += 3) {
            step(i, k1r, v1r, k0r, v0r);
            if (i + 1 < nt) step(i + 1, k2r, v2r, k1r, v1r);
            if (i + 2 < nt) step(i + 2, k0r, v0r, k2r, v2r);
        }
        if (nt > 0) asm volatile("s_waitcnt vmcnt(0)" : "+v"(k0r), "+v"(v0r), "+v"(k1r), "+v"(v1r), "+v"(k2r), "+v"(v2r) :: "memory");
        settle(o[0], o[1]);
        lsum += shflx<32>(lsum);
        const float sc = lsum > 0.f ? gate / lsum : 0.f;
#pragma unroll
        for (int mb = 0; mb < 2; ++mb)
#pragma unroll
            for (int i = 0; i < 16; ++i) oL[(mb * 16 + i) * 64 + lane] += keep ? sc * o[mb][i] : 0.f;
    };
    {
        const bf16_t* kb = p.ksn + ((long)(b * 4 + g) * SEQ) * 64; const bf16_t* vt = p.vsT + ((long)(b * 4 + g) * 64) * SEQ;
        const unsigned long long mm = mymask, myun = un;
#ifndef REP_SLC
#define REP_SLC 1
#define REP_WIN 1
#endif
        for (int rep = 0; rep < REP_SLC; ++rep)
        branch(kb, vt, nsl, [&](int i) { return __builtin_amdgcn_readfirstlane(tl[1 + i]); },
               [&](int key0) { return ((myun >> (key0 >> 6)) & 1ull) != 0ull && key0 <= s0 + 7; },
               [&](int key0, f32x16& acc) { const bool rowsel = ((mm >> (key0 >> 6)) & 1ull) != 0ull;
                   if (key0 + 31 <= s0) return !rowsel;
#pragma unroll
                   for (int i = 0; i < 16; ++i) acc[i] = (rowsel && key0 + crow(i, hh) <= tq) ? acc[i] : -1e30f;
                   return false; }, gate_s, rep == 0);
    }
#ifdef TPROBE
    TP(3);
#endif
    {
        const bf16_t* kb = p.kwn + ((long)(b * 4 + g) * SEQ) * 64; const bf16_t* vt = p.vwT + ((long)(b * 4 + g) * 64) * SEQ;
        const int T_lo = max(0, S0 - 511) >> 6, T_hi = (S0 + 63) >> 6;
        const int k_lo = (max(0, s0 - 511) >> 5) * 32, k_hi = ((s0 + 7) >> 5) * 32;
        for (int rep = 0; rep < REP_WIN; ++rep)
        branch(kb, vt, T_hi - T_lo + 1, [&](int i) { return (T_lo + i) * 64; },
               [&](int key0) { return key0 >= k_lo && key0 <= k_hi; },
               [&](int key0, f32x16& acc) {
                   if (!(key0 + 31 <= s0 && key0 > s0 + 7 - 512)) {
#pragma unroll
                       for (int i = 0; i < 16; ++i) { const int pos = key0 + crow(i, hh); acc[i] = (pos <= tq && pos > tq - 512) ? acc[i] : -1e30f; } }
                   return false; }, gate_w, rep == 0);
    }
    bf16_t* dst = p.mix + tok * D + 1024 + (g * 4 + rr) * 64;
#pragma unroll
    for (int mb = 0; mb < 2; ++mb)
#pragma unroll
        for (int qd = 0; qd < 4; ++qd) { const LAS float* q = oL + (mb * 16 + 4 * qd) * 64 + lane; u32x2 o; o.x = pk2(q[0], q[64]); o.y = pk2(q[128], q[192]);
            *(u32x2*)(dst + 32 * mb + 8 * qd + 4 * hh) = o; }
    __syncthreads();
#ifdef TPROBE
    TP(4);
    if (unit == TPROBE_UNIT && l == 0 && tid == 0) p.err[3445] = (unsigned)nsl;
#endif
}
DI void s5_glu_item(CP p, int l, int item, LAS char* lds) {
    const int tid = tidx(), lane = tid & 63, w = __builtin_amdgcn_readfirstlane(tid >> 6), fr = lane & 15, fq = lane >> 4;
    const long tok0 = (long)item * 64;
    LAS bf16_t* Ys = (LAS bf16_t*)lds;
    LAS float* red = (LAS float*)(lds + 64 * 520 * 2);
#pragma unroll
    for (int i = 0; i < 8; ++i) { const int e = tid + i * 512, r = e >> 6, c = e & 63; *(LAS u32x4*)(Ys + r * 520 + c * 8) = *(const u32x4*)(p.s5y + (tok0 + r) * 512 + c * 8); }
    __syncthreads();
    f32x4 acc[4][4];
#pragma unroll
    for (int nb = 0; nb < 4; ++nb)
#pragma unroll
        for (int it = 0; it < 4; ++it) acc[nb][it] = ZERO4;
    const bf16_t* gw = p.gluT + l * LW_GLU + (long)(w * 64 + fr) * 512 + 8 * fq;
#pragma unroll 8
    for (int ks = 0; ks < 16; ++ks) {
        bf16x8 a[4], bb[4];
#pragma unroll
        for (int it = 0; it < 4; ++it) a[it] = ld8(Ys + (it * 16 + fr) * 520 + ks * 32 + 8 * fq);
#pragma unroll
        for (int nb = 0; nb < 4; ++nb) bb[nb] = ld8(gw + (long)nb * 16 * 512 + ks * 32);
#pragma unroll
        for (int nb = 0; nb < 4; ++nb)
#pragma unroll
            for (int it = 0; it < 4; ++it) acc[nb][it] = MFMA16(bb[nb], a[it], acc[nb][it]);
    }
    settle(acc[0][0], acc[0][1], acc[0][2], acc[0][3], acc[1][0], acc[1][1], acc[1][2], acc[1][3]);
    settle(acc[2][0], acc[2][1], acc[2][2], acc[2][3], acc[3][0], acc[3][1], acc[3][2], acc[3][3]);
#pragma unroll
    for (int it = 0; it < 4; ++it) { const int i = it * 16 + fr; float s = 0.f;
#pragma unroll
        for (int nb = 0; nb < 4; ++nb) { const int n0 = w * 64 + nb * 16 + 4 * fq;
            const u32x2 yy = *(const LAS u32x2*)(Ys + i * 520 + n0); const f32x4 gb = *(const f32x4*)(p.in[I_GLU_B] + l * 512 + n0);
            const float y0 = __uint_as_float(yy.x << 16), y1 = __uint_as_float(yy.x & 0xffff0000u), y2 = __uint_as_float(yy.y << 16), y3 = __uint_as_float(yy.y & 0xffff0000u);
            f32x4 v = acc[nb][it]; v[0] = y0 * sigmoidf_(v[0] + gb[0]); v[1] = y1 * sigmoidf_(v[1] + gb[1]); v[2] = y2 * sigmoidf_(v[2] + gb[2]); v[3] = y3 * sigmoidf_(v[3] + gb[3]);
            acc[nb][it] = v; s += v[0] * v[0] + v[1] * v[1] + v[2] * v[2] + v[3] * v[3]; }
        s += shflx<16>(s); s += shflx<32>(s);
        if (fq == 0) red[w * 64 + i] = s; }
    __syncthreads();
#pragma unroll
    for (int it = 0; it < 4; ++it) { const int i = it * 16 + fr; float tot = 0.f;
#pragma unroll
        for (int ww = 0; ww < 8; ++ww) tot += red[ww * 64 + i];
        const float rstd = rsqrtf(tot * (1.f / 512.f) + EPS);
#pragma unroll
        for (int nb = 0; nb < 4; ++nb) { const int n0 = w * 64 + nb * 16 + 4 * fq; const f32x4 gn = *(const f32x4*)(p.in[I_S5NORM] + l * 512 + n0); const f32x4 v = acc[nb][it];
            u32x2 o; o.x = pk2(v[0] * rstd * gn[0], v[1] * rstd * gn[1]); o.y = pk2(v[2] * rstd * gn[2], v[3] * rstd * gn[3]);
            *(u32x2*)(p.mix + (tok0 + i) * D + n0) = o; } }
    __syncthreads();
}

DI void nsa_outnorm(CP p, int l) {
    const int lane = tidx() & 63, gw = bidx() * 8 + __builtin_amdgcn_readfirstlane(tidx() >> 6), nw = gdim() * 8;
    const float* gain = p.in[I_NSA_NORM] + l * 1024 + lane * 16;
    for (int t0 = gw; t0 < T; t0 += 4 * nw) {
        bf16x8 v0[4], v1[4]; float ss[4];
#pragma unroll
        for (int q = 0; q < 4; ++q) { const int t = min(t0 + q * nw, T - 1); const bf16_t* row = p.mix + (long)t * D + 1024 + lane * 16; v0[q] = ld8(row); v1[q] = ld8(row + 8); }
#pragma unroll
        for (int q = 0; q < 4; ++q) { float s = 0.f;
#pragma unroll
            for (int e = 0; e < 8; ++e) { const float a = bf2f((bf16_t)v0[q][e]), b = bf2f((bf16_t)v1[q][e]); s += a * a + b * b; }
            ss[q] = s; }
#pragma unroll
        for (int q = 0; q < 4; ++q) ss[q] += shflx<1>(ss[q]);
#pragma unroll
        for (int q = 0; q < 4; ++q) ss[q] += shflx<2>(ss[q]);
#pragma unroll
        for (int q = 0; q < 4; ++q) ss[q] += shflx<4>(ss[q]);
#pragma unroll
        for (int q = 0; q < 4; ++q) ss[q] += shflx<8>(ss[q]);
#pragma unroll
        for (int q = 0; q < 4; ++q) ss[q] += shflx<16>(ss[q]);
#pragma unroll
        for (int q = 0; q < 4; ++q) ss[q] += shflx<32>(ss[q]);
#pragma unroll
        for (int q = 0; q < 4; ++q) { const int t = t0 + q * nw; if (t < T) {
            bf16_t* row = p.mix + (long)t * D + 1024 + lane * 16;
            const float rstd = rsqrtf(ss[q] * (1.f / 1024.f) + EPS);
            u32x4 o0, o1;
#pragma unroll
            for (int e = 0; e < 4; ++e) { o0[e] = pk2(bf2f((bf16_t)v0[q][2 * e]) * rstd * gain[2 * e], bf2f((bf16_t)v0[q][2 * e + 1]) * rstd * gain[2 * e + 1]);
                o1[e] = pk2(bf2f((bf16_t)v1[q][2 * e]) * rstd * gain[8 + 2 * e], bf2f((bf16_t)v1[q][2 * e + 1]) * rstd * gain[9 + 2 * e]); }
            *(u32x4*)row = o0; *(u32x4*)(row + 8) = o1; } }
    }
}

DI void p6_outproj(CP p, int l, LAS char* lds) {
    unsigned aoff[2][2], boff[2];
#pragma unroll
    for (int i = 0; i < 2; ++i) { int R, C; g8::my_rc(i, R, C); boff[i] = (unsigned)(R * D + C) * 2u; aoff[0][i] = boff[i]; aoff[1][i] = (unsigned)((128 + R) * D + C) * 2u; }
    const float* xres = l == 0 ? p.in[I_X] : p.out; const float* lnf = p.in[I_LN_FFN] + l * D;
    for (int u = bidx();; u += gdim()) {
        int pm, pn; if (!g8::unit_of(u, T / 256, D / 256, pm, pn)) break;
        float* hh = p.h; bf16_t* hb = p.xb;
        g8::gemm_tile(lds, (const char*)(p.mix + (long)pm * 256 * D), aoff, 128, (const char*)(p.WoutT + l * LW_WOUT + (long)pn * 256 * D), boff, 128L * D * 2, D / 64, [&](const Acc& acc, int rb, int cb) {
            ACC_FOR(ai, m, bj, n) { const int r = ai * 128 + m * 16 + rb, c = bj * 128 + n * 16 + cb; const long off = (long)(pm * 256 + r) * D + pn * 256 + c;
                const f32x4 v = acc[ai][bj][m][n] + *(const f32x4*)(xres + off);
                *(f32x4*)(hh + off) = v; }
        });
    }
}

DI void router_phase(CP p, int l, LAS char* lds) {
    const int tid = tidx(), lane = tid & 63, w = __builtin_amdgcn_readfirstlane(tid >> 6), fr = lane & 15, fq = lane >> 4, half = w & 1;
    for (int tg0 = bidx() * 4; tg0 < T / 16; tg0 += gdim() * 4) {
        const long t0 = (long)(tg0 + (w >> 1)) * 16;
        f32x4 acc[3] = {ZERO4, ZERO4, ZERO4}; float ss = 0.f;
        const float* hr = p.h + (t0 + fr) * D + half * (D / 2) + 4 * fq; const float* wr = p.Wr + (long)fr * D + half * (D / 2) + 4 * fq;
        const float* lnf = p.in[I_LN_FFN] + l * D + half * (D / 2) + 4 * fq; bf16_t* hbr = p.xb + (t0 + fr) * D + half * (D / 2) + 4 * fq;
#pragma unroll 4
        for (int k0 = 0; k0 < D / 2; k0 += 16) {
            const f32x4 hv = *(const f32x4*)(hr + k0);
            { const f32x4 g4 = *(const f32x4*)(lnf + k0); u32x2 hw; hw.x = pk2h(hv[0] * g4[0], hv[1] * g4[1]); hw.y = pk2h(hv[2] * g4[2], hv[3] * g4[3]); *(u32x2*)(hbr + k0) = hw; }
            f32x4 wv[3];
#pragma unroll
            for (int nb = 0; nb < 3; ++nb) wv[nb] = *(const f32x4*)(wr + (long)nb * 16 * D + k0);
            ss += hv[0] * hv[0] + hv[1] * hv[1] + hv[2] * hv[2] + hv[3] * hv[3];
#pragma unroll
            for (int jx = 0; jx < 4; ++jx)
#pragma unroll
                for (int nb = 0; nb < 3; ++nb) acc[nb] = __builtin_amdgcn_mfma_f32_16x16x4f32(hv[jx], wv[nb][jx], acc[nb], 0, 0, 0);
        }
        settle(acc[0], acc[1]); settle(acc[2]);
        ss += shflx<16>(ss); ss += shflx<32>(ss);
        LAS float* lg = (LAS float*)(lds + w * 16384);
        if (fq == 0) lg[16 * 48 + fr] = ss;
#pragma unroll
        for (int nb = 0; nb < 3; ++nb)
#pragma unroll
            for (int j = 0; j < 4; ++j) lg[(4 * fq + j) * 48 + nb * 16 + fr] = acc[nb][j];
        __syncthreads();
        if (half == 0 && lane < 16) {
            const LAS float* q0 = lg + lane * 48; const LAS float* q1 = (const LAS float*)(lds + (w + 1) * 16384) + lane * 48;
            const long t = t0 + lane; const float rs = rsqrtf((lg[16 * 48 + lane] + ((const LAS float*)(lds + (w + 1) * 16384))[16 * 48 + lane]) * (1.f / D) + EPS);
            float gl[4]; int grp = 0; float gm = -3.4e38f;
#pragma unroll
            for (int i = 0; i < 4; ++i) { gl[i] = (q0[i] + q1[i]) * rs + p.in[I_GROUP_B][l * 4 + i]; if (gl[i] > gm) { gm = gl[i]; grp = i; } }
            float se = 0.f;
#pragma unroll
            for (int i = 0; i < 4; ++i) se += expf(gl[i] - gm);
            const float pg = 1.f / se;
            float v0 = -3.4e38f, v1 = -3.4e38f; int i0 = 0, i1 = 0;
#pragma unroll
            for (int i = 0; i < 8; ++i) { const float e = (q0[4 + grp * 8 + i] + q1[4 + grp * 8 + i]) * rs + p.in[I_EXPERT_B][l * 32 + grp * 8 + i];
                if (e > v0) { v1 = v0; i1 = i0; v0 = e; i0 = i; } else if (e > v1) { v1 = e; i1 = i; } }
            const float w0 = 1.f / (1.f + expf(v1 - v0)), w1 = 1.f - w0;
            const int e0 = grp * 8 + i0, e1 = grp * 8 + i1;
            int* cnt = p.cnt + l * 32;
            const int p0 = atomicAdd(cnt + e0, 1), p1 = atomicAdd(cnt + e1, 1);
            p.tok_list[e0 * T + p0] = (int)t; p.w_list[e0 * T + p0] = w0 * pg;
            p.tok_list[e1 * T + p1] = (int)t; p.w_list[e1 * T + p1] = w1 * pg;
            int* ti = p.tokinfo + t * 4; ti[0] = e0; ti[1] = p0; ti[2] = e1; ti[3] = p1;
            p.rstd_ffn[t] = rs;
        }
        __syncthreads();
    }
}

DI void moe_table(CP p, int l, LAS int* tab) {
    if (tidx() < 64) { const int lane = tidx(); const int c = lane < 32 ? p.cnt[l * 32 + lane] : 0; const int ntl = (c + 255) >> 8; int inc = ntl;
#pragma unroll
        for (int o = 1; o < 32; o <<= 1) { const int v = shfl_up_i(inc, o, lane); if ((lane & 31) >= o) inc += v; }
        if (lane < 32) { tab[lane] = inc - ntl; tab[64 + lane] = c; if (lane == 31) tab[32] = inc; } }
    __syncthreads();
}
DI void p8_moe_up(CP p, int l, LAS char* lds) {
    LAS int* tab = (LAS int*)(lds + 140 * 1024);
    moe_table(p, l, tab);
    const int ntiles = tab[32];
    unsigned aoff[2][2], boff[2];
#pragma unroll
    for (int i = 0; i < 2; ++i) { int R, C; g8::my_rc(i, R, C); boff[i] = (unsigned)(R * D + C) * 2u; }
    for (int u = bidx(); u < ntiles * 4; u += gdim()) {
        int tile, pn; if (!g8::unit_of(u, ntiles, 4, tile, pn)) break;
        const int e = __popcll(__ballot((tidx() & 63) < 32 && tab[tidx() & 31] <= tile)) - 1;
        const int mt = tile - tab[e], cnt_e = tab[64 + e];
        const int* tl = p.tok_list + e * T;
#pragma unroll
        for (int h = 0; h < 2; ++h)
#pragma unroll
            for (int i = 0; i < 2; ++i) { int R, C; g8::my_rc(i, R, C); const int pos = mt * 256 + h * 128 + R; const int tk = tl[pos < cnt_e ? pos : 0];
                aoff[h][i] = (unsigned)(((long)tk * D + C) * 2); }
        bf16_t* hid = p.hid; const float* rsf = p.rstd_ffn;
        g8::gemm_tile(lds, (const char*)p.xb, aoff, 128, (const char*)(p.WguT + l * LW_WGU + ((long)e * 1024 + pn * 256) * D), boff, 128L * D * 2, D / 64, [&](const Acc& acc, int rb, int cb) {
#pragma unroll
            for (int ai = 0; ai < 2; ++ai)
#pragma unroll
                for (int m = 0; m < 4; ++m) { const int r = ai * 128 + m * 16 + rb; const int pos = mt * 256 + r; const float rs = rsf[tl[pos < cnt_e ? pos : 0]];
#pragma unroll
                    for (int n = 0; n < 2; ++n) { const f32x4 gt = acc[ai][0][m][n] * rs, up = acc[ai][1][m][n] * rs;
                        u32x2 o; o.x = pk2h(siluf_(gt[0]) * up[0], siluf_(gt[1]) * up[1]); o.y = pk2h(siluf_(gt[2]) * up[2], siluf_(gt[3]) * up[3]);
                        *(u32x2*)(hid + ((long)tile * 256 + r) * DEXP + pn * 128 + n * 16 + cb) = o; } }
        });
    }
}
DI void p9_moe_down(CP p, int l, LAS char* lds) {
    LAS int* tab = (LAS int*)(lds + 140 * 1024);
    moe_table(p, l, tab);
    const int ntiles = tab[32];
    unsigned aoff[2][2], boff[2];
#pragma unroll
    for (int i = 0; i < 2; ++i) { int R, C; g8::my_rc(i, R, C); boff[i] = (unsigned)(R * DEXP + C) * 2u; aoff[0][i] = boff[i]; aoff[1][i] = (unsigned)((128 + R) * DEXP + C) * 2u; }
    for (int u = bidx(); u < ntiles * 8; u += gdim()) {
        int tile, pn; if (!g8::unit_of(u, ntiles, 8, tile, pn)) break;
        const int e = __popcll(__ballot((tidx() & 63) < 32 && tab[tidx() & 31] <= tile)) - 1;
        const int mt = tile - tab[e], cnt_e = tab[64 + e];
        bf16_t* yb = p.ybuf; const float* wl_ = p.w_list + e * T;
        g8::gemm_tile(lds, (const char*)(p.hid + (long)tile * 256 * DEXP), aoff, 128, (const char*)(p.WdT + l * LW_WD + ((long)e * D + pn * 256) * DEXP), boff, 128L * DEXP * 2, DEXP / 64, [&](const Acc& acc, int rb, int cb) {
#pragma unroll
            for (int ai = 0; ai < 2; ++ai)
#pragma unroll
                for (int m = 0; m < 4; ++m) { const int r = ai * 128 + m * 16 + rb; const int pos = mt * 256 + r; const float wt = pos < cnt_e ? wl_[pos] : 0.f;
#pragma unroll
                    for (int bj = 0; bj < 2; ++bj)
#pragma unroll
                        for (int n = 0; n < 2; ++n) { const f32x4 v = acc[ai][bj][m][n] * wt; u32x2 o; o.x = pk2h(v[0], v[1]); o.y = pk2h(v[2], v[3]);
                            *(u32x2*)(yb + ((long)tile * 256 + r) * D + pn * 256 + bj * 128 + n * 16 + cb) = o; } }
        });
    }
}
constexpr int NPH = 19;
#define XCD_BAR_WORDS 3456
#ifndef PH_EN
#define PH_EN 0xffffffffu
#endif
#define EN(i) ((PH_EN >> (i)) & 1u)
#ifndef REP_CV
#define REP_CV 1
#endif
#ifndef NCONV
#define NCONV 64
#endif
#ifndef MULTI_LAUNCH
#define MULTI_LAUNCH 0
#endif
typedef const __attribute__((address_space(4))) Params* CPP;
template <int PH>
DI void run_phase(LAS char* lds_) {
    unsigned lbase = (unsigned)(size_t)lds_; asm volatile("" : "+s"(lbase)); LAS char* lds = (LAS char*)(size_t)lbase;
    CPP pp = (CPP)__builtin_amdgcn_kernarg_segment_ptr();
    asm volatile("" : "+s"(pp));
    CP p = *pp;
    const int tid = tidx(), w = __builtin_amdgcn_readfirstlane(tid >> 6), G = gdim();
    LAS char* wl = lds + w * 16384;
    const int gw = bidx() * 8 + w, nw = G * 8;
    if constexpr (PH == 0 || PH == 9) {
        if (EN(0)) { if (PH == 0) { tconv_range(p, 0, 0, TCONV_EARLY, bidx(), G, lds); tconv_narrow(p, 0, bidx(), G, lds); } p0_tables(p, PH == 9 ? 1 : 0, lds); }
        if (PH == 0) p0_once(p);
        if (EN(1)) p1_rows(p, PH == 9 ? 1 : 0, 0, PH == 9 ? 1 : 0);
    } else if constexpr (PH == 18) {
        if (EN(1)) p1_rows(p, 2, 1, 0);
    } else {
        constexpr int l = PH >= 10 ? 1 : 0; constexpr int k = PH - (l ? 10 : 1);
        if constexpr (k == 0) { if (EN(2)) p2_inproj(p, l, lds); }
        else if constexpr (k == 1) {
#ifndef REP_A
#define REP_A 1
#define REP_B 1
#define REP_C 1
#define REP_D 1
#endif
            if (EN(3)) for (int rep = 0; rep < REP_A; ++rep) for (int u = bidx(); u < 32; u += G) nsa_cmp_unit(p, l, u, lds);
            if (EN(6)) for (int rep = 0; rep < REP_D; ++rep) { nsa_prep_elem(p, l); nsa_vtrans(p, wl); }
            LAS int* shp = (LAS int*)(lds + 156 * 1024);
            if (EN(4)) {
                for (;;) {
                    __syncthreads();
                    if (tid == 0) shp[0] = atomicAdd(p.cnt + 68 + l, 1);
                    __syncthreads();
                    const int it = shp[0];
                    if (it >= 1024 * REP_B) break;
                    gdn_prep_item(p, l, it & 1023, lds);
                }
            }
            if (EN(5)) for (;;) {
                __syncthreads();
                if (tid == 0) shp[0] = atomicAdd(p.cnt + 74 + l, 1);
                __syncthreads();
                const int base = shp[0];
                if (base >= 1024 * REP_C) break;
                s5_item(p, l, (base & 1023) * 8 + w, 1, wl);
            }
        } else if constexpr (k == 2) {
            if (EN(7)) if (bidx() < 16) gdn_chain(p, bidx(), lds);
            if (EN(0)) {
                const int cv0 = G >= 16 + NCONV ? 16 : 0, nb = G >= 16 + NCONV ? NCONV : G, bi = bidx() - cv0;
                if (bi >= 0 && bi < nb) {
                    tconv_range(p, l, TCONV_EARLY + (((T / 256) * (NPROJ / 256)) % G != 0 ? TCONV_TAIL : 0), TCONV_FULL, bi, nb, lds);
                    if (l == 0) { tconv_range(p, 1, 0, TCONV_EARLY, bi, nb, lds); tconv_narrow(p, 1, bi, nb, lds); }
                }
            }
            LAS int* sh = (LAS int*)(lds + 150 * 1024);
            __syncthreads();
#ifdef STATIC_ATT
#ifndef REP_ATT
#define REP_ATT 1
#endif
            if (EN(9)) for (int rep = 0; rep < REP_ATT; ++rep) for (int it = bidx(); it < 1024; it += G) { __syncthreads(); if (tid == 0) sh[0] = it; __syncthreads(); nsa_unit(p, l, sh[0], lds); }
#else
            const int q0 = (int)(__builtin_amdgcn_s_getreg((3 << 11) | 20) & 7u);
            for (int qq = 0; qq < 8; ++qq) { const int q = (q0 + qq) & 7;
                for (;;) {
                    __syncthreads();
                    if (tid == 0) sh[0] = atomicAdd(p.cnt + 96 + l * 8 + q, 1);
                    __syncthreads();
                    const int base = sh[0];
                    if (base >= 128) break;
                    if (EN(9)) nsa_unit(p, l, q * 128 + 127 - base, lds);
                } }
#endif
            for (;;) {
                __syncthreads();
                if (tid == 0) sh[0] = atomicAdd(p.cnt + 72 + l, 1);
                __syncthreads();
                const int base = sh[0];
                if (base >= 1024) break;
                if (EN(8)) s5_item(p, l, base * 8 + w, 2, wl);
            }
        } else if constexpr (k == 3) {
#ifndef REP_G
#define REP_G 1
#define REP_O 1
#endif
            if (EN(10)) for (int it = bidx(); it < 256 * REP_G; it += G) s5_glu_item(p, l, it & 255, lds);
            if (EN(11)) for (int it = bidx(); it < 1024 * REP_O; it += G) gdn_out_item(p, l, it & 1023, lds);
            if (EN(12)) nsa_outnorm(p, l);
        } else if constexpr (k == 4) { if (EN(13)) p6_outproj(p, l, lds); }
        else if constexpr (k == 5) { if (EN(14)) router_phase(p, l, lds); }
        else if constexpr (k == 6) { if (EN(15)) p8_moe_up(p, l, lds); }
        else { if (EN(16)) p9_moe_down(p, l, lds); }
    }
}
#if MULTI_LAUNCH
template <int PH>
__global__ void __launch_bounds__(512) phase_k(Params p_) {
    extern __shared__ __attribute__((aligned(16))) char smem_raw[];
    run_phase<PH>((LAS char*)smem_raw);
}
#ifndef DBG_STOP
#define DBG_STOP 99
#endif
#ifndef DBG_SRC
#define DBG_SRC 0
#endif
__global__ void dbg_copy(Params p) {
    const long n = (long)T * D;
    for (long i = (long)blockIdx.x * blockDim.x + threadIdx.x; i < n; i += (long)gridDim.x * blockDim.x) {
        const long t = i / D, c = i % D; float v;
        if (DBG_SRC == 0) v = p.h[i];
        else if (DBG_SRC == 1) v = bf2f(p.mix[i]);
        else if (DBG_SRC == 2) v = bf2f(p.proj[t * NPROJ + c]);
        else if (DBG_SRC == 3) v = bf2f(p.xb[i]);
        else if (DBG_SRC == 5) v = bf2f(p.proj[t * NPROJ + 2560 + c]);
        else if (DBG_SRC == 6) v = c < 512 ? bf2f(p.s5y[t * 512 + c]) : (c < 1536 ? bf2f(p.qn[t * 1024 + c - 512]) : bf2f(p.ksn[t * 256 + (c - 1536) % 256]));
        else if (DBG_SRC == 8) { const int* ti = p.tokinfo + t * 4; const int k = (int)(c & 3); v = k == 0 ? (float)ti[0] : k == 1 ? (float)ti[2] : k == 2 ? p.w_list[ti[0] * T + ti[1]] : p.w_list[ti[2] * T + ti[3]] + p.rstd_ffn[t]; }
        else if (DBG_SRC == 9) { const int* ti = p.tokinfo + t * 4; int ts0 = 0, ts1 = 0; for (int e = 0; e < 32; ++e) { const int nt_ = (p.cnt[e] + 255) >> 8; if (e < ti[0]) ts0 += nt_; if (e < ti[2]) ts1 += nt_; }
            const long s0 = (long)ts0 * 256 + ti[1], s1 = (long)ts1 * 256 + ti[3]; v = c < 1024 ? bf2f(p.hid[s0 * 512 + (c & 511)]) : bf2f(p.hid[s1 * 512 + (c & 511)]); }
        else if (DBG_SRC == 10) { const int* ti = p.tokinfo + t * 4; int ts0 = 0, ts1 = 0; for (int e = 0; e < 32; ++e) { const int nt_ = (p.cnt[e] + 255) >> 8; if (e < ti[0]) ts0 += nt_; if (e < ti[2]) ts1 += nt_; }
            const long s0 = (long)ts0 * 256 + ti[1], s1 = (long)ts1 * 256 + ti[3]; v = bf2f(p.ybuf[s0 * D + c]) + 3.f * bf2f(p.ybuf[s1 * D + c]); }
        else if (DBG_SRC == 13) v = p.small[t * NSMALL + (c % 56)];
        else if (DBG_SRC == 14) v = ((const float*)p.s5E)[i % (4L * 64 * 32 * 64 * 2)] - ((const float*)p.gRT)[i % (4L * 64 * 32 * 64 * 2)];
        else if (DBG_SRC == 11) v = ((const float*)p.s5E)[i % (4L * 64 * 32 * 64 * 2)];
        else if (DBG_SRC == 12) v = c < 1024 ? ((const float*)p.s5lam)[(t * 1024 + c) % 8192] : bf2f(((c & 1) ? p.s5Bt : p.s5Ct)[(t * 1024 + c) % 65536]);
        else v = 0.f;
#ifdef DBG_AMP
        v = v * DBG_AMP; v = v - floorf(v);
#endif
#ifdef DBG_C0
        if (c < DBG_C0 || c >= DBG_C1) v = 0.f;
#endif
        p.out[i] = v;
    }
}
template <int PH> static void launch_phases(const Params& p, int grid, hipStream_t stream) {
    if constexpr (PH < NPH && PH <= DBG_STOP) {
#ifdef REP_PH
        for (int rep = 0; rep < (PH == REP_PH ? REP_N : 0); ++rep) { hipLaunchKernelGGL(phase_k<PH>, dim3(grid), dim3(512), LDS_BYTES, stream, p); (void)hipMemsetAsync(p.cnt + 64, 0, 192 * 4, stream); }
#endif
        hipLaunchKernelGGL(phase_k<PH>, dim3(grid), dim3(512), LDS_BYTES, stream, p); launch_phases<PH + 1>(p, grid, stream); }
    else if constexpr (PH < NPH && DBG_SRC != 7) hipLaunchKernelGGL(dbg_copy, dim3(1024), dim3(256), 0, stream, p);
}
template <int PH> static bool set_attr() {
    if constexpr (PH < NPH) { if (hipFuncSetAttribute((const void*)phase_k<PH>, hipFuncAttributeMaxDynamicSharedMemorySize, LDS_BYTES) != hipSuccess) return false; return set_attr<PH + 1>(); }
    return true;
}
#else
#define XB_TMO      128
#define XB_XCNT(j)  (256  + 64 * (j))
#define XB_XSUB(j)  (1280 + 64 * (j))
#define XB_XGEN(j)  (2304 + 64 * (j))
#define XB_TOP      3328
#define XB_TOPGEN   3392
#define XB_SPIN_CAP (1u << 22)
DI unsigned xb_ld(unsigned* q) { return __hip_atomic_load(q, __ATOMIC_RELAXED, __HIP_MEMORY_SCOPE_AGENT); }
DI unsigned xb_add(unsigned* q, unsigned v) { return __hip_atomic_fetch_add(q, v, __ATOMIC_RELAXED, __HIP_MEMORY_SCOPE_AGENT); }
DI unsigned xb_xcc_id() { return (unsigned)__builtin_amdgcn_s_getreg((3 << 11) | 20) & 0xFu; }
#define XB_SPIN(cond, bar) do { unsigned _sp = 0; while (cond) { __builtin_amdgcn_s_sleep(1); \
    if ((++_sp & 255u) == 0u) { if (xb_ld(&(bar)[XB_TMO])) break; if (_sp > XB_SPIN_CAP) { atomicAdd(&(bar)[XB_TMO], 1u); break; } } } } while (0)
DI void xcd_post() {
    CPP pp = (CPP)__builtin_amdgcn_kernarg_segment_ptr(); asm volatile("" : "+s"(pp));
    if (tidx() == 0) (void)xb_add(&pp->err[XB_XCNT(xb_xcc_id())], 1u);
}
DI void grid_barrier(LAS char* lds_) {
    unsigned lbase = (unsigned)(size_t)lds_; asm volatile("" : "+s"(lbase));
    volatile LAS unsigned* st = (volatile LAS unsigned*)(size_t)(lbase + 159 * 1024);
    CPP pp = (CPP)__builtin_amdgcn_kernarg_segment_ptr(); asm volatile("" : "+s"(pp));
    unsigned* bar = pp->err;
    asm volatile("s_waitcnt vmcnt(0)" ::: "memory");
    __syncthreads();
    if (tidx() == 0) {
        __builtin_amdgcn_s_waitcnt(0);
        const unsigned x = xb_xcc_id();
        unsigned nloc = st[0], nx = st[1];
        if (nloc == 0u) {
            const unsigned G = (unsigned)gdim(); unsigned sum, cnt, mine, sp = 0u;
            for (;;) { sum = 0u; cnt = 0u; mine = 0u;
#pragma unroll
                for (unsigned j = 0; j < 16; ++j) { const unsigned c = xb_ld(&bar[XB_XCNT(j)]); sum += c; cnt += (c > 0u) ? 1u : 0u; mine = (j == x) ? c : mine; }
                if (sum == G) break;
                __builtin_amdgcn_s_sleep(1);
                if ((++sp & 255u) == 0u) { if (xb_ld(&bar[XB_TMO])) break; if (sp > XB_SPIN_CAP) { atomicAdd(&bar[XB_TMO], 1u); break; } } }
            nloc = mine > 0u ? mine : 1u; nx = cnt > 0u ? cnt : 1u; st[0] = nloc; st[1] = nx; }
        const unsigned old = xb_add(&bar[XB_XSUB(x)], 1u);
        const unsigned gen = old / nloc;
        if (old + 1u == (gen + 1u) * nloc) {
            __builtin_amdgcn_fence(__ATOMIC_RELEASE, "agent");
            asm volatile("s_waitcnt vmcnt(0)" ::: "memory");
            const unsigned og = xb_add(&bar[XB_TOP], 1u);
            const unsigned tg = og / nx;
            if (og + 1u == (tg + 1u) * nx) xb_add(&bar[XB_TOPGEN], 1u);
            else XB_SPIN(xb_ld(&bar[XB_TOPGEN]) == tg, bar);
            __builtin_amdgcn_fence(__ATOMIC_ACQUIRE, "agent");
            xb_add(&bar[XB_XGEN(x)], 1u);
            asm volatile("s_waitcnt vmcnt(0)" ::: "memory");
        } else {
            XB_SPIN(xb_ld(&bar[XB_XGEN(x)]) == gen, bar);
            __builtin_amdgcn_fence(__ATOMIC_ACQUIRE, "agent");
            asm volatile("s_waitcnt vmcnt(0)" ::: "memory");
        }
    }
    __syncthreads();
}
template <int PH>
DI void run_from(LAS char* lds) {
    if constexpr (PH < NPH) { run_phase<PH>(lds); if constexpr (PH + 1 < NPH) grid_barrier(lds); run_from<PH + 1>(lds); }
}
__global__ void __launch_bounds__(512) mega(Params p_) {
    extern __shared__ __attribute__((aligned(16))) char smem_raw[];
    if (tidx() < 2) ((LAS unsigned*)(smem_raw + 159 * 1024))[tidx()] = 0u;
    xcd_post();
    cg::this_grid().sync();
    run_from<0>((LAS char*)smem_raw);
}
#endif

extern "C" void kernel_launch(void* const* d_in, const int* in_sizes, int n_in, void* d_out, int out_size, void* d_ws, size_t ws_size, hipStream_t stream) {
    static int grid = 0;
    if (grid == 0) {
        int dev = 0, cus = 0, per_cu = 0;
        (void)hipGetDevice(&dev); (void)hipDeviceGetAttribute(&cus, hipDeviceAttributeMultiprocessorCount, dev);
#if MULTI_LAUNCH
        if (!set_attr<0>()) { fprintf(stderr, "kernel_launch: hipFuncSetAttribute failed\n"); grid = -1; return; }
        per_cu = 1;
#else
        if (hipFuncSetAttribute((const void*)mega, hipFuncAttributeMaxDynamicSharedMemorySize, LDS_BYTES) != hipSuccess) { fprintf(stderr, "kernel_launch: hipFuncSetAttribute failed\n"); grid = -1; return; }
        if (hipOccupancyMaxActiveBlocksPerMultiprocessor(&per_cu, (const void*)mega, 512, LDS_BYTES) != hipSuccess || per_cu < 1) { fprintf(stderr, "kernel_launch: occupancy query says %d blocks/CU\n", per_cu); per_cu = 1; }
        (void)hipGetLastError();
#endif
        grid = cus;
        if (n_in != 33 || out_size != T * D) { fprintf(stderr, "kernel_launch: unexpected problem shape\n"); grid = -1; return; }
    }
    if (grid < 0) return;
    Params p{};
    for (int i = 0; i < 33; ++i) p.in[i] = (const float*)d_in[i];
    p.out = (float*)d_out;
    size_t off = 0;
    auto take = [&](size_t bytes) { void* r = (char*)d_ws + off; off += (bytes + 255) & ~(size_t)255; return r; };
    p.WinT = (bf16_t*)take(2 * LW_WIN * 2); p.WoutT = (bf16_t*)take(2 * LW_WOUT * 2); p.gluT = (bf16_t*)take(2 * LW_GLU * 2);
    p.w1T = (bf16_t*)take(2 * LW_W1 * 2); p.w2T = (bf16_t*)take(2 * LW_W2 * 2);
    p.WguT = (bf16_t*)take(2 * LW_WGU * 2); p.WdT = (bf16_t*)take(2 * LW_WD * 2); p.Wr = (float*)take(48 * D * 4);
    p.s5Bt = (bf16_t*)take(32 * 128 * 32 * 2); p.s5Ct = (bf16_t*)take(32 * 16 * 128 * 2); p.s5lam = (f32x2*)take(2 * 2048 * 8); p.bias1 = (float*)take(512 * 4);
    p.rope = (f32x2*)take(4096 * 32 * 8);
    p.xb = (bf16_t*)take((size_t)T * D * 2); p.rstd_mix = (float*)take(T * 4); p.rstd_ffn = (float*)take(T * 4);
    p.h = p.out;        p.proj = (bf16_t*)take((size_t)T * NPROJ * 2); p.small = (float*)take((size_t)T * NSMALL * 4);
    p.mix = (bf16_t*)take((size_t)T * D * 2); p.s5y = (bf16_t*)take((size_t)T * 512 * 2); p.s5E = (f32x2*)take((size_t)4 * 64 * 32 * 64 * 8);
    p.qn = (bf16_t*)take((size_t)T * 1024 * 2); p.ksn = (bf16_t*)take((size_t)T * 256 * 2); p.kwn = (bf16_t*)take((size_t)T * 256 * 2);
    p.vsT = (bf16_t*)take((size_t)T * 256 * 2); p.vwT = (bf16_t*)take((size_t)T * 256 * 2);
    p.kcmp = (bf16_t*)take(16 * 256 * 64 * 2); p.vcmpT = (bf16_t*)take(16 * 64 * 256 * 2);
    p.gP = (bf16_t*)take((size_t)1024 * 16384 * 2); p.gRT = (float*)take((size_t)1024 * 16384 * 4); p.gQp = (bf16_t*)take((size_t)1024 * 8192 * 2);
    p.gOU = (float*)take((size_t)1024 * 8192 * 4); p.gST = (bf16_t*)take((size_t)1024 * 16384 * 2); p.gA = (float*)take(1024 * 4);
    p.tok_list = (int*)take((size_t)NEXP * T * 4); p.w_list = (float*)take((size_t)NEXP * T * 4); p.tokinfo = (int*)take((size_t)T * 16);
    p.cnt = (int*)take(256 * 4); p.err = (unsigned*)take(XCD_BAR_WORDS * 4);
    p.hid = (bf16_t*)p.gRT;
    p.ybuf = p.proj;
    if (hipMemsetAsync(p.cnt, 0, 256 * 4 + XCD_BAR_WORDS * 4, stream) != hipSuccess) { fprintf(stderr, "kernel_launch: memset failed\n"); return; }
    if (off > ws_size) { fprintf(stderr, "kernel_launch: workspace too small: need %zu have %zu\n", off, ws_size); return; }
#if MULTI_LAUNCH
    launch_phases<0>(p, grid, stream);
#else
    void* args[] = {&p};
    hipError_t e = hipLaunchCooperativeKernel((const void*)mega, dim3(grid), dim3(512), args, LDS_BYTES, stream);
    if (e != hipSuccess) fprintf(stderr, "kernel_launch: cooperative launch failed: %s (grid %d)\n", hipGetErrorString(e), grid);
#endif
}
```

```cpp
#include <hip/hip_runtime.h>
#include <hip/hip_cooperative_groups.h>
#include <cstdio>
#include <cstdint>
namespace cg = cooperative_groups;

#define DI __device__ __forceinline__
extern "C" __device__ size_t __ockl_get_num_groups(unsigned);
#define LAS __attribute__((address_space(3)))
typedef unsigned short bf16_t;
typedef short bf16x8 __attribute__((ext_vector_type(8)));
typedef short s16x4 __attribute__((ext_vector_type(4)));
typedef float f32x4 __attribute__((ext_vector_type(4)));
typedef float f32x2 __attribute__((ext_vector_type(2)));
typedef float f32x16 __attribute__((ext_vector_type(16)));
typedef unsigned u32x4 __attribute__((ext_vector_type(4)));
typedef unsigned u32x2 __attribute__((ext_vector_type(2)));

constexpr int D = 2048, BATCH = 4, SEQ = 4096, T = BATCH * SEQ, DEPTH = 2;
constexpr int DIN = 5176, NPROJ = 5120, NPAD = 5376, NSMALL = 64;
constexpr int C_U = 0, C_QKV = 512, C_Z = 2048, C_NQ = 2560, C_NKV = 3584;
constexpr int NEXP = 32, DEXP = 512;
constexpr int MOE_TILES_MAX = 160;
constexpr int NCHUNK = 64;
constexpr int LDS_BYTES = 160 * 1024;
constexpr float EPS = 1e-6f;

struct Params {
    const float* in[33];
    float* out;
    bf16_t* WinT; bf16_t* WoutT; bf16_t* gluT; bf16_t* w1T; bf16_t* w2T; bf16_t* WguT; bf16_t* WdT; float* Wr;
    bf16_t* s5Bt; bf16_t* s5Ct; f32x2* s5lam; float* bias1; f32x2* rope;
    bf16_t* xb; float* rstd_mix; float* rstd_ffn; float* h; bf16_t* proj; float* small; bf16_t* mix;
    bf16_t* s5y; f32x2* s5E;
    bf16_t* qn; bf16_t* ksn; bf16_t* kwn; bf16_t* vsT; bf16_t* vwT; bf16_t* kcmp; bf16_t* vcmpT;
    bf16_t* gP; float* gRT; bf16_t* gQp; float* gOU; bf16_t* gST; float* gA;
    int* tok_list; float* w_list; int* tokinfo; int* cnt; bf16_t* hid; bf16_t* ybuf;
    unsigned* err;
};

typedef const __attribute__((address_space(4))) Params& CP;
enum { I_X = 0, I_LN_MIX, I_W_IN, I_LAM_RE, I_LAM_IM, I_B_RE, I_B_IM, I_C_RE, I_C_IM, I_S5D, I_S5LOGDT, I_GLU_W, I_GLU_B,
       I_S5NORM, I_CONV_W, I_A_LOG, I_DT_BIAS, I_GDN_NORM, I_QNORM, I_KNORM, I_CMP_PE, I_CMP_W1, I_CMP_W2, I_NSA_NORM,
       I_W_OUT, I_LN_FFN, I_GROUP_W, I_GROUP_B, I_EXPERT_W, I_EXPERT_B, I_W_GATE, I_W_UP, I_W_DOWN };

DI bf16_t f2bf(float x) { unsigned r; asm("v_cvt_pk_bf16_f32 %0, %1, %1" : "=v"(r) : "v"(x)); return (bf16_t)r; }
DI float bf2f(bf16_t x) { return __uint_as_float(((unsigned)x) << 16); }
DI unsigned pk2(float lo, float hi) { unsigned r; asm("v_cvt_pk_bf16_f32 %0, %1, %2" : "=v"(r) : "v"(lo), "v"(hi)); return r; }
DI unsigned pk2h(float lo, float hi) { unsigned r; asm("v_cvt_pk_bf16_f32 %0, %1, %2" : "=v"(r) : "v"(lo), "v"(hi)); return r; }
DI float sigmoidf_(float x) { return __builtin_amdgcn_rcpf(1.f + __expf(-x)); }
DI float siluf_(float x) { return x * __builtin_amdgcn_rcpf(1.f + __expf(-x)); }
DI float gelu_tanh(float x) { const float u = 0.7978845608028654f * (x + 0.044715f * x * x * x); const float e = __expf(2.f * u); const float th = 1.f - 2.f * __builtin_amdgcn_rcpf(e + 1.f); return 0.5f * x * (1.f + th); }
DI float softplusf_(float x) { return x > 20.f ? x : log1pf(__expf(x)); }
DI int my_lane() { int l = (int)__builtin_amdgcn_mbcnt_hi(~0u, __builtin_amdgcn_mbcnt_lo(~0u, 0u)); asm volatile("" : "+v"(l)); return l; }
template <int M> DI float shflx(float v) {
    if constexpr (M < 32) return __builtin_bit_cast(float, __builtin_amdgcn_ds_swizzle(__builtin_bit_cast(int, v), 0x1f | (M << 10)));
    else return __builtin_bit_cast(float, __builtin_amdgcn_ds_bpermute((my_lane() ^ M) << 2, __builtin_bit_cast(int, v)));
}
DI int shfl_up_i(int v, int o, int lane) { return __builtin_amdgcn_ds_bpermute(((lane - o) & 63) << 2, v); }
DI float shfl_up_f(float v, int o, int lane) { return __builtin_bit_cast(float, __builtin_amdgcn_ds_bpermute(((lane - o) & 63) << 2, __builtin_bit_cast(int, v))); }
DI int shfl_idx_i(int v, int src) { return __builtin_amdgcn_ds_bpermute(src << 2, v); }
DI float wave_sum(float v) {
    v += shflx<1>(v); v += shflx<2>(v); v += shflx<4>(v); v += shflx<8>(v); v += shflx<16>(v); v += shflx<32>(v);
    return v;
}
DI int tidx() { int t = __builtin_amdgcn_workitem_id_x(); asm volatile("" : "+v"(t)); return t; }
DI int bidx() { int b = __builtin_amdgcn_workgroup_id_x(); asm volatile("" : "+s"(b)); return b; }
DI int gdim() { int g = (int)__ockl_get_num_groups(0); asm volatile("" : "+s"(g)); return g; }
DI void lds_wait() { asm volatile("s_waitcnt lgkmcnt(0)" ::: "memory"); }
#define SETTLE_NOPS "s_nop 15\n\ts_nop 15"
DI void settle(f32x4& a) { asm volatile(SETTLE_NOPS : "+v"(a)); }
DI void settle(f32x4& a, f32x4& b) { asm volatile(SETTLE_NOPS : "+v"(a), "+v"(b)); }
DI void settle(f32x4& a, f32x4& b, f32x4& c, f32x4& d) { asm volatile(SETTLE_NOPS : "+v"(a), "+v"(b), "+v"(c), "+v"(d)); }
DI void settle(f32x4& a, f32x4& b, f32x4& c, f32x4& d, f32x4& e, f32x4& f, f32x4& g, f32x4& h) { asm volatile(SETTLE_NOPS : "+v"(a), "+v"(b), "+v"(c), "+v"(d), "+v"(e), "+v"(f), "+v"(g), "+v"(h)); }
DI void settle(f32x16& a) { asm volatile(SETTLE_NOPS : "+v"(a)); }
DI void settle(f32x16& a, f32x16& b) { asm volatile(SETTLE_NOPS : "+v"(a), "+v"(b)); }
#define MFMA16(a, b, c) __builtin_amdgcn_mfma_f32_16x16x32_bf16((a), (b), (c), 0, 0, 0)
#define MFMA32(a, b, c) __builtin_amdgcn_mfma_f32_32x32x16_bf16((a), (b), (c), 0, 0, 0)

namespace g8 {
constexpr int BM = 256, BK = 64, HALF = 128, HT = HALF * BK;
DI int lds_byte(int r, int c) { int st = (r >> 4) * 2 + (c >> 5), rr = r & 15, cc = c & 31, ob = rr * 64 + cc * 2; return st * 1024 + (ob ^ (((ob >> 9) & 1) << 5)); }
DI void stage_rc(int b, int& R, int& C) { int st = b / 1024, sb = b % 1024, swz = sb ^ (((sb >> 9) & 1) << 5); R = (st >> 1) * 16 + swz / 64; C = (st & 1) * 32 + (swz % 64) / 2; }

template <class Epi>
DI void gemm_tile(LAS char* lds, const char* aBase, const unsigned (&aoff)[2][2], long akt, const char* bBase, const unsigned (&boff)[2], long bhalf, int nt, Epi&& epi) {
    const int tid = tidx(), wid = __builtin_amdgcn_readfirstlane(tid >> 6), lane = tid & 63, wr = wid >> 2, wc = wid & 3, fr = lane & 15, fq = lane >> 4;
    const unsigned ldsw = (unsigned)wid * 1024u;
    const int lrA = lds_byte(wr * 64 + fr, fq * 8), lrB = lds_byte(wc * 32 + fr, fq * 8);
#define G8_SA(b, h) (((b) * 2 + (h)) * (HT * 2))
#define G8_SB(b, h) ((4 + (b) * 2 + (h)) * (HT * 2))
#define G8_STAGE_A(bufoff, h, kt) do { const char* _b = aBase + (long)(kt) * akt; _Pragma("unroll") for (int _i = 0; _i < 2; ++_i) \
        __builtin_amdgcn_global_load_lds((const unsigned*)(_b + aoff[h][_i]), (LAS unsigned*)(lds + (bufoff) + ldsw + _i * 8192), 16, 0, 0); } while (0)
#define G8_STAGE_B(bufoff, h, kt) do { const char* _b = bBase + (long)(h) * bhalf + (long)(kt) * 128; _Pragma("unroll") for (int _i = 0; _i < 2; ++_i) \
        __builtin_amdgcn_global_load_lds((const unsigned*)(_b + boff[_i]), (LAS unsigned*)(lds + (bufoff) + ldsw + _i * 8192), 16, 0, 0); } while (0)
#define G8_LDA(dst, b, h) do { _Pragma("unroll") for (int m = 0; m < 4; ++m) _Pragma("unroll") for (int k = 0; k < 2; ++k) dst[m][k] = *(const LAS bf16x8*)(lds + G8_SA(b, h) + lrA + m * 2048 + k * 1024); } while (0)
#define G8_LDB(dst, b, h) do { _Pragma("unroll") for (int n = 0; n < 2; ++n) _Pragma("unroll") for (int k = 0; k < 2; ++k) dst[n][k] = *(const LAS bf16x8*)(lds + G8_SB(b, h) + lrB + n * 2048 + k * 1024); } while (0)
#define G8_MMA(ai, bj, At, Bt) do { __builtin_amdgcn_s_setprio(1); _Pragma("unroll") for (int m = 0; m < 4; ++m) _Pragma("unroll") for (int n = 0; n < 2; ++n) _Pragma("unroll") for (int k = 0; k < 2; ++k) \
        acc[ai][bj][m][n] = MFMA16(Bt[n][k], At[m][k], acc[ai][bj][m][n]); __builtin_amdgcn_s_setprio(0); } while (0)
#define G8_WAIT_V(n) asm volatile("s_waitcnt vmcnt(" #n ")" ::: "memory")
#define G8_WAIT_L(n) asm volatile("s_waitcnt lgkmcnt(" #n ")" ::: "memory")
#define G8_BAR __builtin_amdgcn_s_barrier()
#define G8_SCHED __builtin_amdgcn_sched_barrier(0)
    f32x4 acc[2][2][4][2];
#pragma unroll
    for (int a = 0; a < 2; ++a)
#pragma unroll
        for (int b = 0; b < 2; ++b)
#pragma unroll
            for (int m = 0; m < 4; ++m)
#pragma unroll
                for (int n = 0; n < 2; ++n) acc[a][b][m][n] = (f32x4){0.f, 0.f, 0.f, 0.f};
    bf16x8 At[4][2], B0[2][2], B1[2][2];
    G8_STAGE_B(G8_SB(0, 0), 0, 0); G8_STAGE_A(G8_SA(0, 0), 0, 0); G8_STAGE_B(G8_SB(0, 1), 1, 0); G8_STAGE_A(G8_SA(0, 1), 1, 0);
    if (wr == 1) G8_BAR;
    G8_WAIT_V(4); G8_BAR;
    G8_STAGE_B(G8_SB(1, 0), 0, 1); G8_STAGE_A(G8_SA(1, 0), 0, 1); G8_STAGE_B(G8_SB(1, 1), 1, 1);
    G8_WAIT_V(6); G8_BAR;
    for (int t = 0; t < nt - 2; t += 2) {
        G8_LDB(B0, 0, 0); G8_SCHED; G8_LDA(At, 0, 0); G8_STAGE_A(G8_SA(1, 1), 1, t + 1);
        G8_WAIT_L(8); G8_BAR; G8_WAIT_L(0); G8_MMA(0, 0, At, B0); G8_BAR; G8_SCHED;
        G8_LDB(B1, 0, 1); G8_STAGE_B(G8_SB(0, 0), 0, t + 2);
        G8_BAR; G8_WAIT_L(0); G8_MMA(0, 1, At, B1); G8_BAR;
        G8_LDA(At, 0, 1); G8_STAGE_A(G8_SA(0, 0), 0, t + 2);
        G8_BAR; G8_WAIT_L(0); G8_MMA(1, 0, At, B0); G8_BAR; G8_SCHED;
        G8_STAGE_B(G8_SB(0, 1), 1, t + 2);
        G8_WAIT_V(6); G8_BAR; G8_MMA(1, 1, At, B1); G8_BAR;
        G8_LDB(B0, 1, 0); G8_SCHED; G8_LDA(At, 1, 0); G8_STAGE_A(G8_SA(0, 1), 1, t + 2);
        G8_WAIT_L(8); G8_BAR; G8_WAIT_L(0); G8_MMA(0, 0, At, B0); G8_BAR; G8_SCHED;
        G8_LDB(B1, 1, 1); G8_STAGE_B(G8_SB(1, 0), 0, t + 3);
        G8_BAR; G8_WAIT_L(0); G8_MMA(0, 1, At, B1); G8_BAR;
        G8_LDA(At, 1, 1); G8_STAGE_A(G8_SA(1, 0), 0, t + 3);
        G8_BAR; G8_WAIT_L(0); G8_MMA(1, 0, At, B0); G8_BAR; G8_SCHED;
        G8_STAGE_B(G8_SB(1, 1), 1, t + 3);
        G8_WAIT_V(6); G8_BAR; G8_MMA(1, 1, At, B1); G8_BAR;
    }
    { G8_LDB(B0, 0, 0); G8_LDA(At, 0, 0); G8_STAGE_A(G8_SA(1, 1), 1, nt - 1);
      G8_BAR; G8_WAIT_L(0); G8_MMA(0, 0, At, B0); G8_BAR;
      G8_LDB(B1, 0, 1); G8_BAR; G8_WAIT_L(0); G8_MMA(0, 1, At, B1); G8_BAR;
      G8_LDA(At, 0, 1); G8_WAIT_V(4); G8_BAR; G8_WAIT_L(0); G8_MMA(1, 0, At, B0); G8_MMA(1, 1, At, B1); G8_BAR; }
    { G8_LDB(B0, 1, 0); G8_LDA(At, 1, 0); G8_WAIT_V(2); G8_BAR; G8_WAIT_L(0); G8_MMA(0, 0, At, B0); G8_BAR;
      G8_LDB(B1, 1, 1); G8_WAIT_V(0); G8_BAR; G8_WAIT_L(0); G8_MMA(0, 1, At, B1); G8_BAR;
      G8_LDA(At, 1, 1); G8_BAR; G8_WAIT_L(0); G8_MMA(1, 0, At, B0); G8_MMA(1, 1, At, B1); G8_BAR; }
    if (wr == 0) G8_BAR;
    asm volatile(SETTLE_NOPS : "+v"(acc[0][0][0][0]), "+v"(acc[0][0][0][1]), "+v"(acc[0][0][1][0]), "+v"(acc[0][0][1][1]), "+v"(acc[0][0][2][0]), "+v"(acc[0][0][2][1]), "+v"(acc[0][0][3][0]), "+v"(acc[0][0][3][1]),
                 "+v"(acc[0][1][0][0]), "+v"(acc[0][1][0][1]), "+v"(acc[0][1][1][0]), "+v"(acc[0][1][1][1]), "+v"(acc[0][1][2][0]), "+v"(acc[0][1][2][1]), "+v"(acc[0][1][3][0]), "+v"(acc[0][1][3][1]));
    asm volatile("" : "+v"(acc[1][0][0][0]), "+v"(acc[1][0][0][1]), "+v"(acc[1][0][1][0]), "+v"(acc[1][0][1][1]), "+v"(acc[1][0][2][0]), "+v"(acc[1][0][2][1]), "+v"(acc[1][0][3][0]), "+v"(acc[1][0][3][1]),
                 "+v"(acc[1][1][0][0]), "+v"(acc[1][1][0][1]), "+v"(acc[1][1][1][0]), "+v"(acc[1][1][1][1]), "+v"(acc[1][1][2][0]), "+v"(acc[1][1][2][1]), "+v"(acc[1][1][3][0]), "+v"(acc[1][1][3][1]));
    epi(acc, wr * 64 + fr, wc * 32 + 4 * fq);
#undef G8_SA
#undef G8_SB
#undef G8_STAGE_A
#undef G8_STAGE_B
#undef G8_LDA
#undef G8_LDB
#undef G8_MMA
}
DI void my_rc(int i, int& R, int& C) { stage_rc(tidx() * 16 + i * 8192, R, C); }
DI bool unit_of(int L, int nM, int nN, int& pm, int& pn) {
    const int nwg = nM * nN; if (L >= nwg) return false;
    int wgid = L; { const int q = nwg / 8, r = nwg % 8, xcd = wgid % 8, off = wgid / 8; wgid = (xcd < r ? xcd * (q + 1) : r * (q + 1) + (xcd - r) * q) + off; }
    const int nig = 8 * nN, gid = wgid / nig, fm = gid * 8, gsz = (nM - fm) < 8 ? (nM - fm) : 8;
    pm = fm + ((wgid % nig) % gsz); pn = (wgid % nig) / gsz; return true;
}
}

typedef f32x4 Acc[2][2][4][2];
#define ACC_FOR(ai, m, bj, n) _Pragma("unroll") for (int ai = 0; ai < 2; ++ai) _Pragma("unroll") for (int m = 0; m < 4; ++m) _Pragma("unroll") for (int bj = 0; bj < 2; ++bj) _Pragma("unroll") for (int n = 0; n < 2; ++n)

DI bf16x8 ld8(const bf16_t* q) { return *(const bf16x8*)q; }
DI bf16x8 ld8(const LAS bf16_t* q) { return *(const LAS bf16x8*)q; }
template <int KS, class PA, class PB>
DI f32x4 mma_tile(PA arow, PB brow, f32x4 acc) {
#pragma unroll
    for (int ks = 0; ks < KS; ++ks) acc = MFMA16(ld8(arow + ks * 32), ld8(brow + ks * 32), acc);
    settle(acc);
    return acc;
}
#define ZERO4 ((f32x4){0.f, 0.f, 0.f, 0.f})

constexpr long LW_WIN = (long)NPAD * D, LW_WOUT = (long)D * D, LW_GLU = 512L * 512, LW_W1 = 2L * 256 * 2048, LW_W2 = 2L * 64 * 256, LW_WGU = (long)NEXP * 1024 * D, LW_WD = (long)NEXP * D * DEXP;
struct TDesc { const float* src; bf16_t* dst; int src_ld, dst_ld, nvalid, gu  , which, ntl; };
#ifndef TCONV_TAIL
#define TCONV_TAIL 2560
#endif
constexpr int TCONV_EARLY = 320 + 320 + 64, TCONV_FULL = TCONV_EARLY + 256 + 16 + 4096 + 2048, TCONV_TILES = TCONV_FULL + 72;
struct TBase { const float *win, *wout, *glu, *w1, *w2, *gate, *up, *down; bf16_t *WinT, *WoutT, *gluT, *w1T, *w2T, *WguT, *WdT; };
DI void tconv_base(CP p, int l, TBase& b) {
    b.win = p.in[I_W_IN] + (long)l * D * DIN; b.wout = p.in[I_W_OUT] + (long)l * D * D; b.glu = p.in[I_GLU_W] + (long)l * 512 * 512;
    b.w1 = p.in[I_CMP_W1] + (long)l * 2 * 2048 * 256; b.w2 = p.in[I_CMP_W2] + (long)l * 2 * 256 * 64;
    b.gate = p.in[I_W_GATE] + (long)l * NEXP * D * DEXP; b.up = p.in[I_W_UP] + (long)l * NEXP * D * DEXP; b.down = p.in[I_W_DOWN] + (long)l * NEXP * DEXP * D;
    b.WinT = p.WinT + l * LW_WIN; b.WoutT = p.WoutT + l * LW_WOUT; b.gluT = p.gluT + l * LW_GLU; b.w1T = p.w1T + l * LW_W1; b.w2T = p.w2T + l * LW_W2; b.WguT = p.WguT + l * LW_WGU; b.WdT = p.WdT + l * LW_WD;
}
DI void tconv_desc(const TBase& b, int idx, TDesc& d) {
    auto lin = [&](const float* src, int src_ld, bf16_t* dst, int dst_ld, int K, int N, int t) {
        const int nkt = K / 64, kt = t % nkt, ntl = t / nkt;
        d.src = src + (long)kt * 64 * src_ld + ntl * 256; d.src_ld = src_ld; d.nvalid = min(256, N - ntl * 256);
        d.dst = dst + (long)ntl * 256 * dst_ld + kt * 64; d.dst_ld = dst_ld; d.gu = 0; d.which = 0; d.ntl = ntl; };
    int t = idx;
    if (t < 320) { lin(b.win, DIN, b.WinT, D, D, 2560, t); return; } t -= 320;
    if (t < 320) { lin(b.win + 2568, DIN, b.WinT + 2560L * D, D, D, 2560, t); return; } t -= 320;
    if (t < 64) { const int kv = t >> 5; lin(b.w1 + (long)kv * 2048 * 256, 256, b.w1T + (long)kv * 256 * 2048, 2048, 2048, 256, t & 31); return; } t -= 64;
    if (t < 256) { lin(b.wout, D, b.WoutT, D, D, D, t); return; } t -= 256;
    if (t < 16) { lin(b.glu, 512, b.gluT, 512, 512, 512, t); return; } t -= 16;
    if (t < 4096) { const int e = t >> 7, which = (t >> 6) & 1, r = t & 63, kt = r & 31, ntl = r >> 5;
        d.src = (which ? b.up : b.gate) + (long)e * D * DEXP + (long)kt * 64 * DEXP + ntl * 256; d.src_ld = DEXP; d.nvalid = 256;
        d.dst = b.WguT + (long)e * 1024 * D + kt * 64; d.dst_ld = D; d.gu = 1; d.which = which; d.ntl = ntl; return; } t -= 4096;
    if (t < 2048) { const int e = t >> 6, r = t & 63; lin(b.down + (long)e * DEXP * D, D, b.WdT + (long)e * D * DEXP, DEXP, DEXP, D, r); return; } t -= 2048;
    if (t < 32) { lin(b.win + 2560, DIN, b.WinT + 5120L * D, D, D, 8, t); return; } t -= 32;
    if (t < 32) { lin(b.win + 5128, DIN, b.WinT + 5128L * D, D, D, 48, t); return; } t -= 32;
    { const int kv = t >> 2; lin(b.w2 + (long)kv * 256 * 64, 64, b.w2T + (long)kv * 64 * 256, 256, 256, 64, t & 3); }
}
DI void tconv_load(const TDesc& d, f32x4 (&v)[8]) {
    const int tid = tidx(), n4 = (tid & 63) * 4, kb = tid >> 6;
#pragma unroll
    for (int i = 0; i < 8; ++i) { const int kk = kb + 8 * i; const float* s = d.src + (long)kk * d.src_ld + n4;
        if (n4 + 3 < d.nvalid) v[i] = *(const f32x4*)s;
        else { v[i] = (f32x4){0.f, 0.f, 0.f, 0.f};
#pragma unroll
            for (int e = 0; e < 4; ++e) if (n4 + e < d.nvalid) v[i][e] = s[e]; } }
}
DI void tconv_store(LAS float* scr, const TDesc& d, f32x4 (&v)[8]) {
    const int tid = tidx(), n4 = (tid & 63) * 4, kb = tid >> 6;
    constexpr int LS = 260;
#pragma unroll
    for (int i = 0; i < 8; ++i) { const int kk = kb + 8 * i; *(LAS f32x4*)(scr + kk * LS + 4 * ((n4 >> 2) ^ ((kk >> 3) & 7))) = v[i]; }
    __syncthreads();
#pragma unroll
    for (int i = 0; i < 4; ++i) { const int q = tid + 512 * i, nn = q >> 3, c = q & 7;
        if (nn < d.nvalid) { u32x4 o; const LAS float* s = scr + (8 * c) * LS + 4 * ((nn >> 2) ^ c) + (nn & 3);
            o.x = pk2h(s[0], s[LS]); o.y = pk2h(s[2 * LS], s[3 * LS]); o.z = pk2h(s[4 * LS], s[5 * LS]); o.w = pk2h(s[6 * LS], s[7 * LS]);
            const int n = d.ntl * 256 + nn;
            bf16_t* row = d.gu ? d.dst + (long)((n >> 7) * 256 + d.which * 128 + (n & 127)) * d.dst_ld : d.dst + (long)nn * d.dst_ld;
            *(u32x4*)(row + 8 * c) = o; } }
    __syncthreads();
}
DI void tconv_issue(const TBase& b, int hidx, LAS char* buf) {
    TDesc d; tconv_desc(b, hidx >> 1, d);
    const int lane = my_lane(), w = __builtin_amdgcn_readfirstlane(tidx() >> 6);
    const float* s = d.src + (hidx & 1) * 128 + 4 * ((lane & 31) ^ w);
#pragma unroll
    for (int i = 0; i < 4; ++i) { const int r = 2 * (w * 4 + i) + (lane >> 5);
        __builtin_amdgcn_global_load_lds((const unsigned*)(s + (long)r * d.src_ld), (LAS unsigned*)(buf + (w * 4 + i) * 1024), 16, 0, 2); }
}
DI void tconv_emit(const TBase& b, int hidx, LAS char* buf) {
    TDesc d; tconv_desc(b, hidx >> 1, d);
    const int tid = tidx(), half = hidx & 1;
    const LAS float* sb = (const LAS float*)buf;
#pragma unroll
    for (int it = 0; it < 2; ++it) { const int q = tid + 512 * it, nn = q >> 3, c = q & 7;
        const LAS float* s = sb + (8 * c) * 128 + 4 * ((nn >> 2) ^ c) + (nn & 3);
        u32x4 o; o.x = pk2h(s[0], s[128]); o.y = pk2h(s[256], s[384]); o.z = pk2h(s[512], s[640]); o.w = pk2h(s[768], s[896]);
        const int nl = half * 128 + nn, n = d.ntl * 256 + nl;
        bf16_t* row = d.gu ? d.dst + (long)((n >> 7) * 256 + d.which * 128 + (n & 127)) * d.dst_ld : d.dst + (long)nl * d.dst_ld;
        *(u32x4*)(row + 8 * c) = o; }
}
DI void tconv_range(CP p, int l, int lo, int hi, int bi, int nb, LAS char* lds) {
    const int h0 = 2 * lo + bi, hN = 2 * hi;
    const int nk = h0 < hN ? (hN - 1 - h0) / nb + 1 : 0;
    if (nk <= 0) return;
    TBase b; tconv_base(p, l, b);
    __syncthreads();
#pragma unroll
    for (int j = 0; j < 4; ++j) tconv_issue(b, h0 + min(j, nk - 1) * nb, lds + j * 32768);
    for (int k = 0; k < nk; ++k) {
        if (k < 3) asm volatile("s_waitcnt vmcnt(12)" ::: "memory"); else asm volatile("s_waitcnt vmcnt(18)" ::: "memory");
        __builtin_amdgcn_s_barrier();
        tconv_emit(b, h0 + k * nb, lds + (k & 3) * 32768);
        asm volatile("s_waitcnt lgkmcnt(0)" ::: "memory");
        __builtin_amdgcn_s_barrier();
        tconv_issue(b, h0 + min(k + 4, nk - 1) * nb, lds + (k & 3) * 32768);
    }
    asm volatile("s_waitcnt vmcnt(0)" ::: "memory");
    __syncthreads();
}
DI void tconv_narrow(CP p, int l, int bi, int nb, LAS char* lds) {
    LAS float* scr = (LAS float*)lds;
    TBase b; tconv_base(p, l, b);
    for (int idx = TCONV_FULL + bi; idx < TCONV_TILES; idx += nb) { TDesc d; f32x4 v[8]; tconv_desc(b, idx, d); tconv_load(d, v); tconv_store(scr, d, v); }
    { unsigned* z = (unsigned*)(p.WinT + l * LW_WIN + (long)DIN * D); for (long i = (long)bi * 512 + tidx(); i < (long)(NPAD - DIN) * D / 2; i += (long)nb * 512) z[i] = 0u; }
}
DI void p0_tables(CP p, int l, LAS char* lds) {
    const float* lnf = p.in[I_LN_FFN] + l * D;
    const long gtid = (long)bidx() * 512 + tidx(), nth = (long)gdim() * 512;
    for (long i = gtid; i < 48L * D; i += nth) { const int n = (int)(i / D), k = (int)(i % D); float v = 0.f;
        if (n < 4) v = p.in[I_GROUP_W][((long)l * D + k) * 4 + n]; else if (n < 36) v = p.in[I_EXPERT_W][((long)l * D + k) * 32 + (n - 4)];
        p.Wr[i] = v * lnf[k]; }
    for (int blk = bidx(); blk < 64; blk += gdim()) {
        LAS float* cc = (LAS float*)lds;
        __syncthreads();
        if (tidx() < 32) { const int i = blk * 32 + tidx(), g = i >> 6, pp = i & 63;
            const float a = p.in[I_LAM_RE][(l * 32 + g) * 64 + pp], w = p.in[I_LAM_IM][(l * 32 + g) * 64 + pp], dt = __expf(p.in[I_S5LOGDT][l * 32 + g]);
            const float ea = expf(a * dt); float sn, cs; sincosf(w * dt, &sn, &cs);
            const float lr = ea * cs, li = ea * sn;
            const float sh = sinf(0.5f * w * dt); const float lr1 = expm1f(a * dt) * cs - 2.f * sh * sh;
            const float den = 1.f / (a * a + w * w);
            cc[2 * tidx()] = (lr1 * a + li * w) * den; cc[2 * tidx() + 1] = (li * a - lr1 * w) * den;
            p.s5lam[g * 64 + pp] = (f32x2){lr, li};
            { const float e64 = expf(a * dt * 64.f); float s6, c6; sincosf(w * dt * 64.f, &s6, &c6); p.s5lam[2048 + g * 64 + pp] = (f32x2){e64 * c6, e64 * s6}; } }
        __syncthreads();
        { const int pr = tidx() >> 4, hh = tidx() & 15, i = blk * 32 + pr, g = i >> 6, pp = i & 63;
            const float cr = cc[2 * pr], ci = cc[2 * pr + 1];
            const float br = p.in[I_B_RE][((long)(l * 32 + g) * 64 + pp) * 16 + hh], bi = p.in[I_B_IM][((long)(l * 32 + g) * 64 + pp) * 16 + hh];
            p.s5Bt[((long)g * 128 + pp) * 32 + hh] = f2bf(cr * br - ci * bi); p.s5Bt[((long)g * 128 + pp) * 32 + 16 + hh] = 0;
            p.s5Bt[((long)g * 128 + 64 + pp) * 32 + hh] = f2bf(cr * bi + ci * br); p.s5Bt[((long)g * 128 + 64 + pp) * 32 + 16 + hh] = 0;
            p.s5Ct[((long)g * 16 + hh) * 128 + pp] = f2bf(p.in[I_C_RE][((long)(l * 32 + g) * 16 + hh) * 64 + pp]);
            p.s5Ct[((long)g * 16 + hh) * 128 + 64 + pp] = f2bf(-p.in[I_C_IM][((long)(l * 32 + g) * 16 + hh) * 64 + pp]); }
    }
    __syncthreads();
    {
        const int gw = bidx() * 8 + __builtin_amdgcn_readfirstlane(tidx() >> 6), nw = gdim() * 8, lane = tidx() & 63;
        for (int o = gw; o < 512; o += nw) { const int kv = o >> 8, n = o & 255; float s = 0.f;
            const float* pe = p.in[I_CMP_PE] + (long)(l * 2 + kv) * 2048; const float* w1 = p.in[I_CMP_W1] + (long)(l * 2 + kv) * 2048 * 256 + n;
#pragma unroll
            for (int kk = 0; kk < 32; ++kk) { const int k = lane + 64 * kk; s += pe[k] * w1[(long)k * 256]; }
            s = wave_sum(s); if (lane == 0) p.bias1[o] = s; }
    }
}
DI void p0_once(CP p) {
    const long gtid = (long)bidx() * 512 + tidx(), nth = (long)gdim() * 512;
    for (long i = gtid; i < 4096L * 32; i += nth) { const int pos = (int)(i >> 5), k = (int)(i & 31);
        const float invf = exp2f(-(float)k * (13.287712379549449f / 32.f)); const float ang = (float)pos * invf; float s, c; sincosf(ang, &s, &c); p.rope[i] = (f32x2){c, s}; }
    for (long i = gtid; i < 256; i += nth) p.cnt[i] = 0;
}

DI void p1_rows(CP p, int mode, int lprev, int lnext) {
    const int lane = tidx() & 63, gw = bidx() * 8 + __builtin_amdgcn_readfirstlane(tidx() >> 6), nw = gdim() * 8;
    int ts = 0;
    if (mode > 0) { int c = lane < 32 ? p.cnt[lprev * 32 + lane] : 0; int ntl = (c + 255) >> 8; int inc = ntl;
#pragma unroll
        for (int o = 1; o < 32; o <<= 1) { int v = shfl_up_i(inc, o, lane); if ((lane & 31) >= o) inc += v; }
        ts = inc - ntl; }
    for (int t = gw; t < T; t += nw) {
        f32x4 v[8]; float ss = 0.f;
        if (mode == 0) {
            const f32x4* xr = (const f32x4*)(p.in[I_X] + (long)t * D);
#pragma unroll
            for (int j = 0; j < 8; ++j) v[j] = xr[j * 64 + lane];
        } else {
            const int* ti = p.tokinfo + (long)t * 4; const int e0 = ti[0], p0 = ti[1], e1 = ti[2], p1 = ti[3];
            const long s0 = (long)shfl_idx_i(ts, e0) * 256 + p0, s1 = (long)shfl_idx_i(ts, e1) * 256 + p1;
            const f32x4* hr = (const f32x4*)(p.h + (long)t * D);
            const u32x2* y0 = (const u32x2*)(p.ybuf + s0 * D); const u32x2* y1 = (const u32x2*)(p.ybuf + s1 * D);
#pragma unroll
            for (int j = 0; j < 8; ++j) { f32x4 a = hr[j * 64 + lane]; const u32x2 b0 = y0[j * 64 + lane], b1 = y1[j * 64 + lane];
                a[0] += __uint_as_float(b0.x << 16) + __uint_as_float(b1.x << 16); a[1] += __uint_as_float(b0.x & 0xffff0000u) + __uint_as_float(b1.x & 0xffff0000u);
                a[2] += __uint_as_float(b0.y << 16) + __uint_as_float(b1.y << 16); a[3] += __uint_as_float(b0.y & 0xffff0000u) + __uint_as_float(b1.y & 0xffff0000u);
                v[j] = a; }
        }
#ifdef TPROBE
        if (mode == 2) { const float sc = 1.f + (TPROBE_SEL == 5 ? 2e-3f * (float)p.err[3445] : 2e-5f * (float)p.err[3440]);
#pragma unroll
            for (int j = 0; j < 8; ++j) v[j] *= sc; }
#endif
        if (mode >= 1) { f32x4* o = (f32x4*)(p.out + (long)t * D);
#pragma unroll
            for (int j = 0; j < 8; ++j) o[j * 64 + lane] = v[j]; }
        if (mode <= 1) {
#pragma unroll
            for (int j = 0; j < 8; ++j) ss += v[j][0] * v[j][0] + v[j][1] * v[j][1] + v[j][2] * v[j][2] + v[j][3] * v[j][3];
            ss = wave_sum(ss);
            if (lane == 0) p.rstd_mix[t] = rsqrtf(ss * (1.f / D) + EPS);
            u32x2* xo = (u32x2*)(p.xb + (long)t * D); const f32x4* gn = (const f32x4*)(p.in[I_LN_MIX] + lnext * D);
#pragma unroll
            for (int j = 0; j < 8; ++j) { const f32x4 g4 = gn[j * 64 + lane]; u32x2 w; w.x = pk2h(v[j][0] * g4[0], v[j][1] * g4[1]); w.y = pk2h(v[j][2] * g4[2], v[j][3] * g4[3]); xo[j * 64 + lane] = w; }
        }
    }
}

DI void inproj_narrow(CP p, int l, LAS char* lds) {
    const int tid = tidx(), lane = tid & 63, w = __builtin_amdgcn_readfirstlane(tid >> 6), fr = lane & 15, fq = lane >> 4;
    constexpr int XS = 2056;
    LAS bf16_t* X = (LAS bf16_t*)lds;
    LAS float* red = (LAS float*)lds;
    bf16x8 bw[8][4];
    { const bf16_t* wb = p.WinT + l * LW_WIN + (long)(NPROJ + fr) * D + w * 256 + 8 * fq;
#pragma unroll
      for (int ks = 0; ks < 8; ++ks)
#pragma unroll
          for (int nt = 0; nt < 4; ++nt) bw[ks][nt] = ld8(wb + (long)nt * 16 * D + ks * 32); }
    const LAS bf16_t* xa = X + fr * XS + w * 256 + 8 * fq;
    for (int item = bidx(); item < T / 32; item += gdim()) {
        const long tok0 = (long)item * 32;
        __syncthreads();
#pragma unroll
        for (int i = 0; i < 16; ++i) { const int e = tid + i * 512, r = e >> 8, c = e & 255; *(LAS u32x4*)(X + r * XS + c * 8) = *(const u32x4*)(p.xb + (tok0 + r) * D + c * 8); }
        __syncthreads();
        f32x4 acc[2][4];
#pragma unroll
        for (int mt = 0; mt < 2; ++mt)
#pragma unroll
            for (int nt = 0; nt < 4; ++nt) acc[mt][nt] = ZERO4;
#pragma unroll
        for (int ks = 0; ks < 8; ++ks) {
            bf16x8 a[2];
#pragma unroll
            for (int mt = 0; mt < 2; ++mt) a[mt] = ld8(xa + mt * 16 * XS + ks * 32);
#pragma unroll
            for (int mt = 0; mt < 2; ++mt)
#pragma unroll
                for (int nt = 0; nt < 4; ++nt) acc[mt][nt] = MFMA16(bw[ks][nt], a[mt], acc[mt][nt]);
        }
        settle(acc[0][0], acc[0][1], acc[0][2], acc[0][3], acc[1][0], acc[1][1], acc[1][2], acc[1][3]);
        __syncthreads();
#pragma unroll
        for (int mt = 0; mt < 2; ++mt)
#pragma unroll
            for (int nt = 0; nt < 4; ++nt) *(LAS f32x4*)(red + (w * 32 + mt * 16 + fr) * 64 + nt * 16 + 4 * fq) = acc[mt][nt];
        __syncthreads();
        { const int r = tid >> 4, c4 = (tid & 15) * 4; f32x4 s = ZERO4;
#pragma unroll
          for (int ww = 0; ww < 8; ++ww) s += *(const LAS f32x4*)(red + (ww * 32 + r) * 64 + c4);
          if (c4 < 56) *(f32x4*)(p.small + (tok0 + r) * NSMALL + c4) = s * p.rstd_mix[tok0 + r]; }
    }
    __syncthreads();
}
DI void p2_inproj(CP p, int l, LAS char* lds) {
    unsigned aoff[2][2], boff[2];
#pragma unroll
    for (int i = 0; i < 2; ++i) { int R, C; g8::my_rc(i, R, C); boff[i] = (unsigned)(R * D + C) * 2u; aoff[0][i] = boff[i]; aoff[1][i] = (unsigned)((128 + R) * D + C) * 2u; }
    for (int u = bidx();; u += gdim()) {
        int pm, pn; if (!g8::unit_of(u, T / 256, NPROJ / 256, pm, pn)) break;
        const float* rs = p.rstd_mix + pm * 256; bf16_t* proj = p.proj;
        g8::gemm_tile(lds, (const char*)(p.xb + (long)pm * 256 * D), aoff, 128, (const char*)(p.WinT + l * LW_WIN + (long)pn * 256 * D), boff, 128L * D * 2, D / 64, [&](const Acc& acc, int rb, int cb) {
            ACC_FOR(ai, m, bj, n) { const int r = ai * 128 + m * 16 + rb, c = bj * 128 + n * 16 + cb; const long row = pm * 256 + r;
                f32x4 v = acc[ai][bj][m][n] * rs[r];
                u32x2 w; w.x = pk2h(v[0], v[1]); w.y = pk2h(v[2], v[3]); *(u32x2*)(proj + row * NPROJ + pn * 256 + c) = w; }
        });
    }
    inproj_narrow(p, l, lds);
    { const int G = gdim(), rem = ((T / 256) * (NPROJ / 256)) % G;
      if (rem != 0 && bidx() >= rem) tconv_range(p, l, TCONV_EARLY, TCONV_EARLY + TCONV_TAIL, bidx() - rem, G - rem, lds); }
}

DI void s5_item(CP p, int l, int item, int pass, LAS char* wl) {
    const int lane = tidx() & 63, fr = lane & 15, fq = lane >> 4;
    item = __builtin_amdgcn_readfirstlane(item);
    const int g = item & 31, c = (item >> 5) & 63, b = item >> 11;
    LAS float* BU = (LAS float*)wl;
    LAS bf16_t* X = (LAS bf16_t*)(wl + 8192);
    const f32x2 lam = p.s5lam[g * 64 + lane];
    float sre = 0.f, sim = 0.f;
    if (pass == 2) { const f32x2 l64 = p.s5lam[2048 + g * 64 + lane]; const f32x2* E = p.s5E + ((long)(b * 64) * 32 + g) * 64 + lane;
        for (int c0 = 0; c0 < c; c0 += 8) { f32x2 e[8];
#pragma unroll
            for (int k = 0; k < 8; ++k) e[k] = E[(long)min(c0 + k, c - 1) * 32 * 64];
#pragma unroll
            for (int k = 0; k < 8; ++k) if (c0 + k < c) { const float nr = l64.x * sre - l64.y * sim + e[k].x, ni = l64.x * sim + l64.y * sre + e[k].y; sre = nr; sim = ni; } } }
    bf16x8 bfr[8], cfr[4];
#pragma unroll
    for (int nb = 0; nb < 8; ++nb) bfr[nb] = *(const bf16x8*)(p.s5Bt + ((long)g * 128 + nb * 16 + fr) * 32 + 8 * fq);
    if (pass == 2) {
#pragma unroll
        for (int ks = 0; ks < 4; ++ks) cfr[ks] = *(const bf16x8*)(p.s5Ct + ((long)g * 16 + fr) * 128 + ks * 32 + 8 * fq);
    }
    const long tok0 = (long)b * SEQ + c * 64;
    const float dsk = p.in[I_S5D][l * 512 + g * 16 + fr];
    bf16x8 afr_nx = *(const bf16x8*)(p.proj + (tok0 + fr) * NPROJ + C_U + g * 16 + 8 * (fq & 1));
    for (int sub = 0; sub < 4; ++sub) {
        const long tb = tok0 + sub * 16;
        const bf16x8 afr = afr_nx;
        afr_nx = *(const bf16x8*)(p.proj + (tok0 + min(sub + 1, 3) * 16 + fr) * NPROJ + C_U + g * 16 + 8 * (fq & 1));
        bf16_t uu[4];
        if (pass == 2) {
#pragma unroll
            for (int j = 0; j < 4; ++j) uu[j] = p.proj[(tb + 4 * fq + j) * NPROJ + C_U + g * 16 + fr]; }
        f32x4 accs[8];
#pragma unroll
        for (int nb = 0; nb < 8; ++nb) { accs[nb] = (f32x4){0.f, 0.f, 0.f, 0.f}; accs[nb] = MFMA16(afr, bfr[nb], accs[nb]); }
        settle(accs[0], accs[1], accs[2], accs[3], accs[4], accs[5], accs[6], accs[7]);
#pragma unroll
        for (int nb = 0; nb < 8; ++nb)
#pragma unroll
            for (int j = 0; j < 4; ++j) BU[(4 * fq + j) * 128 + nb * 16 + fr] = accs[nb][j];
        lds_wait();
#pragma unroll
        for (int tt = 0; tt < 16; ++tt) { const float br = BU[tt * 128 + lane], bi = BU[tt * 128 + 64 + lane];
            const float nr = lam.x * sre - lam.y * sim + br, ni = lam.x * sim + lam.y * sre + bi; sre = nr; sim = ni;
            if (pass == 2) { X[tt * 136 + lane] = f2bf(sre); X[tt * 136 + 64 + lane] = f2bf(sim); } }
        if (pass == 2) {
            lds_wait();
            f32x4 acc = {0.f, 0.f, 0.f, 0.f};
            bf16x8 xa[4];
#pragma unroll
            for (int ks = 0; ks < 4; ++ks) xa[ks] = *(const LAS bf16x8*)(X + fr * 136 + ks * 32 + 8 * fq);
            lds_wait();
#pragma unroll
            for (int ks = 0; ks < 4; ++ks) acc = MFMA16(xa[ks], cfr[ks], acc);
            settle(acc);
            asm volatile("" :: "v"(xa[0]), "v"(xa[1]), "v"(xa[2]), "v"(xa[3]));
#pragma unroll
            for (int j = 0; j < 4; ++j) { const long tk = tb + 4 * fq + j; const float u = bf2f(uu[j]);
                p.s5y[tk * 512 + g * 16 + fr] = f2bf(gelu_tanh(acc[j] + dsk * u)); }
        }
        lds_wait();
    }
    if (pass == 1) { p.s5E[((long)(b * 64 + c) * 32 + g) * 64 + lane] = (f32x2){sre, sim};
#ifdef DBG_E2
        ((f32x2*)p.gRT)[((long)(b * 64 + c) * 32 + g) * 64 + lane] = (f32x2){sre, sim};
#endif
    }
}
constexpr int GP_QG = 0, GP_KN = 17408, GP_KB = 34816, GP_QN = 52224, GP_VBT = 69632, GP_KBGT = 88064, GP_KGT = 106496, GP_AM = 124928, GP_QK = 142336, GP_GT = 151552;
constexpr int GP_TM = 17408, GP_UT = 26624, GP_WT = 45056;
constexpr int SK = 136, ST = 72, SA = 68;

template <int SWA> DI f32x4 mma_tile2_sw(const LAS bf16_t* lin, const LAS bf16_t* sw, int fq, int x) {
    f32x4 acc = ZERO4;
#pragma unroll
    for (int ks = 0; ks < 2; ++ks) { const bf16x8 a = ld8(lin + ks * 32), s = ld8(sw + 8 * ((4 * ks + fq) ^ x)); acc = SWA ? MFMA16(s, a, acc) : MFMA16(a, s, acc); }
    settle(acc);
    return acc;
}
DI void gdn_prep_item(CP p, int l, int item, LAS char* lds) {
    const int tid = tidx(), lane = tid & 63, w = __builtin_amdgcn_readfirstlane(tid >> 6), fr = lane & 15, fq = lane >> 4;
    const int n = item & 63, h = (item >> 6) & 3, b = item >> 8;
    const long tok0 = (long)b * SEQ + n * 64;
    LAS bf16_t* Qg = (LAS bf16_t*)(lds + GP_QG); LAS bf16_t* Kn = (LAS bf16_t*)(lds + GP_KN); LAS bf16_t* Kb = (LAS bf16_t*)(lds + GP_KB); LAS bf16_t* Qn = (LAS bf16_t*)(lds + GP_QN);
    LAS bf16_t* VbT = (LAS bf16_t*)(lds + GP_VBT); LAS bf16_t* KbgT = (LAS bf16_t*)(lds + GP_KBGT); LAS bf16_t* KgT = (LAS bf16_t*)(lds + GP_KGT);
    LAS float* Am = (LAS float*)(lds + GP_AM); LAS bf16_t* QKm = (LAS bf16_t*)(lds + GP_QK); LAS float* gts = (LAS float*)(lds + GP_GT);
    LAS bf16_t* Tm = (LAS bf16_t*)(lds + GP_TM); LAS bf16_t* UT = (LAS bf16_t*)(lds + GP_UT); LAS bf16_t* WT = (LAS bf16_t*)(lds + GP_WT);
    if (tid < 64) {
        const float a = p.small[(tok0 + tid) * NSMALL + h], bb = p.small[(tok0 + tid) * NSMALL + 4 + h];
        const float g = -expf(p.in[I_A_LOG][l * 4 + h]) * softplusf_(a + p.in[I_DT_BIAS][l * 4 + h]);
        float inc = g;
#pragma unroll
        for (int o = 1; o < 64; o <<= 1) { const float v = shfl_up_f(inc, o, lane); if (lane >= o) inc += v; }
        gts[tid] = inc; gts[64 + tid] = sigmoidf_(bb);
    }
    LAS float* cw = Am;
    if (tid < 384) {
#pragma unroll
        for (int j = 0; j < 4; ++j) cw[j * 384 + tid] = p.in[I_CONV_W][(long)(l * 4 + j) * 1536 + (tid >> 7) * 512 + h * 128 + (tid & 127)]; }
    __syncthreads();
    {
        const int i = tid >> 3, sub = tid & 7;
        const float gc = gts[i], beta = gts[64 + i], glast = gts[63];
        const float eg = __expf(gc), egl = __expf(glast - gc);
        const int spos = n * 64 + i;
#pragma unroll
        for (int which = 0; which < 3; ++which) {
            const int cbase = which * 512 + h * 128 + sub * 16;
            float o[16];
#pragma unroll
            for (int cc = 0; cc < 16; ++cc) o[cc] = 0.f;
#pragma unroll
            for (int j = 0; j < 4; ++j) {
                if (spos - 3 + j >= 0) {
                    const bf16_t* xr = p.proj + (tok0 + i - 3 + j) * NPROJ + C_QKV + cbase;
                    const bf16x8 x0 = ld8(xr), x1 = ld8(xr + 8);
                    const LAS float* wr_ = cw + j * 384 + which * 128 + sub * 16;
#pragma unroll
                    for (int cc = 0; cc < 8; ++cc) { o[cc] += wr_[cc] * bf2f((bf16_t)x0[cc]); o[8 + cc] += wr_[8 + cc] * bf2f((bf16_t)x1[cc]); }
                }
            }
            float ss = 0.f;
#pragma unroll
            for (int cc = 0; cc < 16; ++cc) { o[cc] = siluf_(o[cc]); ss += o[cc] * o[cc]; }
            ss += shflx<1>(ss); ss += shflx<2>(ss); ss += shflx<4>(ss);
            if (which == 0) {
                const float sc = rsqrtf(ss + 1e-6f) * 0.08838834764831845f;
                u32x4 a0, a1, b0, b1;
#pragma unroll
                for (int cc = 0; cc < 4; ++cc) { a0[cc] = pk2(o[2 * cc] * sc, o[2 * cc + 1] * sc); a1[cc] = pk2(o[8 + 2 * cc] * sc, o[9 + 2 * cc] * sc);
                    b0[cc] = pk2(o[2 * cc] * sc * eg, o[2 * cc + 1] * sc * eg); b1[cc] = pk2(o[8 + 2 * cc] * sc * eg, o[9 + 2 * cc] * sc * eg); }
                *(LAS u32x4*)(Qn + i * SK + sub * 16) = a0; *(LAS u32x4*)(Qn + i * SK + sub * 16 + 8) = a1;
                *(LAS u32x4*)(Qg + i * SK + sub * 16) = b0; *(LAS u32x4*)(Qg + i * SK + sub * 16 + 8) = b1;
            } else if (which == 1) {
                const float sc = rsqrtf(ss + 1e-6f);
                u32x4 a0, a1, b0, b1;
#pragma unroll
                for (int cc = 0; cc < 4; ++cc) { a0[cc] = pk2(o[2 * cc] * sc, o[2 * cc + 1] * sc); a1[cc] = pk2(o[8 + 2 * cc] * sc, o[9 + 2 * cc] * sc);
                    b0[cc] = pk2(o[2 * cc] * sc * beta, o[2 * cc + 1] * sc * beta); b1[cc] = pk2(o[8 + 2 * cc] * sc * beta, o[9 + 2 * cc] * sc * beta); }
                *(LAS u32x4*)(Kn + i * SK + sub * 16) = a0; *(LAS u32x4*)(Kn + i * SK + sub * 16 + 8) = a1;
                *(LAS u32x4*)(Kb + i * SK + sub * 16) = b0; *(LAS u32x4*)(Kb + i * SK + sub * 16 + 8) = b1;
#pragma unroll
                for (int cc = 0; cc < 16; ++cc) { const float kn = o[cc] * sc; KbgT[(sub * 16 + cc) * ST + (i ^ (8 * sub))] = f2bf(kn * beta * eg); KgT[(sub * 16 + cc) * ST + (i ^ (8 * sub))] = f2bf(kn * egl); }
            } else {
#pragma unroll
                for (int cc = 0; cc < 16; ++cc) VbT[(sub * 16 + cc) * ST + (i ^ (8 * sub))] = f2bf(o[cc] * beta);
            }
        }
    }
    __syncthreads();
    for (int tl = w; tl < 16; tl += 8) {
        const int m0 = (tl >> 2) * 16, n0 = (tl & 3) * 16;
        const f32x4 a1 = mma_tile<4>(Kb + (m0 + fr) * SK + 8 * fq, Kn + (n0 + fr) * SK + 8 * fq, ZERO4);
        const f32x4 a2 = mma_tile<4>(Qn + (m0 + fr) * SK + 8 * fq, Kn + (n0 + fr) * SK + 8 * fq, ZERO4);
        const int jj = n0 + fr; const float gj = gts[jj];
#pragma unroll
        for (int j = 0; j < 4; ++j) { const int i = m0 + 4 * fq + j; const float dec = __expf(fminf(gts[i] - gj, 0.f));
            Am[i * SA + jj] = (jj < i) ? a1[j] * dec : 0.f;
            QKm[i * ST + jj] = f2bf((jj <= i) ? a2[j] * dec : 0.f); }
    }
    __syncthreads();
    if (w < 4) {
        const int q = lane & 3, c = 16 * w + (lane >> 2);
        float tq[16];
#pragma unroll
        for (int k = 0; k < 16; ++k) tq[k] = 0.f;
        const LAS float* Aq = Am + q;
#pragma unroll
        for (int i = 0; i < 64; ++i) {
            float acc = (q == 0 && i == c) ? 1.f : 0.f;
#pragma unroll
            for (int jj = 0; 4 * jj < i; ++jj) acc -= Aq[i * SA + 4 * jj] * tq[jj];
            acc += __builtin_bit_cast(float, __builtin_amdgcn_update_dpp(0, __builtin_bit_cast(int, acc), 0xB1, 0xF, 0xF, false));
            acc += __builtin_bit_cast(float, __builtin_amdgcn_update_dpp(0, __builtin_bit_cast(int, acc), 0x4E, 0xF, 0xF, false));
            tq[i >> 2] = (q == (i & 3)) ? acc : tq[i >> 2];
            if (q == 0) Tm[i * ST + c] = f2bf(acc);
        }
    }
    __syncthreads();
    for (int tl = w; tl < 32; tl += 8) {
        const int m0 = (tl >> 3) * 16, n0 = (tl & 7) * 16;
        const f32x4 u = mma_tile2_sw<0>(Tm + (m0 + fr) * ST + 8 * fq, VbT + (n0 + fr) * ST, fq, n0 >> 4);
        const f32x4 ww = mma_tile2_sw<0>(Tm + (m0 + fr) * ST + 8 * fq, KbgT + (n0 + fr) * ST, fq, n0 >> 4);
        u32x2 pu, pw; pu.x = pk2(u[0], u[1]); pu.y = pk2(u[2], u[3]); pw.x = pk2(ww[0], ww[1]); pw.y = pk2(ww[2], ww[3]);
        *(LAS u32x2*)(UT + (n0 + fr) * ST + m0 + 4 * fq) = pu; *(LAS u32x2*)(WT + (n0 + fr) * ST + m0 + 4 * fq) = pw;
    }
    __syncthreads();
    const long ib = item;
    for (int tl = w; tl < 64; tl += 8) {
        const int mt = tl >> 3, nt = tl & 7, m0 = mt * 16, n0 = nt * 16;
        const f32x4 pv = mma_tile2_sw<0>(WT + (m0 + fr) * ST + 8 * fq, KgT + (n0 + fr) * ST, fq, n0 >> 4);
        u32x2 pp; pp.x = pk2(-pv[0], -pv[1]); pp.y = pk2(-pv[2], -pv[3]);
        *(u32x2*)(p.gP + ib * 16384 + (n0 + fr) * 128 + (mt >> 1) * 32 + 8 * fq + (mt & 1) * 4) = pp;
        const f32x4 rv = mma_tile2_sw<1>(UT + (n0 + fr) * ST + 8 * fq, KgT + (m0 + fr) * ST, fq, m0 >> 4);
        *(f32x4*)(p.gRT + ib * 16384 + (n0 + fr) * 128 + m0 + 4 * fq) = rv;
    }
    for (int tl = w; tl < 32; tl += 8) {
        const int mt = tl >> 2, nt = tl & 3, m0 = mt * 16, n0 = nt * 16;
        const f32x4 qw = mma_tile<2>(WT + (m0 + fr) * ST + 8 * fq, QKm + (n0 + fr) * ST + 8 * fq, ZERO4);
        const f32x4 ou = mma_tile<2>(UT + (m0 + fr) * ST + 8 * fq, QKm + (n0 + fr) * ST + 8 * fq, ZERO4);
        const int i = n0 + fr, f = m0 + 4 * fq;
        const u32x2 qg = *(const LAS u32x2*)(Qg + i * SK + f);
        u32x2 qo; qo.x = pk2(__uint_as_float(qg.x << 16) - qw[0], __uint_as_float(qg.x & 0xffff0000u) - qw[1]);
        qo.y = pk2(__uint_as_float(qg.y << 16) - qw[2], __uint_as_float(qg.y & 0xffff0000u) - qw[3]);
        *(u32x2*)(p.gQp + ib * 8192 + i * 128 + f) = qo;
        *(f32x4*)(p.gOU + ib * 8192 + i * 128 + f) = ou;
    }
    if (tid == 0) p.gA[ib] = __expf(gts[63]);
    __syncthreads();
}

DI void gdn_chain(CP p, int ch, LAS char* lds) {
    const int tid = tidx(), lane = tid & 63, w = __builtin_amdgcn_readfirstlane(tid >> 6), fr = lane & 15, fq = lane >> 4;
    constexpr int PST = 136, PBUF = 128 * PST * 2;
    f32x4 acc[8];
#pragma unroll
    for (int mb = 0; mb < 8; ++mb) acc[mb] = ZERO4;
    u32x4 pp[4]; f32x4 rr[8]; float an;
    auto load_step = [&](int n) {
        const long ib = (long)ch * 64 + n;
#pragma unroll
        for (int i = 0; i < 4; ++i) { const int q = tid + 512 * i; pp[i] = *(const u32x4*)(p.gP + ib * 16384 + (q >> 4) * 128 + (q & 15) * 8); }
#pragma unroll
        for (int mb = 0; mb < 8; ++mb) rr[mb] = *(const f32x4*)(p.gRT + ib * 16384 + (w * 16 + fr) * 128 + mb * 16 + 4 * fq);
        an = p.gA[ib];
    };
    auto write_p = [&](int buf) {
#pragma unroll
        for (int i = 0; i < 4; ++i) { const int q = tid + 512 * i; *(LAS u32x4*)(lds + buf * PBUF + (q >> 4) * (PST * 2) + (q & 15) * 16) = pp[i]; }
    };
    __syncthreads();
    load_step(0); write_p(0);
    f32x4 rc[8]; float ac = an;
#pragma unroll
    for (int mb = 0; mb < 8; ++mb) rc[mb] = rr[mb];
    __syncthreads();
    for (int n = 0; n < 64; ++n) {
        const long ib = (long)ch * 64 + n;
        if (n + 1 < 64) load_step(n + 1);
        bf16x8 bfr[4];
#pragma unroll
        for (int ks = 0; ks < 4; ++ks) { u32x4 q; q.x = pk2(acc[2 * ks][0], acc[2 * ks][1]); q.y = pk2(acc[2 * ks][2], acc[2 * ks][3]); q.z = pk2(acc[2 * ks + 1][0], acc[2 * ks + 1][1]); q.w = pk2(acc[2 * ks + 1][2], acc[2 * ks + 1][3]);
            bfr[ks] = __builtin_bit_cast(bf16x8, q);
            bf16_t* sp = p.gST + ib * 16384 + (w * 16 + fr) * 128 + 4 * fq;
            u32x2 lo, hi; lo.x = q.x; lo.y = q.y; hi.x = q.z; hi.y = q.w;
            *(u32x2*)(sp + (2 * ks) * 16) = lo; *(u32x2*)(sp + (2 * ks + 1) * 16) = hi; }
#pragma unroll
        for (int mb = 0; mb < 8; ++mb) acc[mb] = acc[mb] * ac + rc[mb];
        const LAS bf16_t* pb = (const LAS bf16_t*)(lds + (n & 1) * PBUF);
#pragma unroll
        for (int mb = 0; mb < 8; ++mb)
#pragma unroll
            for (int ks = 0; ks < 4; ++ks) acc[mb] = MFMA16(ld8(pb + (mb * 16 + fr) * PST + ks * 32 + 8 * fq), bfr[ks], acc[mb]);
        settle(acc[0], acc[1], acc[2], acc[3], acc[4], acc[5], acc[6], acc[7]);
        if (n + 1 < 64) { write_p((n + 1) & 1); ac = an;
#pragma unroll
            for (int mb = 0; mb < 8; ++mb) rc[mb] = rr[mb]; }
        __syncthreads();
    }
}

DI void gdn_out_item(CP p, int l, int item, LAS char* lds) {
    const int tid = tidx(), lane = tid & 63, w = __builtin_amdgcn_readfirstlane(tid >> 6), fr = lane & 15, fq = lane >> 4;
    const int n = item & 63, h = (item >> 6) & 3, b = item >> 8;
    const long tok0 = (long)b * SEQ + n * 64, ib = item;
    LAS float* red = (LAS float*)lds;
    const int ib16 = (w & 3) * 16, mh = w >> 2, i = ib16 + fr;
    bf16x8 sfr[4][4], qfr[4]; f32x4 ouv[4], gwv[4]; u32x2 zzv[4];
#pragma unroll
    for (int ks = 0; ks < 4; ++ks) qfr[ks] = ld8(p.gQp + ib * 8192 + (ib16 + fr) * 128 + 8 * fq + ks * 32);
#pragma unroll
    for (int m4 = 0; m4 < 4; ++m4)
#pragma unroll
        for (int ks = 0; ks < 4; ++ks) sfr[m4][ks] = ld8(p.gST + ib * 16384 + ((mh * 4 + m4) * 16 + fr) * 128 + 8 * fq + ks * 32);
#pragma unroll
    for (int m4 = 0; m4 < 4; ++m4) { const int c0 = (mh * 4 + m4) * 16 + 4 * fq; ouv[m4] = *(const f32x4*)(p.gOU + ib * 8192 + i * 128 + c0);
        gwv[m4] = *(const f32x4*)(p.in[I_GDN_NORM] + l * 128 + c0); zzv[m4] = *(const u32x2*)(p.proj + (tok0 + i) * NPROJ + C_Z + h * 128 + c0); }
    f32x4 acc[4];
#pragma unroll
    for (int m4 = 0; m4 < 4; ++m4) { acc[m4] = ZERO4;
#pragma unroll
        for (int ks = 0; ks < 4; ++ks) acc[m4] = MFMA16(sfr[m4][ks], qfr[ks], acc[m4]); }
    settle(acc[0], acc[1], acc[2], acc[3]);
    float s = 0.f;
#pragma unroll
    for (int m4 = 0; m4 < 4; ++m4) { acc[m4] += ouv[m4];
        s += acc[m4][0] * acc[m4][0] + acc[m4][1] * acc[m4][1] + acc[m4][2] * acc[m4][2] + acc[m4][3] * acc[m4][3]; }
    s += shflx<16>(s); s += shflx<32>(s);
    if (fq == 0) red[mh * 64 + i] = s;
    __syncthreads();
    const float rstd = rsqrtf((red[i] + red[64 + i]) * (1.f / 128.f) + EPS);
#pragma unroll
    for (int m4 = 0; m4 < 4; ++m4) { const int c0 = (mh * 4 + m4) * 16 + 4 * fq;
        const f32x4 gw = gwv[m4]; const u32x2 zz = zzv[m4];
        const float z0 = __uint_as_float(zz.x << 16), z1 = __uint_as_float(zz.x & 0xffff0000u), z2 = __uint_as_float(zz.y << 16), z3 = __uint_as_float(zz.y & 0xffff0000u);
        u32x2 o; o.x = pk2(acc[m4][0] * rstd * gw[0] * siluf_(z0), acc[m4][1] * rstd * gw[1] * siluf_(z1)); o.y = pk2(acc[m4][2] * rstd * gw[2] * siluf_(z2), acc[m4][3] * rstd * gw[3] * siluf_(z3));
        *(u32x2*)(p.mix + (tok0 + i) * D + 512 + h * 128 + c0) = o; }
    __syncthreads();
}
DI void nsa_prep_elem(CP p, int l) {
    const long gtid = (long)bidx() * 512 + tidx(), nth = (long)gdim() * 512;
    for (long task = gtid; task < (long)T * 24; task += nth) {
        const long t = task / 24; const int k = (int)(task - t * 24);
        const int s = (int)(t & (SEQ - 1)), b = (int)(t >> 12);
        int col; const float* gain; bf16_t* dst; float osc = 1.f;
        if (k < 16) { col = C_NQ + k * 64; gain = p.in[I_QNORM] + l * 64; dst = p.qn + t * 1024 + k * 64; osc = 0.125f * 1.4426950408889634f; }
        else if (k < 20) { const int g = k - 16; col = C_NKV + 2 * 256 + g * 64; gain = p.in[I_KNORM] + (l * 3 + 1) * 64; dst = p.ksn + (((long)(b * 4 + g)) * SEQ + s) * 64; }
        else { const int g = k - 20; col = C_NKV + 4 * 256 + g * 64; gain = p.in[I_KNORM] + (l * 3 + 2) * 64; dst = p.kwn + (((long)(b * 4 + g)) * SEQ + s) * 64; }
        const bf16_t* src = p.proj + t * NPROJ + col;
        float x[64]; float ss = 0.f;
#pragma unroll
        for (int c = 0; c < 8; ++c) { const bf16x8 v = ld8(src + 8 * c);
#pragma unroll
            for (int e = 0; e < 8; ++e) { x[8 * c + e] = bf2f((bf16_t)v[e]); ss += x[8 * c + e] * x[8 * c + e]; } }
        const float rstd = rsqrtf(ss * (1.f / 64.f) + EPS) * osc;
        const f32x4* rp = (const f32x4*)(p.rope + s * 32);
        unsigned o1[16], o2[16];
#pragma unroll
        for (int i2 = 0; i2 < 16; ++i2) { const f32x4 cs = rp[i2]; const int i = 2 * i2;
            const float a1 = x[i] * rstd * gain[i], a2 = x[32 + i] * rstd * gain[32 + i], b1 = x[i + 1] * rstd * gain[i + 1], b2 = x[33 + i] * rstd * gain[33 + i];
            o1[i2] = pk2(a1 * cs[0] - a2 * cs[1], b1 * cs[2] - b2 * cs[3]); o2[i2] = pk2(a2 * cs[0] + a1 * cs[1], b2 * cs[2] + b1 * cs[3]); }
#pragma unroll
        for (int c = 0; c < 4; ++c) { u32x4 w1, w2;
#pragma unroll
            for (int e = 0; e < 4; ++e) { w1[e] = o1[4 * c + e]; w2[e] = o2[4 * c + e]; }
            *(u32x4*)(dst + 8 * c) = w1; *(u32x4*)(dst + 32 + 8 * c) = w2; }
    }
}
DI void nsa_vtrans(CP p, LAS char* wl) {
    const int lane = tidx() & 63, gw = bidx() * 8 + __builtin_amdgcn_readfirstlane(tidx() >> 6), nw = gdim() * 8;
    LAS bf16_t* tile = (LAS bf16_t*)wl;
    for (int item = gw; item < 2 * 4 * 4 * 64; item += nw) {
        const int tl = item & 63, g = (item >> 6) & 3, b = (item >> 8) & 3, which = item >> 10;
        const long t = (long)b * SEQ + tl * 64 + lane;
        const bf16_t* src = p.proj + t * NPROJ + C_NKV + (which ? 5 : 3) * 256 + g * 64;
#pragma unroll
        for (int c = 0; c < 8; ++c) { const bf16x8 v = ld8(src + 8 * c);
#pragma unroll
            for (int e = 0; e < 8; ++e) tile[lane * 66 + 8 * c + e] = (bf16_t)v[e]; }
        lds_wait();
        bf16_t* dst = (which ? p.vwT : p.vsT) + ((long)(b * 4 + g) * 64 + lane) * SEQ + tl * 64;
#pragma unroll
        for (int c = 0; c < 8; ++c) { u32x4 o;
#pragma unroll
            for (int e = 0; e < 4; ++e) o[e] = (unsigned)tile[(8 * c + 2 * e) * 66 + lane] | ((unsigned)tile[(8 * c + 2 * e + 1) * 66 + lane] << 16);
            *(u32x4*)(dst + 8 * c) = o; }
        lds_wait();
    }
}

DI void nsa_cmp_unit(CP p, int l, int unit, LAS char* lds) {
    const int kv = unit >> 4, mtile = unit & 15;
    const int tid = tidx(), lane = tid & 63, w = __builtin_amdgcn_readfirstlane(tid >> 6), fr = lane & 15, fq = lane >> 4;
    unsigned aoff[2][2], boff[2];
#pragma unroll
    for (int h = 0; h < 2; ++h)
#pragma unroll
        for (int i = 0; i < 2; ++i) { int R, C; g8::my_rc(i, R, C); const int row = mtile * 256 + h * 128 + R;
            const int b = row >> 10, n = min((row & 1023) >> 2, 254), g = row & 3;
            aoff[h][i] = (unsigned)((((long)b * SEQ + 16 * n) * NPROJ + C_NKV + kv * 256 + g * 64 + C) * 2);
            boff[i] = (unsigned)(R * 2048 + C) * 2u; }
    LAS bf16_t* Hs = (LAS bf16_t*)lds;
    const float* b1 = p.bias1 + kv * 256;
    g8::gemm_tile(lds, (const char*)p.proj, aoff, (long)NPROJ * 2, (const char*)(p.w1T + l * LW_W1 + (long)kv * 256 * 2048), boff, 128L * 2048 * 2, 32, [&](const Acc& acc, int rb, int cb) {
        ACC_FOR(ai, m, bj, n) { const int r = ai * 128 + m * 16 + rb, c = bj * 128 + n * 16 + cb; const f32x4 v = acc[ai][bj][m][n];
            u32x2 o; o.x = pk2(gelu_tanh(v[0] + b1[c]), gelu_tanh(v[1] + b1[c + 1])); o.y = pk2(gelu_tanh(v[2] + b1[c + 2]), gelu_tanh(v[3] + b1[c + 3]));
            *(LAS u32x2*)(Hs + r * 264 + c) = o; }
    });
    __syncthreads();
    const bf16_t* w2 = p.w2T + l * LW_W2 + (long)kv * 64 * 256;
    for (int rg = w; rg < 16; rg += 8) {
        f32x4 acc[4];
#pragma unroll
        for (int mt = 0; mt < 4; ++mt) acc[mt] = ZERO4;
#pragma unroll
        for (int ks = 0; ks < 8; ++ks) { const bf16x8 hb = ld8(Hs + (rg * 16 + fr) * 264 + ks * 32 + 8 * fq);
#pragma unroll
            for (int mt = 0; mt < 4; ++mt) acc[mt] = MFMA16(ld8(w2 + (mt * 16 + fr) * 256 + ks * 32 + 8 * fq), hb, acc[mt]); }
        settle(acc[0], acc[1], acc[2], acc[3]);
        const int row = mtile * 256 + rg * 16 + fr; const int b = row >> 10, n = (row & 1023) >> 2, g = row & 3;
        const bool valid = n < 255;
        if (kv == 0) {
            float ss = 0.f;
#pragma unroll
            for (int mt = 0; mt < 4; ++mt)
#pragma unroll
                for (int j = 0; j < 4; ++j) ss += acc[mt][j] * acc[mt][j];
            ss += shflx<16>(ss); ss += shflx<32>(ss);
            const float rstd = rsqrtf(ss * (1.f / 64.f) + EPS);
            const float* gain = p.in[I_KNORM] + (l * 3 + 0) * 64;
            const int pos = min(16 * n + 31, SEQ - 1);
            bf16_t* dst = p.kcmp + (((long)(b * 4 + g)) * 256 + n) * 64;
#pragma unroll
            for (int mt = 0; mt < 2; ++mt) { u32x2 lo, hi; float o1[4], o2[4];
#pragma unroll
                for (int j = 0; j < 4; ++j) { const int d = mt * 16 + 4 * fq + j; const f32x2 cs = p.rope[pos * 32 + d];
                    const float y1 = acc[mt][j] * rstd * gain[d], y2 = acc[mt + 2][j] * rstd * gain[32 + d];
                    o1[j] = valid ? y1 * cs.x - y2 * cs.y : 0.f; o2[j] = valid ? y2 * cs.x + y1 * cs.y : 0.f; }
                lo.x = pk2(o1[0], o1[1]); lo.y = pk2(o1[2], o1[3]); hi.x = pk2(o2[0], o2[1]); hi.y = pk2(o2[2], o2[3]);
                *(u32x2*)(dst + mt * 16 + 4 * fq) = lo; *(u32x2*)(dst + 32 + mt * 16 + 4 * fq) = hi; }
        } else {
            bf16_t* dst = p.vcmpT + (((long)(b * 4 + g)) * 64) * 256 + n;
#pragma unroll
            for (int mt = 0; mt < 4; ++mt)
#pragma unroll
                for (int j = 0; j < 4; ++j) dst[(long)(mt * 16 + 4 * fq + j) * 256] = f2bf(valid ? acc[mt][j] : 0.f);
        }
    }
    __syncthreads();
}

DI int crow(int i, int hh) { return (i & 3) + 8 * (i >> 2) + 4 * hh; }
DI bf16x8 pack8(const float* q) { u32x4 r; r.x = pk2(q[0], q[1]); r.y = pk2(q[2], q[3]); r.z = pk2(q[4], q[5]); r.w = pk2(q[6], q[7]); return __builtin_bit_cast(bf16x8, r); }
template <int S> DI bf16x8 pack_step(const f32x16& x) {
    u32x4 r;
    asm volatile("v_cvt_pk_bf16_f32 %0, %4, %5\n\tv_cvt_pk_bf16_f32 %1, %6, %7\n\tv_cvt_pk_bf16_f32 %2, %8, %9\n\tv_cvt_pk_bf16_f32 %3, %10, %11\n\ts_nop 1"
                 : "=&v"(r[0]), "=&v"(r[1]), "=&v"(r[2]), "=&v"(r[3])
                 : "v"(x[8 * S]), "v"(x[8 * S + 1]), "v"(x[8 * S + 2]), "v"(x[8 * S + 3]), "v"(x[8 * S + 4]), "v"(x[8 * S + 5]), "v"(x[8 * S + 6]), "v"(x[8 * S + 7]));
    return __builtin_bit_cast(bf16x8, r);
}
DI float exp2_(float x) { return __builtin_amdgcn_exp2f(x); }
DI float max16(const f32x16& a) { float m0 = fmaxf(fmaxf(a[0], a[1]), fmaxf(a[2], a[3])), m1 = fmaxf(fmaxf(a[4], a[5]), fmaxf(a[6], a[7])), m2 = fmaxf(fmaxf(a[8], a[9]), fmaxf(a[10], a[11])), m3 = fmaxf(fmaxf(a[12], a[13]), fmaxf(a[14], a[15])); return fmaxf(fmaxf(m0, m1), fmaxf(m2, m3)); }
DI bf16x8 ldvt(const bf16_t* vt, long ldv, int d, int key) { const u32x2 a = *(const u32x2*)(vt + (long)d * ldv + key), b = *(const u32x2*)(vt + (long)d * ldv + key + 8); u32x4 r; r.x = a.x; r.y = a.y; r.z = b.x; r.w = b.y; return __builtin_bit_cast(bf16x8, r); }

constexpr int NS_KC = 0, NS_VC = 36864, NS_KR = 70656, NS_VR = 89088, NS_IMP = 107520, NS_UN = 123904, NS_TL = 124160;
DI bf16x8 ldvt_l(const LAS bf16_t* q) { const u32x2 a = *(const LAS u32x2*)q, b = *(const LAS u32x2*)(q + 8); u32x4 r; r.x = a.x; r.y = a.y; r.z = b.x; r.w = b.y; return __builtin_bit_cast(bf16x8, r); }
DI void nsa_unit(CP p, int l, int unit, LAS char* lds) {
    const int tid = tidx(), lane = tid & 63, w = __builtin_amdgcn_readfirstlane(tid >> 6), r31 = lane & 31, hh = lane >> 5;
    unit = __builtin_amdgcn_readfirstlane(unit);
    const int ub = unit & 63, g = (unit >> 6) & 3, b = unit >> 8;
    const int S0 = ub * 64, s0 = S0 + 8 * w, qi = r31 >> 2, rr = r31 & 3, tq = s0 + qi;
    const long tok = (long)b * SEQ + tq;
    LAS bf16_t* Kc = (LAS bf16_t*)(lds + NS_KC);
    LAS bf16_t* Vc = (LAS bf16_t*)(lds + NS_VC);
    LAS bf16_t* Kr = (LAS bf16_t*)(lds + NS_KR);
    LAS bf16_t* Vr = (LAS bf16_t*)(lds + NS_VR);
    LAS float* impL = (LAS float*)(lds + NS_IMP + w * 2048);
    LAS unsigned long long* unL = (LAS unsigned long long*)(lds + NS_UN);
    LAS int* tl = (LAS int*)(lds + NS_TL);
#ifdef TPROBE
#define TP(k) do { if ((k) == TPROBE_A && tid == 0) ((LAS unsigned*)(lds + 157 * 1024))[0] = (unsigned)__builtin_amdgcn_s_memrealtime(); if ((k) == TPROBE_B && unit == TPROBE_UNIT && l == 0 && tid == 0) p.err[3440] = (unsigned)__builtin_amdgcn_s_memrealtime() - ((LAS unsigned*)(lds + 157 * 1024))[0]; } while (0)
    TP(0);
#endif
    bf16x8 qf[4];
    { const bf16_t* qp = p.qn + tok * 1024 + (g * 4 + rr) * 64 + 8 * hh;
#pragma unroll
      for (int s = 0; s < 4; ++s) qf[s] = ld8(qp + 16 * s); }
#pragma unroll
    for (int k = 0; k < 8; ++k) impL[k * 64 + lane] = 0.f;
    f32x16 outacc[2];
#pragma unroll
    for (int i = 0; i < 16; ++i) { outacc[0][i] = 0.f; outacc[1][i] = 0.f; }
    const float* gl = p.small + tok * NSMALL + 8 + g * 12 + rr * 3;
    const float gate_c = sigmoidf_(gl[0]), gate_s = sigmoidf_(gl[1]), gate_w = sigmoidf_(gl[2]);
    const f32x16 zero16 = {0.f, 0.f, 0.f, 0.f, 0.f, 0.f, 0.f, 0.f, 0.f, 0.f, 0.f, 0.f, 0.f, 0.f, 0.f, 0.f};
    auto qk = [&](const LAS bf16_t* kt  ) { f32x16 acc = zero16;
#pragma unroll
        for (int s = 0; s < 4; ++s) acc = MFMA32(ld8(kt + r31 * 72 + 16 * s + 8 * hh), qf[s], acc);
        settle(acc); return acc; };
    {
        const int nvB = (S0 + 63 >= 31) ? ((S0 + 63 - 31) >> 4) + 1 : 0; const int rows = ((nvB + 31) >> 5) * 32;
        const bf16_t* kc = p.kcmp + ((long)(b * 4 + g) * 256) * 64; const bf16_t* vt = p.vcmpT + ((long)(b * 4 + g) * 64) * 256;
        for (int q = tid; q < rows * 8; q += 512) { const int row = q >> 3, c = q & 7; *(LAS u32x4*)(Kc + row * 72 + c * 8) = *(const u32x4*)(kc + (long)row * 64 + c * 8); }
        const int pc = rows >> 3;
        for (int q = tid; q < 64 * pc; q += 512) { const int d = q / pc, c = q - d * pc; *(LAS u32x4*)(Vc + d * 264 + c * 8) = *(const u32x4*)(vt + (long)d * 256 + c * 8); }
        __syncthreads();
        const int nvmax = (s0 + 7 >= 31) ? ((s0 + 7 - 31) >> 4) + 1 : 0; const int ntile = (nvmax + 31) >> 5;
        const int nv = (tq >= 31) ? ((tq - 31) >> 4) + 1 : 0;
        const int nvmin = (s0 >= 31) ? ((s0 - 31) >> 4) + 1 : 0;
#ifndef REP_PA
#define REP_PA 1
#endif
        float m = -1e30f, lsum = 0.f;
        for (int rpa = 0; rpa < REP_PA; ++rpa) { m = -1e30f; lsum = 0.f;
        for (int tI = 0; tI < ntile; ++tI) {
            const int key0 = tI * 32; f32x16 acc = qk(Kc + key0 * 72);
            if (key0 + 32 > nvmin) {
#pragma unroll
                for (int i = 0; i < 16; ++i) acc[i] = (key0 + crow(i, hh) < nv) ? acc[i] : -1e30f; }
            float mx = max16(acc); mx = fmaxf(mx, shflx<32>(mx));
            const float mn = fmaxf(m, mx), ms = fmaxf(mn, -1e20f); float ps = 0.f;
#pragma unroll
            for (int i = 0; i < 16; ++i) ps += exp2_(acc[i] - ms);
            lsum = lsum * exp2_(m - mn) + ps; m = mn;
        } }
        lsum += shflx<32>(lsum);
        const float inv = lsum > 0.f ? 1.f / lsum : 0.f;
        const float mfin = fmaxf(m, -1e20f), linv = __builtin_amdgcn_logf(fmaxf(inv, 1e-37f));
        const float sub = mfin - linv;
        f32x16 oc[2] = {zero16, zero16};
        for (int tI = 0; tI < ntile; ++tI) {
            const int key0 = tI * 32; f32x16 acc = qk(Kc + key0 * 72);
            if (key0 + 32 > nvmin) {
#pragma unroll
                for (int i = 0; i < 16; ++i) acc[i] = (key0 + crow(i, hh) < nv) ? acc[i] : -1e30f; }
#pragma unroll
            for (int i = 0; i < 16; ++i) acc[i] = exp2_(acc[i] - sub);
#pragma unroll
            for (int qd = 0; qd < 4; ++qd) { float mainv = acc[4 * qd] + acc[4 * qd + 1] + acc[4 * qd + 2] + 0.5f * acc[4 * qd + 3], sp = 0.5f * acc[4 * qd + 3];
                mainv += shflx<1>(mainv); mainv += shflx<2>(mainv); sp += shflx<1>(sp); sp += shflx<2>(sp);
                const int j = (key0 >> 2) + 2 * qd + hh;
                if (rr == 0) { __hip_atomic_fetch_add(&impL[qi * 64 + j], mainv, __ATOMIC_RELAXED, __HIP_MEMORY_SCOPE_WORKGROUP);
                    if (j + 1 < 64) __hip_atomic_fetch_add(&impL[qi * 64 + j + 1], sp, __ATOMIC_RELAXED, __HIP_MEMORY_SCOPE_WORKGROUP); } }
            { const bf16x8 pb0 = pack_step<0>(acc), pb1 = pack_step<1>(acc);
#pragma unroll
              for (int mb = 0; mb < 2; ++mb) { oc[mb] = MFMA32(ldvt_l(Vc + (32 * mb + r31) * 264 + key0 + 4 * hh), pb0, oc[mb]); oc[mb] = MFMA32(ldvt_l(Vc + (32 * mb + r31) * 264 + key0 + 16 + 4 * hh), pb1, oc[mb]); } }
        }
        settle(oc[0], oc[1]);
#pragma unroll
        for (int i = 0; i < 16; ++i) { outacc[0][i] = gate_c * oc[0][i]; outacc[1][i] = gate_c * oc[1][i]; }
    }
    lds_wait();
#ifdef TPROBE
    TP(1);
#endif
    unsigned long long mymask = 0ull, un = 0ull;
    {
        const int cur = S0 >> 6;
        if (cur < 16) {
            mymask = un = (2ull << cur) - 1ull;
        } else {
#ifndef REP_SEL
#define REP_SEL 1
#endif
#pragma unroll 1
            for (int q2x = 0; q2x < 8 * REP_SEL; ++q2x) { const int q2 = q2x & 7; if (q2x >= 8 && q2 == 0) { un = 0ull; }
                const float v = impL[q2 * 64 + lane];
                const bool forced = (lane == 0) || (lane == cur) || (lane == cur - 1), started = lane <= cur;
                const unsigned key = forced ? (0xffffffc0u | (unsigned)(63 - lane)) : (started ? ((__float_as_uint(v) & ~63u) | (unsigned)(63 - lane)) : 0u);
                int rank = 0;
#pragma unroll 32
                for (int jj = 0; jj < 64; ++jj) { const unsigned o = (unsigned)__builtin_amdgcn_readlane((int)key, jj); rank += (o > key) ? 1 : 0; }
                const unsigned long long mk = __ballot(rank < 16 && started);
                if (qi == q2) mymask = mk;
                un |= mk;
            }
        }
    }
    if (lane == 0) unL[w] = un;
    __syncthreads();
    if (tid == 0) { unsigned long long U = 0ull; for (int k = 0; k < 8; ++k) U |= unL[k]; int n = 0; while (U) { const int j = __builtin_ctzll(U); U &= U - 1ull; tl[1 + n] = 64 * j; ++n; } tl[0] = n; }
    __syncthreads();
    const int nsl = __builtin_amdgcn_readfirstlane(tl[0]);
    LAS float* oL = (LAS float*)(lds + w * 8192);
#pragma unroll
    for (int mb = 0; mb < 2; ++mb)
#pragma unroll
        for (int i = 0; i < 16; ++i) oL[(mb * 16 + i) * 64 + lane] = outacc[mb][i];
#ifdef TPROBE
    TP(2);
#endif
    const int prow = tid >> 3, pcol = (tid & 7) * 8;
    auto branch = [&](const bf16_t* kb, const bf16_t* vt, int nt, auto&& k0of, auto&& need_fn, auto&& mask_fn, float gate, bool keep) {
        float m = -1e30f, lsum = 0.f; f32x16 o[2] = {zero16, zero16};
        auto gload = [&](int K0, u32x4& kr, u32x4& vr) { kr = *(const u32x4*)(kb + (long)(K0 + prow) * 64 + pcol); vr = *(const u32x4*)(vt + (long)prow * SEQ + K0 + pcol); };
        auto lwrite = [&](int slot, const u32x4& kr, const u32x4& vr) { *(LAS u32x4*)(Kr + slot * 4608 + prow * 72 + pcol) = kr; *(LAS u32x4*)(Vr + slot * 4608 + prow * 72 + pcol) = vr; };
        auto process = [&](int key0, const LAS bf16_t* kt, const LAS bf16_t* vtl  ) {
            f32x16 acc = qk(kt);
            const bool dead = mask_fn(key0, acc);
            float mx = dead ? -1e30f : max16(acc); mx = fmaxf(mx, shflx<32>(mx));
            const float mn = fmaxf(m, mx), alpha = exp2_(m - mn), ms = dead ? 1e30f : fmaxf(mn, -1e20f); float ps = 0.f;
#pragma unroll
            for (int i = 0; i < 16; ++i) { acc[i] = exp2_(acc[i] - ms); ps += acc[i]; }
            lsum = lsum * alpha + ps; m = mn;
            if (__any(alpha != 1.f)) {
#pragma unroll
                for (int i = 0; i < 16; ++i) { o[0][i] *= alpha; o[1][i] *= alpha; } }
            const bf16x8 pb0 = pack_step<0>(acc), pb1 = pack_step<1>(acc);
#pragma unroll
            for (int mb = 0; mb < 2; ++mb) o[mb] = MFMA32(ldvt_l(vtl + (32 * mb + r31) * 72 + 4 * hh), pb0, o[mb]);
#pragma unroll
            for (int mb = 0; mb < 2; ++mb) o[mb] = MFMA32(ldvt_l(vtl + (32 * mb + r31) * 72 + 16 + 4 * hh), pb1, o[mb]); };
        auto process2 = [&](int K0, const LAS bf16_t* kt, const LAS bf16_t* vtl) {
            f32x16 a0 = zero16, a1 = zero16;
#pragma unroll
            for (int s = 0; s < 4; ++s) { a0 = MFMA32(ld8(kt + r31 * 72 + 16 * s + 8 * hh), qf[s], a0); a1 = MFMA32(ld8(kt + (32 + r31) * 72 + 16 * s + 8 * hh), qf[s], a1); }
            settle(a0, a1);
            const bool d0 = mask_fn(K0, a0), d1 = mask_fn(K0 + 32, a1);
            float mx = fmaxf(d0 ? -1e30f : max16(a0), d1 ? -1e30f : max16(a1)); mx = fmaxf(mx, shflx<32>(mx));
            const float mn = fmaxf(m, mx), alpha = exp2_(m - mn), msv = fmaxf(mn, -1e20f), ms0 = d0 ? 1e30f : msv, ms1 = d1 ? 1e30f : msv; float ps = 0.f;
#pragma unroll
            for (int i = 0; i < 16; ++i) { a0[i] = exp2_(a0[i] - ms0); a1[i] = exp2_(a1[i] - ms1); ps += a0[i] + a1[i]; }
            lsum = lsum * alpha + ps; m = mn;
            if (__any(alpha != 1.f)) {
#pragma unroll
                for (int i = 0; i < 16; ++i) { o[0][i] *= alpha; o[1][i] *= alpha; } }
            const bf16x8 p00 = pack_step<0>(a0), p01 = pack_step<1>(a0), p10 = pack_step<0>(a1), p11 = pack_step<1>(a1);
#pragma unroll
            for (int mb = 0; mb < 2; ++mb) o[mb] = MFMA32(ldvt_l(vtl + (32 * mb + r31) * 72 + 4 * hh), p00, o[mb]);
#pragma unroll
            for (int mb = 0; mb < 2; ++mb) o[mb] = MFMA32(ldvt_l(vtl + (32 * mb + r31) * 72 + 16 + 4 * hh), p01, o[mb]);
#pragma unroll
            for (int mb = 0; mb < 2; ++mb) o[mb] = MFMA32(ldvt_l(vtl + (32 * mb + r31) * 72 + 32 + 4 * hh), p10, o[mb]);
#pragma unroll
            for (int mb = 0; mb < 2; ++mb) o[mb] = MFMA32(ldvt_l(vtl + (32 * mb + r31) * 72 + 48 + 4 * hh), p11, o[mb]); };
        auto gload_a = [&](int K0, u32x4& kr, u32x4& vr) {
            const bf16_t* kp = kb + (long)(K0 + prow) * 64 + pcol; const bf16_t* vp = vt + (long)prow * SEQ + K0 + pcol;
            asm volatile("global_load_dwordx4 %0, %2, off\n\tglobal_load_dwordx4 %1, %3, off" : "=&v"(kr), "=&v"(vr) : "v"(kp), "v"(vp) : "memory"); };
        auto step = [&](int i, u32x4& kNext, u32x4& vNext, u32x4& kFar, u32x4& vFar) {
            gload_a(k0of(min(i + 3, nt - 1)), kFar, vFar);
            const int K0 = k0of(i); const int slot = i & 1;
            const bool n0 = need_fn(K0), n1 = need_fn(K0 + 32);
            if (n0 && n1) process2(K0, Kr + slot * 4608, Vr + slot * 4608);
            else if (n0) process(K0, Kr + slot * 4608, Vr + slot * 4608);
            else if (n1) process(K0 + 32, Kr + slot * 4608 + 32 * 72, Vr + slot * 4608 + 32);
            asm volatile("s_waitcnt vmcnt(4)" : "+v"(kNext), "+v"(vNext) :: "memory");
            if (i + 1 < nt) lwrite((i + 1) & 1, kNext, vNext);
            __syncthreads(); };
        u32x4 k0r, v0r, k1r, v1r, k2r, v2r;
        if (nt > 0) {
            gload_a(k0of(0), k0r, v0r); gload_a(k0of(min(1, nt - 1)), k1r, v1r); gload_a(k0of(min(2, nt - 1)), k2r, v2r);
            asm volatile("s_waitcnt vmcnt(4)" : "+v"(k0r), "+v"(v0r) :: "memory");
            lwrite(0, k0r, v0r);
        }
        __syncthreads();
        for (int i = 0; i < nt; i += 3) {
            step(i, k1r, v1r, k0r, v0r);
            if (i + 1 < nt) step(i + 1, k2r, v2r, k1r, v1r);
            if (i + 2 < nt) step(i + 2, k0r, v0r, k2r, v2r);
        }
        if (nt > 0) asm volatile("s_waitcnt vmcnt(0)" : "+v"(k0r), "+v"(v0r), "+v"(k1r), "+v"(v1r), "+v"(k2r), "+v"(v2r) :: "memory");
        settle(o[0], o[1]);
        lsum += shflx<32>(lsum);
        const float sc = lsum > 0.f ? gate / lsum : 0.f;
#pragma unroll
        for (int mb = 0; mb < 2; ++mb)
#pragma unroll
            for (int i = 0; i < 16; ++i) oL[(mb * 16 + i) * 64 + lane] += keep ? sc * o[mb][i] : 0.f;
    };
    {
        const bf16_t* kb = p.ksn + ((long)(b * 4 + g) * SEQ) * 64; const bf16_t* vt = p.vsT + ((long)(b * 4 + g) * 64) * SEQ;
        const unsigned long long mm = mymask, myun = un;
#ifndef REP_SLC
#define REP_SLC 1
#define REP_WIN 1
#endif
        for (int rep = 0; rep < REP_SLC; ++rep)
        branch(kb, vt, nsl, [&](int i) { return __builtin_amdgcn_readfirstlane(tl[1 + i]); },
               [&](int key0) { return ((myun >> (key0 >> 6)) & 1ull) != 0ull && key0 <= s0 + 7; },
               [&](int key0, f32x16& acc) { const bool rowsel = ((mm >> (key0 >> 6)) & 1ull) != 0ull;
                   if (key0 + 31 <= s0) return !rowsel;
#pragma unroll
                   for (int i = 0; i < 16; ++i) acc[i] = (rowsel && key0 + crow(i, hh) <= tq) ? acc[i] : -1e30f;
                   return false; }, gate_s, rep == 0);
    }
#ifdef TPROBE
    TP(3);
#endif
    {
        const bf16_t* kb = p.kwn + ((long)(b * 4 + g) * SEQ) * 64; const bf16_t* vt = p.vwT + ((long)(b * 4 + g) * 64) * SEQ;
        const int T_lo = max(0, S0 - 511) >> 6, T_hi = (S0 + 63) >> 6;
        const int k_lo = (max(0, s0 - 511) >> 5) * 32, k_hi = ((s0 + 7) >> 5) * 32;
        for (int rep = 0; rep < REP_WIN; ++rep)
        branch(kb, vt, T_hi - T_lo + 1, [&](int i) { return (T_lo + i) * 64; },
               [&](int key0) { return key0 >= k_lo && key0 <= k_hi; },
               [&](int key0, f32x16& acc) {
                   if (!(key0 + 31 <= s0 && key0 > s0 + 7 - 512)) {
#pragma unroll
                       for (int i = 0; i < 16; ++i) { const int pos = key0 + crow(i, hh); acc[i] = (pos <= tq && pos > tq - 512) ? acc[i] : -1e30f; } }
                   return false; }, gate_w, rep == 0);
    }
    bf16_t* dst = p.mix + tok * D + 1024 + (g * 4 + rr) * 64;
#pragma unroll
    for (int mb = 0; mb < 2; ++mb)
#pragma unroll
        for (int qd = 0; qd < 4; ++qd) { const LAS float* q = oL + (mb * 16 + 4 * qd) * 64 + lane; u32x2 o; o.x = pk2(q[0], q[64]); o.y = pk2(q[128], q[192]);
            *(u32x2*)(dst + 32 * mb + 8 * qd + 4 * hh) = o; }
    __syncthreads();
#ifdef TPROBE
    TP(4);
    if (unit == TPROBE_UNIT && l == 0 && tid == 0) p.err[3445] = (unsigned)nsl;
#endif
}
DI void s5_glu_item(CP p, int l, int item, LAS char* lds) {
    const int tid = tidx(), lane = tid & 63, w = __builtin_amdgcn_readfirstlane(tid >> 6), fr = lane & 15, fq = lane >> 4;
    const long tok0 = (long)item * 64;
    LAS bf16_t* Ys = (LAS bf16_t*)lds;
    LAS float* red = (LAS float*)(lds + 64 * 520 * 2);
#pragma unroll
    for (int i = 0; i < 8; ++i) { const int e = tid + i * 512, r = e >> 6, c = e & 63; *(LAS u32x4*)(Ys + r * 520 + c * 8) = *(const u32x4*)(p.s5y + (tok0 + r) * 512 + c * 8); }
    __syncthreads();
    f32x4 acc[4][4];
#pragma unroll
    for (int nb = 0; nb < 4; ++nb)
#pragma unroll
        for (int it = 0; it < 4; ++it) acc[nb][it] = ZERO4;
    const bf16_t* gw = p.gluT + l * LW_GLU + (long)(w * 64 + fr) * 512 + 8 * fq;
#pragma unroll 8
    for (int ks = 0; ks < 16; ++ks) {
        bf16x8 a[4], bb[4];
#pragma unroll
        for (int it = 0; it < 4; ++it) a[it] = ld8(Ys + (it * 16 + fr) * 520 + ks * 32 + 8 * fq);
#pragma unroll
        for (int nb = 0; nb < 4; ++nb) bb[nb] = ld8(gw + (long)nb * 16 * 512 + ks * 32);
#pragma unroll
        for (int nb = 0; nb < 4; ++nb)
#pragma unroll
            for (int it = 0; it < 4; ++it) acc[nb][it] = MFMA16(bb[nb], a[it], acc[nb][it]);
    }
    settle(acc[0][0], acc[0][1], acc[0][2], acc[0][3], acc[1][0], acc[1][1], acc[1][2], acc[1][3]);
    settle(acc[2][0], acc[2][1], acc[2][2], acc[2][3], acc[3][0], acc[3][1], acc[3][2], acc[3][3]);
#pragma unroll
    for (int it = 0; it < 4; ++it) { const int i = it * 16 + fr; float s = 0.f;
#pragma unroll
        for (int nb = 0; nb < 4; ++nb) { const int n0 = w * 64 + nb * 16 + 4 * fq;
            const u32x2 yy = *(const LAS u32x2*)(Ys + i * 520 + n0); const f32x4 gb = *(const f32x4*)(p.in[I_GLU_B] + l * 512 + n0);
            const float y0 = __uint_as_float(yy.x << 16), y1 = __uint_as_float(yy.x & 0xffff0000u), y2 = __uint_as_float(yy.y << 16), y3 = __uint_as_float(yy.y & 0xffff0000u);
            f32x4 v = acc[nb][it]; v[0] = y0 * sigmoidf_(v[0] + gb[0]); v[1] = y1 * sigmoidf_(v[1] + gb[1]); v[2] = y2 * sigmoidf_(v[2] + gb[2]); v[3] = y3 * sigmoidf_(v[3] + gb[3]);
            acc[nb][it] = v; s += v[0] * v[0] + v[1] * v[1] + v[2] * v[2] + v[3] * v[3]; }
        s += shflx<16>(s); s += shflx<32>(s);
        if (fq == 0) red[w * 64 + i] = s; }
    __syncthreads();
#pragma unroll
    for (int it = 0; it < 4; ++it) { const int i = it * 16 + fr; float tot = 0.f;
#pragma unroll
        for (int ww = 0; ww < 8; ++ww) tot += red[ww * 64 + i];
        const float rstd = rsqrtf(tot * (1.f / 512.f) + EPS);
#pragma unroll
        for (int nb = 0; nb < 4; ++nb) { const int n0 = w * 64 + nb * 16 + 4 * fq; const f32x4 gn = *(const f32x4*)(p.in[I_S5NORM] + l * 512 + n0); const f32x4 v = acc[nb][it];
            u32x2 o; o.x = pk2(v[0] * rstd * gn[0], v[1] * rstd * gn[1]); o.y = pk2(v[2] * rstd * gn[2], v[3] * rstd * gn[3]);
            *(u32x2*)(p.mix + (tok0 + i) * D + n0) = o; } }
    __syncthreads();
}

DI void nsa_outnorm(CP p, int l) {
    const int lane = tidx() & 63, gw = bidx() * 8 + __builtin_amdgcn_readfirstlane(tidx() >> 6), nw = gdim() * 8;
    const float* gain = p.in[I_NSA_NORM] + l * 1024 + lane * 16;
    for (int t0 = gw; t0 < T; t0 += 4 * nw) {
        bf16x8 v0[4], v1[4]; float ss[4];
#pragma unroll
        for (int q = 0; q < 4; ++q) { const int t = min(t0 + q * nw, T - 1); const bf16_t* row = p.mix + (long)t * D + 1024 + lane * 16; v0[q] = ld8(row); v1[q] = ld8(row + 8); }
#pragma unroll
        for (int q = 0; q < 4; ++q) { float s = 0.f;
#pragma unroll
            for (int e = 0; e < 8; ++e) { const float a = bf2f((bf16_t)v0[q][e]), b = bf2f((bf16_t)v1[q][e]); s += a * a + b * b; }
            ss[q] = s; }
#pragma unroll
        for (int q = 0; q < 4; ++q) ss[q] += shflx<1>(ss[q]);
#pragma unroll
        for (int q = 0; q < 4; ++q) ss[q] += shflx<2>(ss[q]);
#pragma unroll
        for (int q = 0; q < 4; ++q) ss[q] += shflx<4>(ss[q]);
#pragma unroll
        for (int q = 0; q < 4; ++q) ss[q] += shflx<8>(ss[q]);
#pragma unroll
        for (int q = 0; q < 4; ++q) ss[q] += shflx<16>(ss[q]);
#pragma unroll
        for (int q = 0; q < 4; ++q) ss[q] += shflx<32>(ss[q]);
#pragma unroll
        for (int q = 0; q < 4; ++q) { const int t = t0 + q * nw; if (t < T) {
            bf16_t* row = p.mix + (long)t * D + 1024 + lane * 16;
            const float rstd = rsqrtf(ss[q] * (1.f / 1024.f) + EPS);
            u32x4 o0, o1;
#pragma unroll
            for (int e = 0; e < 4; ++e) { o0[e] = pk2(bf2f((bf16_t)v0[q][2 * e]) * rstd * gain[2 * e], bf2f((bf16_t)v0[q][2 * e + 1]) * rstd * gain[2 * e + 1]);
                o1[e] = pk2(bf2f((bf16_t)v1[q][2 * e]) * rstd * gain[8 + 2 * e], bf2f((bf16_t)v1[q][2 * e + 1]) * rstd * gain[9 + 2 * e]); }
            *(u32x4*)row = o0; *(u32x4*)(row + 8) = o1; } }
    }
}

DI void p6_outproj(CP p, int l, LAS char* lds) {
    unsigned aoff[2][2], boff[2];
#pragma unroll
    for (int i = 0; i < 2; ++i) { int R, C; g8::my_rc(i, R, C); boff[i] = (unsigned)(R * D + C) * 2u; aoff[0][i] = boff[i]; aoff[1][i] = (unsigned)((128 + R) * D + C) * 2u; }
    const float* xres = l == 0 ? p.in[I_X] : p.out; const float* lnf = p.in[I_LN_FFN] + l * D;
    for (int u = bidx();; u += gdim()) {
        int pm, pn; if (!g8::unit_of(u, T / 256, D / 256, pm, pn)) break;
        float* hh = p.h; bf16_t* hb = p.xb;
        g8::gemm_tile(lds, (const char*)(p.mix + (long)pm * 256 * D), aoff, 128, (const char*)(p.WoutT + l * LW_WOUT + (long)pn * 256 * D), boff, 128L * D * 2, D / 64, [&](const Acc& acc, int rb, int cb) {
            ACC_FOR(ai, m, bj, n) { const int r = ai * 128 + m * 16 + rb, c = bj * 128 + n * 16 + cb; const long off = (long)(pm * 256 + r) * D + pn * 256 + c;
                const f32x4 v = acc[ai][bj][m][n] + *(const f32x4*)(xres + off);
                const f32x4 g4 = *(const f32x4*)(lnf + pn * 256 + c);
                *(f32x4*)(hh + off) = v; u32x2 w; w.x = pk2h(v[0] * g4[0], v[1] * g4[1]); w.y = pk2h(v[2] * g4[2], v[3] * g4[3]); *(u32x2*)(hb + off) = w; }
        });
    }
}

DI void router_phase(CP p, int l, LAS char* lds) {
    const int tid = tidx(), lane = tid & 63, w = __builtin_amdgcn_readfirstlane(tid >> 6), fr = lane & 15, fq = lane >> 4, half = w & 1;
    for (int tg0 = bidx() * 4; tg0 < T / 16; tg0 += gdim() * 4) {
        const long t0 = (long)(tg0 + (w >> 1)) * 16;
        f32x4 acc[3] = {ZERO4, ZERO4, ZERO4}; float ss = 0.f;
        const float* hr = p.h + (t0 + fr) * D + half * (D / 2) + 4 * fq; const float* wr = p.Wr + (long)fr * D + half * (D / 2) + 4 * fq;
#pragma unroll 4
        for (int k0 = 0; k0 < D / 2; k0 += 16) {
            const f32x4 hv = *(const f32x4*)(hr + k0);
            f32x4 wv[3];
#pragma unroll
            for (int nb = 0; nb < 3; ++nb) wv[nb] = *(const f32x4*)(wr + (long)nb * 16 * D + k0);
            ss += hv[0] * hv[0] + hv[1] * hv[1] + hv[2] * hv[2] + hv[3] * hv[3];
#pragma unroll
            for (int jx = 0; jx < 4; ++jx)
#pragma unroll
                for (int nb = 0; nb < 3; ++nb) acc[nb] = __builtin_amdgcn_mfma_f32_16x16x4f32(hv[jx], wv[nb][jx], acc[nb], 0, 0, 0);
        }
        settle(acc[0], acc[1]); settle(acc[2]);
        ss += shflx<16>(ss); ss += shflx<32>(ss);
        LAS float* lg = (LAS float*)(lds + w * 16384);
        if (fq == 0) lg[16 * 48 + fr] = ss;
#pragma unroll
        for (int nb = 0; nb < 3; ++nb)
#pragma unroll
            for (int j = 0; j < 4; ++j) lg[(4 * fq + j) * 48 + nb * 16 + fr] = acc[nb][j];
        __syncthreads();
        if (half == 0 && lane < 16) {
            const LAS float* q0 = lg + lane * 48; const LAS float* q1 = (const LAS float*)(lds + (w + 1) * 16384) + lane * 48;
            const long t = t0 + lane; const float rs = rsqrtf((lg[16 * 48 + lane] + ((const LAS float*)(lds + (w + 1) * 16384))[16 * 48 + lane]) * (1.f / D) + EPS);
            float gl[4]; int grp = 0; float gm = -3.4e38f;
#pragma unroll
            for (int i = 0; i < 4; ++i) { gl[i] = (q0[i] + q1[i]) * rs + p.in[I_GROUP_B][l * 4 + i]; if (gl[i] > gm) { gm = gl[i]; grp = i; } }
            float se = 0.f;
#pragma unroll
            for (int i = 0; i < 4; ++i) se += expf(gl[i] - gm);
            const float pg = 1.f / se;
            float v0 = -3.4e38f, v1 = -3.4e38f; int i0 = 0, i1 = 0;
#pragma unroll
            for (int i = 0; i < 8; ++i) { const float e = (q0[4 + grp * 8 + i] + q1[4 + grp * 8 + i]) * rs + p.in[I_EXPERT_B][l * 32 + grp * 8 + i];
                if (e > v0) { v1 = v0; i1 = i0; v0 = e; i0 = i; } else if (e > v1) { v1 = e; i1 = i; } }
            const float w0 = 1.f / (1.f + expf(v1 - v0)), w1 = 1.f - w0;
            const int e0 = grp * 8 + i0, e1 = grp * 8 + i1;
            int* cnt = p.cnt + l * 32;
            const int p0 = atomicAdd(cnt + e0, 1), p1 = atomicAdd(cnt + e1, 1);
            p.tok_list[e0 * T + p0] = (int)t; p.w_list[e0 * T + p0] = w0 * pg;
            p.tok_list[e1 * T + p1] = (int)t; p.w_list[e1 * T + p1] = w1 * pg;
            int* ti = p.tokinfo + t * 4; ti[0] = e0; ti[1] = p0; ti[2] = e1; ti[3] = p1;
            p.rstd_ffn[t] = rs;
        }
        __syncthreads();
    }
}

DI void moe_table(CP p, int l, LAS int* tab) {
    if (tidx() < 64) { const int lane = tidx(); const int c = lane < 32 ? p.cnt[l * 32 + lane] : 0; const int ntl = (c + 255) >> 8; int inc = ntl;
#pragma unroll
        for (int o = 1; o < 32; o <<= 1) { const int v = shfl_up_i(inc, o, lane); if ((lane & 31) >= o) inc += v; }
        if (lane < 32) { tab[lane] = inc - ntl; tab[64 + lane] = c; if (lane == 31) tab[32] = inc; } }
    __syncthreads();
}
DI void p8_moe_up(CP p, int l, LAS char* lds) {
    LAS int* tab = (LAS int*)(lds + 140 * 1024);
    moe_table(p, l, tab);
    const int ntiles = tab[32];
    unsigned aoff[2][2], boff[2];
#pragma unroll
    for (int i = 0; i < 2; ++i) { int R, C; g8::my_rc(i, R, C); boff[i] = (unsigned)(R * D + C) * 2u; }
    for (int u = bidx(); u < ntiles * 4; u += gdim()) {
        const int tile = u >> 2, pn = u & 3;
        const int e = __popcll(__ballot((tidx() & 63) < 32 && tab[tidx() & 31] <= tile)) - 1;
        const int mt = tile - tab[e], cnt_e = tab[64 + e];
        const int* tl = p.tok_list + e * T;
#pragma unroll
        for (int h = 0; h < 2; ++h)
#pragma unroll
            for (int i = 0; i < 2; ++i) { int R, C; g8::my_rc(i, R, C); const int pos = mt * 256 + h * 128 + R; const int tk = tl[pos < cnt_e ? pos : 0];
                aoff[h][i] = (unsigned)(((long)tk * D + C) * 2); }
        bf16_t* hid = p.hid; const float* rsf = p.rstd_ffn;
        g8::gemm_tile(lds, (const char*)p.xb, aoff, 128, (const char*)(p.WguT + l * LW_WGU + ((long)e * 1024 + pn * 256) * D), boff, 128L * D * 2, D / 64, [&](const Acc& acc, int rb, int cb) {
#pragma unroll
            for (int ai = 0; ai < 2; ++ai)
#pragma unroll
                for (int m = 0; m < 4; ++m) { const int r = ai * 128 + m * 16 + rb; const int pos = mt * 256 + r; const float rs = rsf[tl[pos < cnt_e ? pos : 0]];
#pragma unroll
                    for (int n = 0; n < 2; ++n) { const f32x4 gt = acc[ai][0][m][n] * rs, up = acc[ai][1][m][n] * rs;
                        u32x2 o; o.x = pk2h(siluf_(gt[0]) * up[0], siluf_(gt[1]) * up[1]); o.y = pk2h(siluf_(gt[2]) * up[2], siluf_(gt[3]) * up[3]);
                        *(u32x2*)(hid + ((long)tile * 256 + r) * DEXP + pn * 128 + n * 16 + cb) = o; } }
        });
    }
}
DI void p9_moe_down(CP p, int l, LAS char* lds) {
    LAS int* tab = (LAS int*)(lds + 140 * 1024);
    moe_table(p, l, tab);
    const int ntiles = tab[32];
    unsigned aoff[2][2], boff[2];
#pragma unroll
    for (int i = 0; i < 2; ++i) { int R, C; g8::my_rc(i, R, C); boff[i] = (unsigned)(R * DEXP + C) * 2u; aoff[0][i] = boff[i]; aoff[1][i] = (unsigned)((128 + R) * DEXP + C) * 2u; }
    for (int u = bidx(); u < ntiles * 8; u += gdim()) {
        const int tile = u >> 3, pn = u & 7;
        const int e = __popcll(__ballot((tidx() & 63) < 32 && tab[tidx() & 31] <= tile)) - 1;
        const int mt = tile - tab[e], cnt_e = tab[64 + e];
        bf16_t* yb = p.ybuf; const float* wl_ = p.w_list + e * T;
        g8::gemm_tile(lds, (const char*)(p.hid + (long)tile * 256 * DEXP), aoff, 128, (const char*)(p.WdT + l * LW_WD + ((long)e * D + pn * 256) * DEXP), boff, 128L * DEXP * 2, DEXP / 64, [&](const Acc& acc, int rb, int cb) {
#pragma unroll
            for (int ai = 0; ai < 2; ++ai)
#pragma unroll
                for (int m = 0; m < 4; ++m) { const int r = ai * 128 + m * 16 + rb; const int pos = mt * 256 + r; const float wt = pos < cnt_e ? wl_[pos] : 0.f;
#pragma unroll
                    for (int bj = 0; bj < 2; ++bj)
#pragma unroll
                        for (int n = 0; n < 2; ++n) { const f32x4 v = acc[ai][bj][m][n] * wt; u32x2 o; o.x = pk2h(v[0], v[1]); o.y = pk2h(v[2], v[3]);
                            *(u32x2*)(yb + ((long)tile * 256 + r) * D + pn * 256 + bj * 128 + n * 16 + cb) = o; } }
        });
    }
}
constexpr int NPH = 19;
#define XCD_BAR_WORDS 3456
#ifndef PH_EN
#define PH_EN 0xffffffffu
#endif
#define EN(i) ((PH_EN >> (i)) & 1u)
#ifndef REP_CV
#define REP_CV 1
#endif
#ifndef NCONV
#define NCONV 64
#endif
#ifndef MULTI_LAUNCH
#define MULTI_LAUNCH 0
#endif
typedef const __attribute__((address_space(4))) Params* CPP;
template <int PH>
DI void run_phase(LAS char* lds_) {
    unsigned lbase = (unsigned)(size_t)lds_; asm volatile("" : "+s"(lbase)); LAS char* lds = (LAS char*)(size_t)lbase;
    CPP pp = (CPP)__builtin_amdgcn_kernarg_segment_ptr();
    asm volatile("" : "+s"(pp));
    CP p = *pp;
    const int tid = tidx(), w = __builtin_amdgcn_readfirstlane(tid >> 6), G = gdim();
    LAS char* wl = lds + w * 16384;
    const int gw = bidx() * 8 + w, nw = G * 8;
    if constexpr (PH == 0 || PH == 9) {
        if (EN(0)) { if (PH == 0) { tconv_range(p, 0, 0, TCONV_EARLY, bidx(), G, lds); tconv_narrow(p, 0, bidx(), G, lds); } p0_tables(p, PH == 9 ? 1 : 0, lds); }
        if (PH == 0) p0_once(p);
        if (EN(1)) p1_rows(p, PH == 9 ? 1 : 0, 0, PH == 9 ? 1 : 0);
    } else if constexpr (PH == 18) {
        if (EN(1)) p1_rows(p, 2, 1, 0);
    } else {
        constexpr int l = PH >= 10 ? 1 : 0; constexpr int k = PH - (l ? 10 : 1);
        if constexpr (k == 0) { if (EN(2)) p2_inproj(p, l, lds); }
        else if constexpr (k == 1) {
#ifndef REP_A
#define REP_A 1
#define REP_B 1
#define REP_C 1
#define REP_D 1
#endif
            if (EN(3)) for (int rep = 0; rep < REP_A; ++rep) for (int u = bidx(); u < 32; u += G) nsa_cmp_unit(p, l, u, lds);
            if (EN(6)) for (int rep = 0; rep < REP_D; ++rep) { nsa_prep_elem(p, l); nsa_vtrans(p, wl); }
            LAS int* shp = (LAS int*)(lds + 156 * 1024);
            if (EN(4)) {
                for (;;) {
                    __syncthreads();
                    if (tid == 0) shp[0] = atomicAdd(p.cnt + 68 + l, 1);
                    __syncthreads();
                    const int it = shp[0];
                    if (it >= 1024 * REP_B) break;
                    gdn_prep_item(p, l, it & 1023, lds);
                }
            }
            if (EN(5)) for (;;) {
                __syncthreads();
                if (tid == 0) shp[0] = atomicAdd(p.cnt + 74 + l, 1);
                __syncthreads();
                const int base = shp[0];
                if (base >= 1024 * REP_C) break;
                s5_item(p, l, (base & 1023) * 8 + w, 1, wl);
            }
        } else if constexpr (k == 2) {
            if (EN(7)) if (bidx() < 16) gdn_chain(p, bidx(), lds);
            if (EN(0)) {
                const int cv0 = G >= 16 + NCONV ? 16 : 0, nb = G >= 16 + NCONV ? NCONV : G, bi = bidx() - cv0;
                if (bi >= 0 && bi < nb) {
                    tconv_range(p, l, TCONV_EARLY + (((T / 256) * (NPROJ / 256)) % G != 0 ? TCONV_TAIL : 0), TCONV_FULL, bi, nb, lds);
                    if (l == 0) { tconv_range(p, 1, 0, TCONV_EARLY, bi, nb, lds); tconv_narrow(p, 1, bi, nb, lds); }
                }
            }
            LAS int* sh = (LAS int*)(lds + 150 * 1024);
            __syncthreads();
#ifdef STATIC_ATT
#ifndef REP_ATT
#define REP_ATT 1
#endif
            if (EN(9)) for (int rep = 0; rep < REP_ATT; ++rep) for (int it = bidx(); it < 1024; it += G) { __syncthreads(); if (tid == 0) sh[0] = it; __syncthreads(); nsa_unit(p, l, sh[0], lds); }
#else
            const int q0 = (int)(__builtin_amdgcn_s_getreg((3 << 11) | 20) & 7u);
            for (int qq = 0; qq < 8; ++qq) { const int q = (q0 + qq) & 7;
                for (;;) {
                    __syncthreads();
                    if (tid == 0) sh[0] = atomicAdd(p.cnt + 96 + l * 8 + q, 1);
                    __syncthreads();
                    const int base = sh[0];
                    if (base >= 128) break;
                    if (EN(9)) nsa_unit(p, l, q * 128 + 127 - base, lds);
                } }
#endif
            for (;;) {
                __syncthreads();
                if (tid == 0) sh[0] = atomicAdd(p.cnt + 72 + l, 1);
                __syncthreads();
                const int base = sh[0];
                if (base >= 1024) break;
                if (EN(8)) s5_item(p, l, base * 8 + w, 2, wl);
            }
        } else if constexpr (k == 3) {
#ifndef REP_G
#define REP_G 1
#define REP_O 1
#endif
            if (EN(10)) for (int it = bidx(); it < 256 * REP_G; it += G) s5_glu_item(p, l, it & 255, lds);
            if (EN(11)) for (int it = bidx(); it < 1024 * REP_O; it += G) gdn_out_item(p, l, it & 1023, lds);
            if (EN(12)) nsa_outnorm(p, l);
        } else if constexpr (k == 4) { if (EN(13)) p6_outproj(p, l, lds); }
        else if constexpr (k == 5) { if (EN(14)) router_phase(p, l, lds); }
        else if constexpr (k == 6) { if (EN(15)) p8_moe_up(p, l, lds); }
        else { if (EN(16)) p9_moe_down(p, l, lds); }
    }
}
#if MULTI_LAUNCH
template <int PH>
__global__ void __launch_bounds__(512) phase_k(Params p_) {
    extern __shared__ __attribute__((aligned(16))) char smem_raw[];
    run_phase<PH>((LAS char*)smem_raw);
}
#ifndef DBG_STOP
#define DBG_STOP 99
#endif
#ifndef DBG_SRC
#define DBG_SRC 0
#endif
__global__ void dbg_copy(Params p) {
    const long n = (long)T * D;
    for (long i = (long)blockIdx.x * blockDim.x + threadIdx.x; i < n; i += (long)gridDim.x * blockDim.x) {
        const long t = i / D, c = i % D; float v;
        if (DBG_SRC == 0) v = p.h[i];
        else if (DBG_SRC == 1) v = bf2f(p.mix[i]);
        else if (DBG_SRC == 2) v = bf2f(p.proj[t * NPROJ + c]);
        else if (DBG_SRC == 3) v = bf2f(p.xb[i]);
        else if (DBG_SRC == 5) v = bf2f(p.proj[t * NPROJ + 2560 + c]);
        else if (DBG_SRC == 6) v = c < 512 ? bf2f(p.s5y[t * 512 + c]) : (c < 1536 ? bf2f(p.qn[t * 1024 + c - 512]) : bf2f(p.ksn[t * 256 + (c - 1536) % 256]));
        else if (DBG_SRC == 8) { const int* ti = p.tokinfo + t * 4; const int k = (int)(c & 3); v = k == 0 ? (float)ti[0] : k == 1 ? (float)ti[2] : k == 2 ? p.w_list[ti[0] * T + ti[1]] : p.w_list[ti[2] * T + ti[3]] + p.rstd_ffn[t]; }
        else if (DBG_SRC == 9) { const int* ti = p.tokinfo + t * 4; int ts0 = 0, ts1 = 0; for (int e = 0; e < 32; ++e) { const int nt_ = (p.cnt[e] + 255) >> 8; if (e < ti[0]) ts0 += nt_; if (e < ti[2]) ts1 += nt_; }
            const long s0 = (long)ts0 * 256 + ti[1], s1 = (long)ts1 * 256 + ti[3]; v = c < 1024 ? bf2f(p.hid[s0 * 512 + (c & 511)]) : bf2f(p.hid[s1 * 512 + (c & 511)]); }
        else if (DBG_SRC == 10) { const int* ti = p.tokinfo + t * 4; int ts0 = 0, ts1 = 0; for (int e = 0; e < 32; ++e) { const int nt_ = (p.cnt[e] + 255) >> 8; if (e < ti[0]) ts0 += nt_; if (e < ti[2]) ts1 += nt_; }
            const long s0 = (long)ts0 * 256 + ti[1], s1 = (long)ts1 * 256 + ti[3]; v = bf2f(p.ybuf[s0 * D + c]) + 3.f * bf2f(p.ybuf[s1 * D + c]); }
        else if (DBG_SRC == 13) v = p.small[t * NSMALL + (c % 56)];
        else if (DBG_SRC == 14) v = ((const float*)p.s5E)[i % (4L * 64 * 32 * 64 * 2)] - ((const float*)p.gRT)[i % (4L * 64 * 32 * 64 * 2)];
        else if (DBG_SRC == 11) v = ((const float*)p.s5E)[i % (4L * 64 * 32 * 64 * 2)];
        else if (DBG_SRC == 12) v = c < 1024 ? ((const float*)p.s5lam)[(t * 1024 + c) % 8192] : bf2f(((c & 1) ? p.s5Bt : p.s5Ct)[(t * 1024 + c) % 65536]);
        else v = 0.f;
#ifdef DBG_AMP
        v = v * DBG_AMP; v = v - floorf(v);
#endif
#ifdef DBG_C0
        if (c < DBG_C0 || c >= DBG_C1) v = 0.f;
#endif
        p.out[i] = v;
    }
}
template <int PH> static void launch_phases(const Params& p, int grid, hipStream_t stream) {
    if constexpr (PH < NPH && PH <= DBG_STOP) {
#ifdef REP_PH
        for (int rep = 0; rep < (PH == REP_PH ? REP_N : 0); ++rep) { hipLaunchKernelGGL(phase_k<PH>, dim3(grid), dim3(512), LDS_BYTES, stream, p); (void)hipMemsetAsync(p.cnt + 64, 0, 192 * 4, stream); }
#endif
        hipLaunchKernelGGL(phase_k<PH>, dim3(grid), dim3(512), LDS_BYTES, stream, p); launch_phases<PH + 1>(p, grid, stream); }
    else if constexpr (PH < NPH && DBG_SRC != 7) hipLaunchKernelGGL(dbg_copy, dim3(1024), dim3(256), 0, stream, p);
}
template <int PH> static bool set_attr() {
    if constexpr (PH < NPH) { if (hipFuncSetAttribute((const void*)phase_k<PH>, hipFuncAttributeMaxDynamicSharedMemorySize, LDS_BYTES) != hipSuccess) return false; return set_attr<PH + 1>(); }
    return true;
}
#else
#define XB_TMO      128
#define XB_XCNT(j)  (256  + 64 * (j))
#define XB_XSUB(j)  (1280 + 64 * (j))
#define XB_XGEN(j)  (2304 + 64 * (j))
#define XB_TOP      3328
#define XB_TOPGEN   3392
#define XB_SPIN_CAP (1u << 22)
DI unsigned xb_ld(unsigned* q) { return __hip_atomic_load(q, __ATOMIC_RELAXED, __HIP_MEMORY_SCOPE_AGENT); }
DI unsigned xb_add(unsigned* q, unsigned v) { return __hip_atomic_fetch_add(q, v, __ATOMIC_RELAXED, __HIP_MEMORY_SCOPE_AGENT); }
DI unsigned xb_xcc_id() { return (unsigned)__builtin_amdgcn_s_getreg((3 << 11) | 20) & 0xFu; }
#define XB_SPIN(cond, bar) do { unsigned _sp = 0; while (cond) { __builtin_amdgcn_s_sleep(1); \
    if ((++_sp & 255u) == 0u) { if (xb_ld(&(bar)[XB_TMO])) break; if (_sp > XB_SPIN_CAP) { atomicAdd(&(bar)[XB_TMO], 1u); break; } } } } while (0)
DI void xcd_post() {
    CPP pp = (CPP)__builtin_amdgcn_kernarg_segment_ptr(); asm volatile("" : "+s"(pp));
    if (tidx() == 0) (void)xb_add(&pp->err[XB_XCNT(xb_xcc_id())], 1u);
}
DI void grid_barrier(LAS char* lds_) {
    unsigned lbase = (unsigned)(size_t)lds_; asm volatile("" : "+s"(lbase));
    volatile LAS unsigned* st = (volatile LAS unsigned*)(size_t)(lbase + 159 * 1024);
    CPP pp = (CPP)__builtin_amdgcn_kernarg_segment_ptr(); asm volatile("" : "+s"(pp));
    unsigned* bar = pp->err;
    asm volatile("s_waitcnt vmcnt(0)" ::: "memory");
    __syncthreads();
    if (tidx() == 0) {
        __builtin_amdgcn_s_waitcnt(0);
        const unsigned x = xb_xcc_id();
        unsigned nloc = st[0], nx = st[1];
        if (nloc == 0u) {
            const unsigned G = (unsigned)gdim(); unsigned sum, cnt, mine, sp = 0u;
            for (;;) { sum = 0u; cnt = 0u; mine = 0u;
#pragma unroll
                for (unsigned j = 0; j < 16; ++j) { const unsigned c = xb_ld(&bar[XB_XCNT(j)]); sum += c; cnt += (c > 0u) ? 1u : 0u; mine = (j == x) ? c : mine; }
                if (sum == G) break;
                __builtin_amdgcn_s_sleep(1);
                if ((++sp & 255u) == 0u) { if (xb_ld(&bar[XB_TMO])) break; if (sp > XB_SPIN_CAP) { atomicAdd(&bar[XB_TMO], 1u); break; } } }
            nloc = mine > 0u ? mine : 1u; nx = cnt > 0u ? cnt : 1u; st[0] = nloc; st[1] = nx; }
        const unsigned old = xb_add(&bar[XB_XSUB(x)], 1u);
        const unsigned gen = old / nloc;
        if (old + 1u == (gen + 1u) * nloc) {
            __builtin_amdgcn_fence(__ATOMIC_RELEASE, "agent");
            asm volatile("s_waitcnt vmcnt(0)" ::: "memory");
            const unsigned og = xb_add(&bar[XB_TOP], 1u);
            const unsigned tg = og / nx;
            if (og + 1u == (tg + 1u) * nx) xb_add(&bar[XB_TOPGEN], 1u);
            else XB_SPIN(xb_ld(&bar[XB_TOPGEN]) == tg, bar);
            __builtin_amdgcn_fence(__ATOMIC_ACQUIRE, "agent");
            xb_add(&bar[XB_XGEN(x)], 1u);
            asm volatile("s_waitcnt vmcnt(0)" ::: "memory");
        } else {
            XB_SPIN(xb_ld(&bar[XB_XGEN(x)]) == gen, bar);
            __builtin_amdgcn_fence(__ATOMIC_ACQUIRE, "agent");
            asm volatile("s_waitcnt vmcnt(0)" ::: "memory");
        }
    }
    __syncthreads();
}
template <int PH>
DI void run_from(LAS char* lds) {
    if constexpr (PH < NPH) { run_phase<PH>(lds); if constexpr (PH + 1 < NPH) grid_barrier(lds); run_from<PH + 1>(lds); }
}
__global__ void __launch_bounds__(512) mega(Params p_) {
    extern __shared__ __attribute__((aligned(16))) char smem_raw[];
    if (tidx() < 2) ((LAS unsigned*)(smem_raw + 159 * 1024))[tidx()] = 0u;
    xcd_post();
    cg::this_grid().sync();
    run_from<0>((LAS char*)smem_raw);
}
#endif

extern "C" void kernel_launch(void* const* d_in, const int* in_sizes, int n_in, void* d_out, int out_size, void* d_ws, size_t ws_size, hipStream_t stream) {
    static int grid = 0;
    if (grid == 0) {
        int dev = 0, cus = 0, per_cu = 0;
        (void)hipGetDevice(&dev); (void)hipDeviceGetAttribute(&cus, hipDeviceAttributeMultiprocessorCount, dev);
#if MULTI_LAUNCH
        if (!set_attr<0>()) { fprintf(stderr, "kernel_launch: hipFuncSetAttribute failed\n"); grid = -1; return; }
        per_cu = 1;
#else
        if (hipFuncSetAttribute((const void*)mega, hipFuncAttributeMaxDynamicSharedMemorySize, LDS_BYTES) != hipSuccess) { fprintf(stderr, "kernel_launch: hipFuncSetAttribute failed\n"); grid = -1; return; }
        if (hipOccupancyMaxActiveBlocksPerMultiprocessor(&per_cu, (const void*)mega, 512, LDS_BYTES) != hipSuccess || per_cu < 1) { fprintf(stderr, "kernel_launch: occupancy query says %d blocks/CU\n", per_cu); per_cu = 1; }
        (void)hipGetLastError();
#endif
        grid = cus;
        if (n_in != 33 || out_size != T * D) { fprintf(stderr, "kernel_launch: unexpected problem shape\n"); grid = -1; return; }
    }
    if (grid < 0) return;
    Params p{};
    for (int i = 0; i < 33; ++i) p.in[i] = (const float*)d_in[i];
    p.out = (float*)d_out;
    size_t off = 0;
    auto take = [&](size_t bytes) { void* r = (char*)d_ws + off; off += (bytes + 255) & ~(size_t)255; return r; };
    p.WinT = (bf16_t*)take(2 * LW_WIN * 2); p.WoutT = (bf16_t*)take(2 * LW_WOUT * 2); p.gluT = (bf16_t*)take(2 * LW_GLU * 2);
    p.w1T = (bf16_t*)take(2 * LW_W1 * 2); p.w2T = (bf16_t*)take(2 * LW_W2 * 2);
    p.WguT = (bf16_t*)take(2 * LW_WGU * 2); p.WdT = (bf16_t*)take(2 * LW_WD * 2); p.Wr = (float*)take(48 * D * 4);
    p.s5Bt = (bf16_t*)take(32 * 128 * 32 * 2); p.s5Ct = (bf16_t*)take(32 * 16 * 128 * 2); p.s5lam = (f32x2*)take(2 * 2048 * 8); p.bias1 = (float*)take(512 * 4);
    p.rope = (f32x2*)take(4096 * 32 * 8);
    p.xb = (bf16_t*)take((size_t)T * D * 2); p.rstd_mix = (float*)take(T * 4); p.rstd_ffn = (float*)take(T * 4);
    p.h = p.out;        p.proj = (bf16_t*)take((size_t)T * NPROJ * 2); p.small = (float*)take((size_t)T * NSMALL * 4);
    p.mix = (bf16_t*)take((size_t)T * D * 2); p.s5y = (bf16_t*)take((size_t)T * 512 * 2); p.s5E = (f32x2*)take((size_t)4 * 64 * 32 * 64 * 8);
    p.qn = (bf16_t*)take((size_t)T * 1024 * 2); p.ksn = (bf16_t*)take((size_t)T * 256 * 2); p.kwn = (bf16_t*)take((size_t)T * 256 * 2);
    p.vsT = (bf16_t*)take((size_t)T * 256 * 2); p.vwT = (bf16_t*)take((size_t)T * 256 * 2);
    p.kcmp = (bf16_t*)take(16 * 256 * 64 * 2); p.vcmpT = (bf16_t*)take(16 * 64 * 256 * 2);
    p.gP = (bf16_t*)take((size_t)1024 * 16384 * 2); p.gRT = (float*)take((size_t)1024 * 16384 * 4); p.gQp = (bf16_t*)take((size_t)1024 * 8192 * 2);
    p.gOU = (float*)take((size_t)1024 * 8192 * 4); p.gST = (bf16_t*)take((size_t)1024 * 16384 * 2); p.gA = (float*)take(1024 * 4);
    p.tok_list = (int*)take((size_t)NEXP * T * 4); p.w_list = (float*)take((size_t)NEXP * T * 4); p.tokinfo = (int*)take((size_t)T * 16);
    p.cnt = (int*)take(256 * 4); p.err = (unsigned*)take(XCD_BAR_WORDS * 4);
    p.hid = (bf16_t*)p.gRT;
    p.ybuf = p.proj;
    if (hipMemsetAsync(p.cnt, 0, 256 * 4 + XCD_BAR_WORDS * 4, stream) != hipSuccess) { fprintf(stderr, "kernel_launch: memset failed\n"); return; }
    if (off > ws_size) { fprintf(stderr, "kernel_launch: workspace too small: need %zu have %zu\n", off, ws_size); return; }
#if MULTI_LAUNCH
    launch_phases<0>(p, grid, stream);
#else
    void* args[] = {&p};
    hipError_t e = hipLaunchCooperativeKernel((const void*)mega, dim3(grid), dim3(512), args, LDS_BYTES, stream);
    if (e != hipSuccess) fprintf(stderr, "kernel_launch: cooperative launch failed: %s (grid %d)\n", hipGetErrorString(e), grid);
#endif
}
```
